# Optimizing an MI355X kernel written in HIP

```python
import math
import jax, jax.numpy as jnp
from jax import lax
import numpy as np

D_MODEL = 1024
BATCH = 4
SEQ = 4096
DEPTH = 2

GRID_W = 64
CTX_LEN = 256
N_EVEN = (DEPTH + 1) // 2
N_ODD = DEPTH // 2

LRU_WIDTH = D_MODEL // 2
LRU_BLOCKS = 8
LRU_BLOCK = LRU_WIDTH // LRU_BLOCKS
CONV_W = 4
LRU_C = 8.0

MLA_HEADS = 8
MLA_NOPE = 64
MLA_ROPE = 32
MLA_QK = MLA_NOPE + MLA_ROPE
MLA_V = 64
Q_LORA = D_MODEL // 4
KV_LORA = D_MODEL // 8

EVEN_SPLITS = (LRU_WIDTH, 2 * LRU_WIDTH, 2 * LRU_WIDTH + Q_LORA, 2 * LRU_WIDTH + Q_LORA + KV_LORA)
EVEN_IN = 2 * LRU_WIDTH + Q_LORA + KV_LORA + MLA_ROPE
EVEN_MIX = LRU_WIDTH + MLA_HEADS * MLA_V

GQA_HEADS = 16
GQA_KV_HEADS = 4
GQA_DIM = 64
WINDOW = 128
ODD_IN = (GQA_HEADS + 2 * GQA_KV_HEADS) * GQA_DIM
ODD_MIX = GQA_HEADS * GQA_DIM

Q_BLOCK = 128
ROPE_THETA = 10000.0
NEG_INF = -1e30
EPS = 1e-6

N_EXPERTS = 32
TOP_K = 4
D_FF = D_MODEL
SWIGLU_LIMIT = 7.0
SWIGLU_ALPHA = 1.702
MOE_BLOCK = 128

kernel_name = 'hybrid_rglru_mla_swa_moe_diffusion_block'


def rms_norm(x, g):
    xf = x.astype(jnp.float32)
    y = xf * lax.rsqrt(jnp.mean(xf * xf, axis=-1, keepdims=True) + EPS)
    return (y * g.astype(jnp.float32)).astype(x.dtype)


def axial_rope(n_rows, rot_dim):
    row = jnp.repeat(jnp.arange(n_rows, dtype=jnp.float32), GRID_W)
    col = jnp.tile(jnp.arange(GRID_W, dtype=jnp.float32), n_rows)
    n = rot_dim // 4
    freqs = ROPE_THETA ** (-jnp.arange(n, dtype=jnp.float32) / n)
    ang = jnp.concatenate([row[:, None] * freqs, col[:, None] * freqs], axis=-1)
    return jnp.cos(ang), jnp.sin(ang)


def apply_rope(x, cos, sin):
    xf = x.astype(jnp.float32)
    x1, x2 = jnp.split(xf, 2, axis=-1)
    cs, sn = cos[None, :, None, :], sin[None, :, None, :]
    return jnp.concatenate([x1 * cs - x2 * sn, x2 * cs + x1 * sn], axis=-1).astype(x.dtype)


def ctx_attention(q, k, v, scale, sink=None):
    B, L, H, d = q.shape
    KH = k.shape[2]
    G = H // KH
    qg = q.reshape(B, L, KH, G, d)
    s = jnp.einsum('bqhgd,bkhd->bhgqk', qg, k, preferred_element_type=jnp.float32) * scale
    if sink is not None:
        sink_logit = jnp.broadcast_to(sink.astype(jnp.float32).reshape(1, KH, G, 1, 1), (B, KH, G, L, 1))
        s = jnp.concatenate([s, sink_logit], axis=-1)
    p = jax.nn.softmax(s, axis=-1)[..., :L].astype(v.dtype)
    o = jnp.einsum('bhgqk,bkhd->bqhgd', p, v)
    return o.reshape(B, L, H, -1)


def dense_latent_attention(q, k, v, scale):
    B, S, H, dq = q.shape
    nb = S // Q_BLOCK
    q_blocks = q.reshape(B, nb, Q_BLOCK, H, dq).swapaxes(0, 1)

    def one_block(q_blk):
        s = jnp.einsum('bqhd,bkhd->bhqk', q_blk, k, preferred_element_type=jnp.float32) * scale
        p = jax.nn.softmax(s, axis=-1).astype(v.dtype)
        return jnp.einsum('bhqk,bkhd->bqhd', p, v)

    o = lax.map(one_block, q_blocks)
    return o.swapaxes(0, 1).reshape(B, S, H, -1)


def window_attention(q, k, v, k_ctx, v_ctx, sink, scale):
    B, S, H, d = q.shape
    KH = k.shape[2]
    G = H // KH
    L = k_ctx.shape[1]
    W3 = 3 * Q_BLOCK
    nb = S // Q_BLOCK
    pad = ((0, 0), (Q_BLOCK, Q_BLOCK), (0, 0), (0, 0))
    k_pad = jnp.pad(k, pad)
    v_pad = jnp.pad(v, pad)
    q_blocks = q.reshape(B, nb, Q_BLOCK, KH, G, d).swapaxes(0, 1)
    sink_logit = jnp.broadcast_to(sink.astype(jnp.float32).reshape(1, KH, G, 1, 1), (B, KH, G, Q_BLOCK, 1))

    def one_block(args):
        i, q_blk = args
        k_win = lax.dynamic_slice_in_dim(k_pad, i * Q_BLOCK, W3, axis=1)
        v_win = lax.dynamic_slice_in_dim(v_pad, i * Q_BLOCK, W3, axis=1)
        q_pos = i * Q_BLOCK + jnp.arange(Q_BLOCK)
        k_pos = (i - 1) * Q_BLOCK + jnp.arange(W3)
        valid = (jnp.abs(q_pos[:, None] - k_pos[None, :]) <= WINDOW) & (k_pos >= 0) & (k_pos < S)
        s_win = jnp.einsum('bqhgd,bkhd->bhgqk', q_blk, k_win, preferred_element_type=jnp.float32) * scale
        s_win = jnp.where(valid, s_win, NEG_INF)
        s_ctx = jnp.einsum('bqhgd,bkhd->bhgqk', q_blk, k_ctx, preferred_element_type=jnp.float32) * scale
        p = jax.nn.softmax(jnp.concatenate([s_win, s_ctx, sink_logit], axis=-1), axis=-1)
        p_win = p[..., :W3].astype(v.dtype)
        p_ctx = p[..., W3:W3 + L].astype(v.dtype)
        return (jnp.einsum('bhgqk,bkhd->bqhgd', p_win, v_win)
                + jnp.einsum('bhgqk,bkhd->bqhgd', p_ctx, v_ctx))

    o = lax.map(one_block, (jnp.arange(nb), q_blocks))
    return o.swapaxes(0, 1).reshape(B, S, H, d)


def _linear_recurrence_combine(e1, e2):
    a1, b1 = e1
    a2, b2 = e2
    return a1 * a2, a2 * b1 + b2


def rglru_scan(u, conv_w, conv_b, w_r, b_r, w_i, b_i, lam, h0):
    B, T, C = u.shape
    xc = lax.conv_general_dilated(
        u, conv_w.astype(u.dtype)[:, None, :], window_strides=(1,), padding=[(CONV_W - 1, 0)],
        dimension_numbers=('NWC', 'WIO', 'NWC'), feature_group_count=C)
    xf = (xc + conv_b.astype(u.dtype)).astype(jnp.float32)
    xb = xf.reshape(B, T, LRU_BLOCKS, LRU_BLOCK)
    r = jax.nn.sigmoid(jnp.einsum('btnc,ncd->btnd', xb, w_r.astype(jnp.float32)).reshape(B, T, C)
                       + b_r.astype(jnp.float32))
    gi = jax.nn.sigmoid(jnp.einsum('btnc,ncd->btnd', xb, w_i.astype(jnp.float32)).reshape(B, T, C)
                        + b_i.astype(jnp.float32))
    log_a = -LRU_C * r * jax.nn.softplus(-lam.astype(jnp.float32))
    a = jnp.exp(log_a)
    b = jnp.sqrt(-jnp.expm1(2.0 * log_a)) * (gi * xf)
    b = b.at[:, 0].add(a[:, 0] * h0)
    _, h = lax.associative_scan(_linear_recurrence_combine, (a, b), axis=1)
    return h, h[:, -1]


def even_mixer(h_lat, h_ctx, w_in, conv_w, conv_b, w_r, b_r, w_i, b_i, lam,
               q_a_norm, w_q_b, kv_a_norm, w_kv_b, nope_norm, rope_norm, w_out, rope_cs, need_ctx):
    B, S, _ = h_lat.shape
    L = h_ctx.shape[1]
    xa_l, ga_l, qa_l, kva_l, kr_l = jnp.split(h_lat @ w_in, EVEN_SPLITS, axis=-1)
    xa_c, ga_c, qa_c, kva_c, kr_c = jnp.split(h_ctx @ w_in, EVEN_SPLITS, axis=-1)

    rec_l, rec_c = [], []
    for d in range(2):
        flip = (lambda t: jnp.flip(t, axis=1)) if d == 1 else (lambda t: t)
        h0 = jnp.zeros((B, LRU_WIDTH), jnp.float32)
        hc, hc_last = rglru_scan(flip(xa_c), conv_w[d], conv_b[d], w_r[d], b_r[d], w_i[d], b_i[d], lam[d], h0)
        hl, _ = rglru_scan(flip(xa_l), conv_w[d], conv_b[d], w_r[d], b_r[d], w_i[d], b_i[d], lam[d], hc_last)
        rec_l.append(flip(hl))
        rec_c.append(flip(hc))
    ya_l = ((rec_l[0] + rec_l[1]) * jax.nn.gelu(ga_l.astype(jnp.float32))).astype(h_lat.dtype)

    def mla_qkv(qa, kva, kr, cs):
        Bq, T, _ = qa.shape
        q = (rms_norm(qa, q_a_norm) @ w_q_b).reshape(Bq, T, MLA_HEADS, MLA_QK)
        kv = (rms_norm(kva, kv_a_norm) @ w_kv_b).reshape(Bq, T, MLA_HEADS, MLA_NOPE + MLA_V)
        q_nope = rms_norm(q[..., :MLA_NOPE], nope_norm[0])
        q_rope = rms_norm(q[..., MLA_NOPE:], rope_norm[0])
        k_nope = rms_norm(kv[..., :MLA_NOPE], nope_norm[1])
        v = kv[..., MLA_NOPE:]
        k_rope = rms_norm(kr[:, :, None, :], rope_norm[1])
        if cs is not None:
            q_rope = apply_rope(q_rope, *cs)
            k_rope = apply_rope(k_rope, *cs)
        k_rope = jnp.broadcast_to(k_rope, (Bq, T, MLA_HEADS, MLA_ROPE))
        return (jnp.concatenate([q_nope, q_rope], axis=-1),
                jnp.concatenate([k_nope, k_rope], axis=-1), v)

    scale = MLA_QK ** -0.5
    q_c, k_c, v_c = mla_qkv(qa_c, kva_c, kr_c, None)
    q_l, k_l, v_l = mla_qkv(qa_l, kva_l, kr_l, rope_cs)
    yb_l = dense_latent_attention(q_l, jnp.concatenate([k_l, k_c], axis=1),
                                  jnp.concatenate([v_l, v_c], axis=1), scale)
    out_l = jnp.concatenate([ya_l, yb_l.reshape(B, S, -1)], axis=-1) @ w_out
    out_c = None
    if need_ctx:
        ya_c = ((rec_c[0] + rec_c[1]) * jax.nn.gelu(ga_c.astype(jnp.float32))).astype(h_ctx.dtype)
        yb_c = ctx_attention(q_c, k_c, v_c, scale)
        out_c = jnp.concatenate([ya_c, yb_c.reshape(B, L, -1)], axis=-1) @ w_out
    return out_l, out_c


def odd_mixer(h_lat, h_ctx, w_qkv, qk_norm, sink, w_out, rope_cs, need_ctx):
    B, S, _ = h_lat.shape
    L = h_ctx.shape[1]
    nq = GQA_HEADS * GQA_DIM
    nk = GQA_KV_HEADS * GQA_DIM

    def qkv(h, cs):
        Bq, T, _ = h.shape
        z = h @ w_qkv
        q = rms_norm(z[..., :nq].reshape(Bq, T, GQA_HEADS, GQA_DIM), qk_norm[0])
        k = rms_norm(z[..., nq:nq + nk].reshape(Bq, T, GQA_KV_HEADS, GQA_DIM), qk_norm[1])
        v = z[..., nq + nk:].reshape(Bq, T, GQA_KV_HEADS, GQA_DIM)
        if cs is not None:
            q = apply_rope(q, *cs)
            k = apply_rope(k, *cs)
        return q, k, v

    scale = GQA_DIM ** -0.5
    q_c, k_c, v_c = qkv(h_ctx, None)
    q_l, k_l, v_l = qkv(h_lat, rope_cs)
    o_l = window_attention(q_l, k_l, v_l, k_c, v_c, sink, scale)
    out_l = o_l.reshape(B, S, -1) @ w_out
    out_c = None
    if need_ctx:
        out_c = ctx_attention(q_c, k_c, v_c, scale, sink).reshape(B, L, -1) @ w_out
    return out_l, out_c


def moe_ffn(t, w_router, b_router, w_gu, b_gu, w_dn, b_dn):
    N, D = t.shape
    logits = jnp.dot(t, w_router, preferred_element_type=jnp.float32) + b_router.astype(jnp.float32)
    top_logit, top_e = lax.top_k(logits, TOP_K)
    gate = jax.nn.softmax(top_logit, axis=-1)
    n_assign = N * TOP_K
    flat_e = top_e.reshape(-1)
    order = jnp.argsort(flat_e)
    e_sorted = flat_e[order]
    tok_sorted = (order // TOP_K).astype(jnp.int32)
    gate_sorted = gate.reshape(-1)[order]
    counts = jnp.bincount(flat_e, length=N_EXPERTS)
    padded = (counts + MOE_BLOCK - 1) // MOE_BLOCK * MOE_BLOCK
    start = jnp.cumsum(counts) - counts
    padded_end = jnp.cumsum(padded)
    padded_start = padded_end - padded
    dest = padded_start[e_sorted] + jnp.arange(n_assign) - start[e_sorted]
    n_blocks = -(-n_assign // MOE_BLOCK) + N_EXPERTS
    rows = n_blocks * MOE_BLOCK
    row_tok = jnp.full((rows,), N, jnp.int32).at[dest].set(tok_sorted)
    row_gate = jnp.zeros((rows,), jnp.float32).at[dest].set(gate_sorted)
    block_e = jnp.minimum(jnp.searchsorted(padded_end, jnp.arange(n_blocks) * MOE_BLOCK, side='right'),
                          N_EXPERTS - 1)
    t_pad = jnp.concatenate([t, jnp.zeros((1, D), t.dtype)], axis=0)
    xb = t_pad[row_tok].reshape(n_blocks, MOE_BLOCK, D)

    def expert_block(args):
        x_blk, e = args
        hgu = jnp.dot(x_blk, w_gu[e], preferred_element_type=jnp.float32) + b_gu[e].astype(jnp.float32)
        hg, hu = jnp.split(hgu, 2, axis=-1)
        hg = jnp.minimum(hg, SWIGLU_LIMIT)
        hu = jnp.clip(hu, -SWIGLU_LIMIT, SWIGLU_LIMIT)
        act = hg * jax.nn.sigmoid(SWIGLU_ALPHA * hg) * (hu + 1.0)
        return jnp.dot(act.astype(t.dtype), w_dn[e], preferred_element_type=jnp.float32) + b_dn[e].astype(jnp.float32)

    yb = lax.map(expert_block, (xb, block_e))
    y = yb.reshape(rows, D) * row_gate[:, None]
    out = jnp.zeros((N + 1, D), jnp.float32).at[row_tok].add(y)[:N]
    return out.astype(t.dtype)


def setup_inputs(seed: int = 0) -> dict:
    key = jax.random.key(seed)
    keys = iter(jax.random.split(key, 48))
    f32 = jnp.float32
    D = D_MODEL

    def nrm(shape, scale):
        return jax.random.normal(next(keys), shape, f32) * scale

    def gain(shape):
        return 1.0 + 0.1 * jax.random.normal(next(keys), shape, f32)

    x = nrm((BATCH, SEQ, D), 1.0)
    c = nrm((BATCH, D), 1.0)
    ctx = nrm((BATCH, CTX_LEN, D), 1.0)
    c_ctx = nrm((D,), 1.0)
    w_mod = nrm((DEPTH, D, 6 * D), 0.5 / math.sqrt(D))
    b_mod = nrm((DEPTH, 6 * D), 0.02)
    norm_mix = gain((DEPTH, D))
    norm_ffn = gain((DEPTH, D))
    w_in_even = nrm((N_EVEN, D, EVEN_IN), D ** -0.5)
    lru_conv_w = nrm((N_EVEN, 2, CONV_W, LRU_WIDTH), 0.5)
    lru_conv_b = nrm((N_EVEN, 2, LRU_WIDTH), 0.02)
    lru_w_r = nrm((N_EVEN, 2, LRU_BLOCKS, LRU_BLOCK, LRU_BLOCK), LRU_BLOCK ** -0.5)
    lru_b_r = nrm((N_EVEN, 2, LRU_WIDTH), 0.02)
    lru_w_i = nrm((N_EVEN, 2, LRU_BLOCKS, LRU_BLOCK, LRU_BLOCK), LRU_BLOCK ** -0.5)
    lru_b_i = nrm((N_EVEN, 2, LRU_WIDTH), 0.02)
    a0 = jax.random.uniform(next(keys), (N_EVEN, 2, LRU_WIDTH), f32, 0.9, 0.999)
    a_base = a0 ** (1.0 / LRU_C)
    lru_lambda = jnp.log(a_base) - jnp.log1p(-a_base)
    mla_q_a_norm = gain((N_EVEN, Q_LORA))
    mla_w_q_b = nrm((N_EVEN, Q_LORA, MLA_HEADS * MLA_QK), Q_LORA ** -0.5)
    mla_kv_a_norm = gain((N_EVEN, KV_LORA))
    mla_w_kv_b = nrm((N_EVEN, KV_LORA, MLA_HEADS * (MLA_NOPE + MLA_V)), KV_LORA ** -0.5)
    mla_nope_norm = gain((N_EVEN, 2, MLA_NOPE))
    mla_rope_norm = gain((N_EVEN, 2, MLA_ROPE))
    w_out_even = nrm((N_EVEN, EVEN_MIX, D), EVEN_MIX ** -0.5)
    w_qkv_odd = nrm((N_ODD, D, ODD_IN), D ** -0.5)
    gqa_qk_norm = gain((N_ODD, 2, GQA_DIM))
    gqa_sink = nrm((N_ODD, GQA_HEADS), 0.5)
    w_out_odd = nrm((N_ODD, ODD_MIX, D), ODD_MIX ** -0.5)
    w_router = nrm((DEPTH, D, N_EXPERTS), D ** -0.5)
    b_router = nrm((DEPTH, N_EXPERTS), 0.01)
    w_gate_up = nrm((DEPTH, N_EXPERTS, D, 2 * D_FF), D ** -0.5)
    b_gate_up = nrm((DEPTH, N_EXPERTS, 2 * D_FF), 0.02)
    w_down = nrm((DEPTH, N_EXPERTS, D_FF, D), D_FF ** -0.5)
    b_down = nrm((DEPTH, N_EXPERTS, D), 0.02)
    return {'x': x, 'c': c, 'ctx': ctx, 'c_ctx': c_ctx,
            'w_mod': w_mod, 'b_mod': b_mod, 'norm_mix': norm_mix, 'norm_ffn': norm_ffn,
            'w_in_even': w_in_even, 'lru_conv_w': lru_conv_w, 'lru_conv_b': lru_conv_b,
            'lru_w_r': lru_w_r, 'lru_b_r': lru_b_r, 'lru_w_i': lru_w_i, 'lru_b_i': lru_b_i,
            'lru_lambda': lru_lambda, 'mla_q_a_norm': mla_q_a_norm, 'mla_w_q_b': mla_w_q_b,
            'mla_kv_a_norm': mla_kv_a_norm, 'mla_w_kv_b': mla_w_kv_b, 'mla_nope_norm': mla_nope_norm,
            'mla_rope_norm': mla_rope_norm, 'w_out_even': w_out_even,
            'w_qkv_odd': w_qkv_odd, 'gqa_qk_norm': gqa_qk_norm, 'gqa_sink': gqa_sink, 'w_out_odd': w_out_odd,
            'w_router': w_router, 'b_router': b_router, 'w_gate_up': w_gate_up, 'b_gate_up': b_gate_up,
            'w_down': w_down, 'b_down': b_down}


def reference(x, c, ctx, c_ctx, w_mod, b_mod, norm_mix, norm_ffn,
              w_in_even, lru_conv_w, lru_conv_b, lru_w_r, lru_b_r, lru_w_i, lru_b_i, lru_lambda,
              mla_q_a_norm, mla_w_q_b, mla_kv_a_norm, mla_w_kv_b, mla_nope_norm, mla_rope_norm, w_out_even,
              w_qkv_odd, gqa_qk_norm, gqa_sink, w_out_odd,
              w_router, b_router, w_gate_up, b_gate_up, w_down, b_down):
    B, S, D = x.shape
    L = ctx.shape[1]
    n_rows = S // GRID_W
    rope_mla = axial_rope(n_rows, MLA_ROPE)
    rope_gqa = axial_rope(n_rows, GQA_DIM)
    x_l, x_c = x, ctx
    for layer in range(DEPTH):
        last = layer == DEPTH - 1
        mod_l = (jax.nn.silu(c) @ w_mod[layer] + b_mod[layer])[:, None, :]
        mod_c = jax.nn.silu(c_ctx) @ w_mod[layer] + b_mod[layer]
        sh1_l, sc1_l, g1_l, sh2_l, sc2_l, g2_l = jnp.split(mod_l, 6, axis=-1)
        sh1_c, sc1_c, g1_c, sh2_c, sc2_c, g2_c = jnp.split(mod_c, 6, axis=-1)
        h_l = rms_norm(x_l, norm_mix[layer]) * (1.0 + sc1_l) + sh1_l
        h_c = rms_norm(x_c, norm_mix[layer]) * (1.0 + sc1_c) + sh1_c
        if layer % 2 == 0:
            e = layer // 2
            m_l, m_c = even_mixer(h_l, h_c, w_in_even[e], lru_conv_w[e], lru_conv_b[e], lru_w_r[e], lru_b_r[e],
                                  lru_w_i[e], lru_b_i[e], lru_lambda[e], mla_q_a_norm[e], mla_w_q_b[e],
                                  mla_kv_a_norm[e], mla_w_kv_b[e], mla_nope_norm[e], mla_rope_norm[e],
                                  w_out_even[e], rope_mla, not last)
        else:
            o = layer // 2
            m_l, m_c = odd_mixer(h_l, h_c, w_qkv_odd[o], gqa_qk_norm[o], gqa_sink[o], w_out_odd[o],
                                 rope_gqa, not last)
        x_l = x_l + g1_l * m_l
        f_l = rms_norm(x_l, norm_ffn[layer]) * (1.0 + sc2_l) + sh2_l
        moe_args = (w_router[layer], b_router[layer], w_gate_up[layer], b_gate_up[layer],
                    w_down[layer], b_down[layer])
        if last:
            y_l = moe_ffn(f_l.reshape(B * S, D), *moe_args).reshape(B, S, D)
        else:
            x_c = x_c + g1_c * m_c
            f_c = rms_norm(x_c, norm_ffn[layer]) * (1.0 + sc2_c) + sh2_c
            y = moe_ffn(jnp.concatenate([f_l.reshape(B * S, D), f_c.reshape(B * L, D)], axis=0), *moe_args)
            y_l = y[:B * S].reshape(B, S, D)
            x_c = x_c + g2_c * y[B * S:].reshape(B, L, D)
        x_l = x_l + g2_l * y_l
    return x_l
```

```cpp
#include <hip/hip_runtime.h>
#include <stdint.h>
#include <stdio.h>

typedef unsigned short bf16;
typedef short bf16x8 __attribute__((ext_vector_type(8)));
typedef float f32x4 __attribute__((ext_vector_type(4)));
typedef unsigned u32x2 __attribute__((ext_vector_type(2)));
typedef unsigned u32x4 __attribute__((ext_vector_type(4)));

constexpr int D = 1024, NB = 4, SEQ = 4096, CTX = 256;
constexpr int NL = NB * SEQ, NC = NB * CTX, NT = NL + NC;
constexpr int TA = SEQ + CTX;
constexpr int NE = 32, TOPK = 4;
constexpr int EVEN_IN = 1440, ZLD = 1536;
constexpr int MAXT256 = 304;
constexpr int ACT_ROWS = MAXT256 * 256;

constexpr size_t al256(size_t x) { return (x + 255) & ~(size_t)255; }
constexpr size_t WS_CTL = 0, CTL_BYTES = 1u << 20;
constexpr size_t CW_CNT = 65536;
constexpr size_t WS_MOD = WS_CTL + CTL_BYTES;
constexpr size_t WS_ROPEM = al256(WS_MOD + 2 * 5 * 6144 * 4);
constexpr size_t WS_ROPEG = al256(WS_ROPEM + 4096 * 16 * 2 * 4);
constexpr size_t WS_WRT = al256(WS_ROPEG + 4096 * 32 * 2 * 4);
constexpr size_t WS_WRI = al256(WS_WRT + 2 * 32 * 1024 * 4);
constexpr size_t WS_WIN = al256(WS_WRI + 2 * 8 * 128 * 64 * 2);
constexpr size_t WS_WQKVB = al256(WS_WIN + 1536 * 1024 * 2);
constexpr size_t WS_WOE = al256(WS_WQKVB + 1792 * 384 * 2);
constexpr size_t WS_WQO = al256(WS_WOE + 1024 * 1024 * 2);
constexpr size_t WS_WOO = al256(WS_WQO + 1536 * 1024 * 2);
constexpr size_t WS_WGU = al256(WS_WOO + 1024 * 1024 * 2);
constexpr size_t WS_WDN = al256(WS_WGU + (size_t)2 * 32 * 2048 * 1024 * 2);
constexpr size_t WS_HN = al256(WS_WDN + (size_t)2 * 32 * 1024 * 1024 * 2);
constexpr size_t WS_Z = al256(WS_HN + (size_t)NT * D * 2);
constexpr size_t WS_QKVN = al256(WS_Z + (size_t)NT * ZLD * 4);
constexpr size_t WS_QKVR = al256(WS_QKVN + (size_t)NT * 384 * 2);
constexpr size_t WS_QM = al256(WS_QKVR + (size_t)NT * 1792 * 4);
constexpr size_t WS_KM = al256(WS_QM + (size_t)NB * 8 * TA * 96 * 2);
constexpr size_t WS_VM = al256(WS_KM + (size_t)NB * 8 * TA * 96 * 2);
constexpr size_t WS_QG = al256(WS_VM + (size_t)NB * 8 * TA * 64 * 2);
constexpr size_t WS_KG = al256(WS_QG + (size_t)NB * 16 * SEQ * 64 * 2);
constexpr size_t WS_VG = al256(WS_KG + (size_t)NB * 4 * TA * 64 * 2);
constexpr size_t WS_YM = al256(WS_VG + (size_t)NB * 4 * TA * 64 * 2);
constexpr size_t WS_X1 = al256(WS_YM + (size_t)NT * D * 2);
constexpr size_t WS_X2 = al256(WS_X1 + (size_t)NT * D * 4);
constexpr size_t WS_F = al256(WS_X2 + (size_t)NT * D * 4);
constexpr size_t WS_LA = al256(WS_F + (size_t)NT * D * 2);
constexpr size_t WS_LB = al256(WS_LA + (size_t)2 * NT * 512 * 4);
constexpr size_t WS_LH = al256(WS_LB + (size_t)2 * NT * 512 * 4);
constexpr size_t WS_XF = al256(WS_LH + (size_t)2 * NT * 512 * 4);
constexpr size_t WS_PE = al256(WS_XF + (size_t)2 * NT * 512 * 4);
constexpr size_t WS_PS = al256(WS_PE + (size_t)NT * 4 * 4);
constexpr size_t WS_PG = al256(WS_PS + (size_t)NT * 4 * 4);
constexpr size_t WS_TOK = al256(WS_PG + (size_t)NT * 4 * 4);
constexpr size_t WS_ACT = al256(WS_TOK + (size_t)NE * NT * 4);
constexpr size_t WS_Y = al256(WS_ACT + (size_t)ACT_ROWS * D * 2);
constexpr size_t WS_END = al256(WS_Y + (size_t)ACT_ROWS * D * 2);

__device__ __forceinline__ unsigned f2bf(float f) { unsigned u = __float_as_uint(f); u += 0x7FFFu + ((u >> 16) & 1u); return u >> 16; }
__device__ __forceinline__ unsigned pk2(float a, float b) { return f2bf(a) | (f2bf(b) << 16); }
__device__ __forceinline__ float bf2f(unsigned b) { return __uint_as_float(b << 16); }
__device__ __forceinline__ float bflo(unsigned u) { return __uint_as_float(u << 16); }
__device__ __forceinline__ float bfhi(unsigned u) { return __uint_as_float(u & 0xffff0000u); }
__device__ __forceinline__ float wave_sum(float v) {
#pragma unroll
    for (int o = 1; o < 64; o <<= 1) v += __shfl_xor(v, o);
    return v;
}
__device__ __forceinline__ float sigmoidf_(float x) { return 1.f / (1.f + __expf(-x)); }
__device__ __forceinline__ float gelu_tanh(float x) { const float u = 0.7978845608028654f * (x + 0.044715f * x * x * x); return 0.5f * x * (1.f + tanhf(u)); }
__device__ __forceinline__ int mod_row(int r) { return r < NL ? (r >> 12) : 4; }
__device__ __forceinline__ void row_bs(int r, int& b, int& s) { if (r < NL) { b = r >> 12; s = r & 4095; } else { const int rc = r - NL; b = rc >> 8; s = SEQ + (rc & 255); } }

struct Ptrs {
    const float* in[33];
    float* out;
    unsigned char* ws;
};
#define WSP(T, off) ((T*)(P.ws + (off)))

__global__ void __launch_bounds__(256) k_mod(Ptrs P) {
    __shared__ float sl[5][1024];
    const float* c = P.in[1]; const float* cc = P.in[3];
    for (int i = threadIdx.x; i < 5 * 1024; i += 256) { const int r = i >> 10, k = i & 1023; const float v = r < 4 ? c[r * 1024 + k] : cc[k]; sl[r][k] = v / (1.f + __expf(-v)); }
    __syncthreads();
    const int gid = blockIdx.x * 256 + threadIdx.x, l = gid / 6144, j = gid % 6144;
    const float* w = P.in[4] + (size_t)l * 1024 * 6144 + j;
    float acc[5] = {0.f, 0.f, 0.f, 0.f, 0.f};
    for (int k = 0; k < 1024; ++k) { const float wv = w[(size_t)k * 6144];
#pragma unroll
        for (int r = 0; r < 5; ++r) acc[r] += sl[r][k] * wv; }
    float* MOD = WSP(float, WS_MOD);
    const float bm = P.in[5][l * 6144 + j];
#pragma unroll
    for (int r = 0; r < 5; ++r) MOD[(l * 5 + r) * 6144 + j] = acc[r] + bm;
}
__global__ void __launch_bounds__(256) k_rope(Ptrs P) {
    const int gid = blockIdx.x * 256 + threadIdx.x; if (gid >= 4096 * 48) return;
    const int s = gid / 48, i = gid % 48;
    const int row = s >> 6, col = s & 63;
    if (i < 16) { const int n = 8, fi = i & 7; const float fr = powf(10000.f, -(float)fi / (float)n); const float ang = (float)(i < 8 ? row : col) * fr;
        float* T = WSP(float, WS_ROPEM) + ((size_t)s * 16 + i) * 2; T[0] = cosf(ang); T[1] = sinf(ang); }
    else { const int ii = i - 16, n = 16, fi = ii & 15; const float fr = powf(10000.f, -(float)fi / (float)n); const float ang = (float)(ii < 16 ? row : col) * fr;
        float* T = WSP(float, WS_ROPEG) + ((size_t)s * 32 + ii) * 2; T[0] = cosf(ang); T[1] = sinf(ang); }
}
template <int MAP>
__device__ __forceinline__ void transpose_item(const float* W, int ldw, bf16* WT, int ldt, int k0, int n0, int row_off, int col_off, float* scr, int lane) {
#pragma unroll 8
    for (int i = 0; i < 32; ++i) { const int kk = 2 * i + (lane >> 5); scr[kk * 33 + (lane & 31)] = W[(size_t)(k0 + kk) * ldw + n0 + (lane & 31)]; }
    __builtin_amdgcn_s_waitcnt(0xc07f); asm volatile("" ::: "memory");
    const int c = lane & 7;
#pragma unroll
    for (int j = 0; j < 4; ++j) { const int n = (lane >> 3) + 8 * j; const float* s = scr + (8 * c) * 33 + n;
        u32x4 o; o.x = pk2(s[0 * 33], s[1 * 33]); o.y = pk2(s[2 * 33], s[3 * 33]); o.z = pk2(s[4 * 33], s[5 * 33]); o.w = pk2(s[6 * 33], s[7 * 33]);
        int nn = n0 + n;
        if (MAP == 1) { const int up = nn >= 1024, jj = nn & 1023; nn = (jj >> 4) * 32 + up * 16 + (jj & 15); }
        *(u32x4*)(WT + (size_t)(row_off + nn) * ldt + col_off + k0 + 8 * c) = o; }
    __builtin_amdgcn_s_waitcnt(0xc07f); asm volatile("" ::: "memory");
}
struct TJob { const float* W; bf16* WT; int K, N, ldw, ldt, row_off, col_off, map; long wstride, tstride; int count; };
__global__ void __launch_bounds__(256) k_transpose(TJob j) {
    __shared__ float scr_all[4][64 * 33];
    const int wave = threadIdx.x >> 6, lane = threadIdx.x & 63;
    float* scr = scr_all[wave];
    const int nkb = j.K / 64, nnb = j.N / 32; const long per = (long)nkb * nnb, total = per * j.count;
    for (long it = (long)blockIdx.x * 4 + wave; it < total; it += (long)gridDim.x * 4) {
        const int m = (int)(it / per); const int r = (int)(it % per); const int kb = r / nnb, nb = r % nnb;
        const float* W = j.W + (size_t)m * j.wstride; bf16* WT = j.WT + (size_t)m * j.tstride;
        if (j.map == 1) transpose_item<1>(W, j.ldw, WT, j.ldt, kb * 64, nb * 32, j.row_off, j.col_off, scr, lane);
        else transpose_item<0>(W, j.ldw, WT, j.ldt, kb * 64, nb * 32, j.row_off, j.col_off, scr, lane);
    }
}
__global__ void __launch_bounds__(256) k_zero16(u32x4* p, size_t n16) { for (size_t i = (size_t)blockIdx.x * 256 + threadIdx.x; i < n16; i += (size_t)gridDim.x * 256) p[i] = (u32x4){0u, 0u, 0u, 0u}; }
__global__ void __launch_bounds__(256) k_router_t(Ptrs P) {
    const int gid = blockIdx.x * 256 + threadIdx.x; if (gid >= 2 * 32 * 1024) return;
    const int l = gid >> 15, e = (gid >> 10) & 31, k = gid & 1023;
    WSP(float, WS_WRT)[gid] = P.in[27][((size_t)l * 1024 + k) * 32 + e];
}
__global__ void __launch_bounds__(256) k_lru_w(Ptrs P) {
    const int gid = blockIdx.x * 256 + threadIdx.x; if (gid >= 2 * 8 * 128 * 64) return;
    const int c = gid & 63, o = (gid >> 6) & 127, blk = (gid >> 13) & 7, dir = gid >> 16;
    const float* src = o < 64 ? P.in[11] : P.in[13];
    WSP(bf16, WS_WRI)[gid] = (bf16)f2bf(src[(((size_t)dir * 8 + blk) * 64 + c) * 64 + (o & 63)]);
}

struct RowV { f32x4 v[4]; };
__device__ __forceinline__ RowV load_row(const float* p, int lane) { RowV r; const f32x4* q = (const f32x4*)p + lane;
#pragma unroll
    for (int j = 0; j < 4; ++j) r.v[j] = q[64 * j]; return r; }
__device__ __forceinline__ void norm_mod(RowV& r, const float* g, const float* sc, const float* sh, int lane) {
    float s = 0.f;
#pragma unroll
    for (int j = 0; j < 4; ++j) s += r.v[j].x * r.v[j].x + r.v[j].y * r.v[j].y + r.v[j].z * r.v[j].z + r.v[j].w * r.v[j].w;
    const float rs = rsqrtf(wave_sum(s) * (1.f / D) + 1e-6f);
#pragma unroll
    for (int j = 0; j < 4; ++j) { const f32x4 gv = ((const f32x4*)g)[lane + 64 * j], scv = ((const f32x4*)sc)[lane + 64 * j], shv = ((const f32x4*)sh)[lane + 64 * j];
        r.v[j] = (r.v[j] * rs * gv) * (scv + 1.f) + shv; }
}
__device__ __forceinline__ void store_row_bf16(bf16* p, const RowV& r, int lane) { u32x2* q = (u32x2*)p + lane;
#pragma unroll
    for (int j = 0; j < 4; ++j) { u32x2 o; o.x = pk2(r.v[j].x, r.v[j].y); o.y = pk2(r.v[j].z, r.v[j].w); q[64 * j] = o; } }
__device__ __forceinline__ const float* xrow0(const Ptrs& P, int r) { return r < NL ? P.in[0] + (size_t)r * D : P.in[2] + (size_t)(r - NL) * D; }

__global__ void __launch_bounds__(256) k_norm0(Ptrs P) {
    const int lane = threadIdx.x & 63; const int nw = gridDim.x * 4;
    const float* MOD = WSP(float, WS_MOD);
    for (int r = blockIdx.x * 4 + (threadIdx.x >> 6); r < NT; r += nw) {
        RowV v = load_row(xrow0(P, r), lane);
        const float* m = MOD + (size_t)(0 * 5 + mod_row(r)) * 6144;
        norm_mod(v, P.in[6], m + 1024, m, lane);
        store_row_bf16(WSP(bf16, WS_HN) + (size_t)r * D, v, lane);
    }
}

__device__ __forceinline__ void wtile(const bf16* a0, const bf16* a1, const bf16* b0, const bf16* b1, int K, f32x4 (&acc)[2][2]) {
#pragma unroll
    for (int m = 0; m < 2; ++m)
#pragma unroll
        for (int n = 0; n < 2; ++n) acc[m][n] = (f32x4){0.f, 0.f, 0.f, 0.f};
    for (int k = 0; k < K; k += 32) {
        const bf16x8 A0 = *(const bf16x8*)(a0 + k), A1 = *(const bf16x8*)(a1 + k), B0 = *(const bf16x8*)(b0 + k), B1 = *(const bf16x8*)(b1 + k);
        acc[0][0] = __builtin_amdgcn_mfma_f32_16x16x32_bf16(B0, A0, acc[0][0], 0, 0, 0);
        acc[0][1] = __builtin_amdgcn_mfma_f32_16x16x32_bf16(B1, A0, acc[0][1], 0, 0, 0);
        acc[1][0] = __builtin_amdgcn_mfma_f32_16x16x32_bf16(B0, A1, acc[1][0], 0, 0, 0);
        acc[1][1] = __builtin_amdgcn_mfma_f32_16x16x32_bf16(B1, A1, acc[1][1], 0, 0, 0);
    }
}
struct EpiF32 { float* C; int ldc, nvalid;
    __device__ __forceinline__ void operator()(int row, int col, f32x4 a, f32x4 b) const {
        if (col < nvalid) *(f32x4*)(C + (size_t)row * ldc + col) = a;
        if (col + 16 < nvalid) *(f32x4*)(C + (size_t)row * ldc + col + 16) = b; } };
struct EpiResid { const float* xin0; const float* xin1; float* xout; const float* g;
    __device__ __forceinline__ void operator()(int row, int col, f32x4 a, f32x4 b) const {
        const float* xi = row < NL ? xin0 + (size_t)row * D : xin1 + (size_t)(row - NL) * D; const float* gg = g + (size_t)mod_row(row) * 6144;
        float* xo = xout + (size_t)row * D;
        *(f32x4*)(xo + col) = *(const f32x4*)(xi + col) + *(const f32x4*)(gg + col) * a;
        *(f32x4*)(xo + col + 16) = *(const f32x4*)(xi + col + 16) + *(const f32x4*)(gg + col + 16) * b; } };
struct EpiSwiglu { bf16* act; const float* bias;
    __device__ __forceinline__ void operator()(int row, int col, f32x4 a, f32x4 b) const {
        const int j = (col >> 5) * 16 + (col & 15);
        const f32x4 bg = *(const f32x4*)(bias + j), bu = *(const f32x4*)(bias + 1024 + j);
        float o[4];
#pragma unroll
        for (int i = 0; i < 4; ++i) { float hg = a[i] + bg[i], hu = b[i] + bu[i]; hg = fminf(hg, 7.f); hu = fminf(fmaxf(hu, -7.f), 7.f);
            o[i] = hg * sigmoidf_(1.702f * hg) * (hu + 1.f); }
        u32x2 w; w.x = pk2(o[0], o[1]); w.y = pk2(o[2], o[3]);
        *(u32x2*)(act + (size_t)row * D + j) = w; } };
struct EpiBiasBf16 { bf16* Y; const float* bias;
    __device__ __forceinline__ void operator()(int row, int col, f32x4 a, f32x4 b) const {
        const f32x4 b0 = *(const f32x4*)(bias + col), b1 = *(const f32x4*)(bias + col + 16);
        u32x2 w; w.x = pk2(a[0] + b0[0], a[1] + b0[1]); w.y = pk2(a[2] + b0[2], a[3] + b0[3]); *(u32x2*)(Y + (size_t)row * D + col) = w;
        w.x = pk2(b[0] + b1[0], b[1] + b1[1]); w.y = pk2(b[2] + b1[2], b[3] + b1[3]); *(u32x2*)(Y + (size_t)row * D + col + 16) = w; } };

template <class Epi>
__global__ void __launch_bounds__(256) k_sgemm(const bf16* A, int lda, const bf16* Bt, int ldb, int M, int N, int K, Epi E) {
    const int wave = threadIdx.x >> 6, lane = threadIdx.x & 63, fr = lane & 15, fq = lane >> 4;
    const int ngrp = N / 128, nt = (M / 32) * ngrp;
    for (int t = blockIdx.x; t < nt; t += gridDim.x) {
        const int mt = t / ngrp, ng = t % ngrp; const int row0 = mt * 32, col0 = ng * 128 + wave * 32;
        f32x4 acc[2][2];
        wtile(A + (size_t)(row0 + fr) * lda + 8 * fq, A + (size_t)(row0 + 16 + fr) * lda + 8 * fq,
              Bt + (size_t)(col0 + fr) * ldb + 8 * fq, Bt + (size_t)(col0 + 16 + fr) * ldb + 8 * fq, K, acc);
#pragma unroll
        for (int m = 0; m < 2; ++m) E(row0 + m * 16 + fr, col0 + 4 * fq, acc[m][0], acc[m][1]);
    }
}
__device__ __forceinline__ void moe_prefix(const int* cnt, int* pre  ) {
    if (threadIdx.x == 0) { int s = 0; for (int e = 0; e < NE; ++e) { pre[e] = s; s += (cnt[e] + 255) >> 8; } pre[NE] = s; }
    __syncthreads();
}
__device__ __forceinline__ int moe_find(const int* pre, int t256) { int e = 0;
#pragma unroll 1
    for (int i = 0; i < NE; ++i) e = (pre[i + 1] <= t256) ? i + 1 : e;
    return e; }
template <int STAGE>
__global__ void __launch_bounds__(256) k_moe_gemm(Ptrs P, int layer) {
    __shared__ int pre[NE + 1];
    const int* cnt = (const int*)(P.ws + WS_CTL + CW_CNT) + layer * NE;
    moe_prefix(cnt, pre);
    const int wave = threadIdx.x >> 6, lane = threadIdx.x & 63, fr = lane & 15, fq = lane >> 4;
    constexpr int N = STAGE == 1 ? 2048 : 1024, ngrp = N / 128;
    const int nt = pre[NE] * 8 * ngrp;
    const int* toklist = WSP(int, WS_TOK);
    for (int t = blockIdx.x; t < nt; t += gridDim.x) {
        const int t256 = t / (8 * ngrp), rem = t % (8 * ngrp), sub = rem / ngrp, ng = rem % ngrp;
        const int e = moe_find(pre, t256), mt = t256 - pre[e];
        const int row0 = t256 * 256 + sub * 32, col0 = ng * 128 + wave * 32;
        f32x4 acc[2][2];
        if (STAGE == 1) {
            const int s0 = mt * 256 + sub * 32 + fr, s1 = s0 + 16; const int c = cnt[e];
            const int tk0 = s0 < c ? toklist[(size_t)e * NT + s0] : 0, tk1 = s1 < c ? toklist[(size_t)e * NT + s1] : 0;
            const bf16* F = WSP(bf16, WS_F); const bf16* Bt = WSP(bf16, WS_WGU) + ((size_t)layer * NE + e) * 2048 * 1024;
            wtile(F + (size_t)tk0 * D + 8 * fq, F + (size_t)tk1 * D + 8 * fq, Bt + (size_t)(col0 + fr) * D + 8 * fq, Bt + (size_t)(col0 + 16 + fr) * D + 8 * fq, D, acc);
            EpiSwiglu E{WSP(bf16, WS_ACT), P.in[30] + ((size_t)layer * NE + e) * 2048};
#pragma unroll
            for (int m = 0; m < 2; ++m) E(row0 + m * 16 + fr, col0 + 4 * fq, acc[m][0], acc[m][1]);
        } else {
            const bf16* A = WSP(bf16, WS_ACT); const bf16* Bt = WSP(bf16, WS_WDN) + ((size_t)layer * NE + e) * 1024 * 1024;
            wtile(A + (size_t)(row0 + fr) * D + 8 * fq, A + (size_t)(row0 + 16 + fr) * D + 8 * fq, Bt + (size_t)(col0 + fr) * D + 8 * fq, Bt + (size_t)(col0 + 16 + fr) * D + 8 * fq, D, acc);
            EpiBiasBf16 E{WSP(bf16, WS_Y), P.in[32] + ((size_t)layer * NE + e) * 1024};
#pragma unroll
            for (int m = 0; m < 2; ++m) E(row0 + m * 16 + fr, col0 + 4 * fq, acc[m][0], acc[m][1]);
        }
    }
}

__global__ void __launch_bounds__(256) k_e3(Ptrs P) {
    const int lane = threadIdx.x & 63; const int nw = gridDim.x * 4;
    const float* Z = WSP(float, WS_Z); bf16* QKVN = WSP(bf16, WS_QKVN); bf16* KM = WSP(bf16, WS_KM);
    const float* ropeM = WSP(float, WS_ROPEM);
    for (int r = blockIdx.x * 4 + (threadIdx.x >> 6); r < NT; r += nw) {
        const float* z = Z + (size_t)r * ZLD;
        const f32x4 qa = *(const f32x4*)(z + 1024 + 4 * lane);
        float ss = wave_sum(qa.x * qa.x + qa.y * qa.y + qa.z * qa.z + qa.w * qa.w);
        float rs = rsqrtf(ss * (1.f / 256.f) + 1e-6f);
        const f32x4 gq = *(const f32x4*)(P.in[16] + 4 * lane);
        u32x2 o; o.x = pk2(qa.x * rs * gq.x, qa.y * rs * gq.y); o.y = pk2(qa.z * rs * gq.z, qa.w * rs * gq.w);
        *(u32x2*)(QKVN + (size_t)r * 384 + 4 * lane) = o;
        const float k0 = z[1280 + 2 * lane], k1 = z[1280 + 2 * lane + 1];
        ss = wave_sum(k0 * k0 + k1 * k1); rs = rsqrtf(ss * (1.f / 128.f) + 1e-6f);
        *(unsigned*)(QKVN + (size_t)r * 384 + 256 + 2 * lane) = pk2(k0 * rs * P.in[18][2 * lane], k1 * rs * P.in[18][2 * lane + 1]);
        float kr = lane < 32 ? z[1408 + lane] : 0.f;
        ss = wave_sum(kr * kr); rs = rsqrtf(ss * (1.f / 32.f) + 1e-6f);
        kr = kr * rs * (lane < 32 ? P.in[21][32 + lane] : 0.f);
        int b, s; row_bs(r, b, s);
        const float other = __shfl_xor(kr, 16);
        float outv = kr;
        if (r < NL && lane < 32) { const int i = lane & 15; const float cs = ropeM[((size_t)s * 16 + i) * 2], sn = ropeM[((size_t)s * 16 + i) * 2 + 1];
            outv = lane < 16 ? kr * cs - other * sn : kr * cs + other * sn; }
        if (lane < 32) { const bf16 ov = (bf16)f2bf(outv);
#pragma unroll
            for (int h = 0; h < 8; ++h) KM[(((size_t)b * 8 + h) * TA + s) * 96 + 64 + lane] = ov; }
    }
}
__global__ void __launch_bounds__(256) k_e5(Ptrs P) {
    const int lane = threadIdx.x & 63; const int nw = gridDim.x * 4;
    const float* R = WSP(float, WS_QKVR); bf16* QM = WSP(bf16, WS_QM); bf16* KM = WSP(bf16, WS_KM); bf16* VM = WSP(bf16, WS_VM);
    const float* ropeM = WSP(float, WS_ROPEM);
    const float gqn = P.in[20][lane], gkn = P.in[20][64 + lane], gqr = lane < 32 ? P.in[21][lane] : 0.f;
    for (int r = blockIdx.x * 4 + (threadIdx.x >> 6); r < NT; r += nw) {
        const float* q = R + (size_t)r * 1792; int b, s; row_bs(r, b, s);
        for (int h = 0; h < 8; ++h) {
            const size_t qo = (((size_t)b * 8 + h) * TA + s) * 96, vo = (((size_t)b * 8 + h) * TA + s) * 64;
            const float qn = q[h * 96 + lane];
            float rs = rsqrtf(wave_sum(qn * qn) * (1.f / 64.f) + 1e-6f);
            QM[qo + lane] = (bf16)f2bf(qn * rs * gqn);
            float qr = lane < 32 ? q[h * 96 + 64 + lane] : 0.f;
            rs = rsqrtf(wave_sum(qr * qr) * (1.f / 32.f) + 1e-6f);
            qr = qr * rs * gqr;
            const float other = __shfl_xor(qr, 16); float outv = qr;
            if (r < NL && lane < 32) { const int i = lane & 15; const float cs = ropeM[((size_t)s * 16 + i) * 2], sn = ropeM[((size_t)s * 16 + i) * 2 + 1];
                outv = lane < 16 ? qr * cs - other * sn : qr * cs + other * sn; }
            if (lane < 32) QM[qo + 64 + lane] = (bf16)f2bf(outv);
            const float kn = q[768 + h * 128 + lane];
            rs = rsqrtf(wave_sum(kn * kn) * (1.f / 64.f) + 1e-6f);
            KM[qo + lane] = (bf16)f2bf(kn * rs * gkn);
            VM[vo + lane] = (bf16)f2bf(q[768 + h * 128 + 64 + lane]);
        }
    }
}
__global__ void __launch_bounds__(256) k_attn_mla_naive(Ptrs P) {
    const int bh = blockIdx.x / 17, qb = blockIdx.x % 17, b = bh >> 3, h = bh & 7;
    const int s = qb * 256 + threadIdx.x;
    const bf16* QM = WSP(bf16, WS_QM); const bf16* KM = WSP(bf16, WS_KM); const bf16* VM = WSP(bf16, WS_VM);
    float qr[96];
    { const u32x4* q = (const u32x4*)(QM + ((size_t)bh * TA + s) * 96); const float sc = 0.10206207261596577f;
#pragma unroll
      for (int i = 0; i < 12; ++i) { const u32x4 u = q[i]; qr[8 * i] = bflo(u.x) * sc; qr[8 * i + 1] = bfhi(u.x) * sc; qr[8 * i + 2] = bflo(u.y) * sc; qr[8 * i + 3] = bfhi(u.y) * sc;
          qr[8 * i + 4] = bflo(u.z) * sc; qr[8 * i + 5] = bfhi(u.z) * sc; qr[8 * i + 6] = bflo(u.w) * sc; qr[8 * i + 7] = bfhi(u.w) * sc; } }
    const int k0 = qb < 16 ? 0 : SEQ;
    float m = -1e30f, l = 0.f, o[64];
#pragma unroll
    for (int i = 0; i < 64; ++i) o[i] = 0.f;
    for (int j = k0; j < TA; ++j) {
        const u32x4* kr = (const u32x4*)(KM + ((size_t)bh * TA + j) * 96);
        float sc = 0.f;
#pragma unroll
        for (int i = 0; i < 12; ++i) { const u32x4 u = kr[i];
            sc += qr[8 * i] * bflo(u.x) + qr[8 * i + 1] * bfhi(u.x) + qr[8 * i + 2] * bflo(u.y) + qr[8 * i + 3] * bfhi(u.y) + qr[8 * i + 4] * bflo(u.z) + qr[8 * i + 5] * bfhi(u.z) + qr[8 * i + 6] * bflo(u.w) + qr[8 * i + 7] * bfhi(u.w); }
        const float mn = fmaxf(m, sc), al = __expf(m - mn), p = __expf(sc - mn);
        l = l * al + p; m = mn;
        const u32x4* vr = (const u32x4*)(VM + ((size_t)bh * TA + j) * 64);
#pragma unroll
        for (int i = 0; i < 8; ++i) { const u32x4 u = vr[i];
            o[8 * i] = o[8 * i] * al + p * bflo(u.x); o[8 * i + 1] = o[8 * i + 1] * al + p * bfhi(u.x); o[8 * i + 2] = o[8 * i + 2] * al + p * bflo(u.y); o[8 * i + 3] = o[8 * i + 3] * al + p * bfhi(u.y);
            o[8 * i + 4] = o[8 * i + 4] * al + p * bflo(u.z); o[8 * i + 5] = o[8 * i + 5] * al + p * bfhi(u.z); o[8 * i + 6] = o[8 * i + 6] * al + p * bflo(u.w); o[8 * i + 7] = o[8 * i + 7] * al + p * bfhi(u.w); }
    }
    const int row = s < SEQ ? b * SEQ + s : NL + b * CTX + (s - SEQ);
    bf16* y = WSP(bf16, WS_YM) + (size_t)row * D + 512 + h * 64; const float il = 1.f / l;
#pragma unroll
    for (int i = 0; i < 32; ++i) *(unsigned*)(y + 2 * i) = pk2(o[2 * i] * il, o[2 * i + 1] * il);
}

__global__ void __launch_bounds__(256) k_lru_xf(Ptrs P) {
    const size_t gid = (size_t)blockIdx.x * 256 + threadIdx.x; if (gid >= (size_t)2 * NT * 512) return;
    const int ch = (int)(gid & 511); const int row = (int)((gid >> 9) % NT); const int dir = (int)(gid / ((size_t)NT * 512));
    const float* Z = WSP(float, WS_Z);
    int t, T, base; if (row < NL) { t = row & 4095; T = SEQ; base = row - t; } else { t = (row - NL) & 255; T = CTX; base = row - t; }
    const float* cw = P.in[9] + (size_t)dir * 4 * 512 + ch;
    float acc = P.in[10][dir * 512 + ch];
#pragma unroll
    for (int j = 0; j < 4; ++j) { const int tt = dir == 0 ? t - 3 + j : t + 3 - j; if (tt >= 0 && tt < T) acc += cw[j * 512] * Z[(size_t)(base + tt) * ZLD + ch]; }
    WSP(float, WS_XF)[gid] = acc;
}
__global__ void __launch_bounds__(256) k_lru_ab(Ptrs P) {
    const size_t gid = (size_t)blockIdx.x * 256 + threadIdx.x; if (gid >= (size_t)2 * NT * 512) return;
    const int ch = (int)(gid & 511); const int dir = (int)(gid / ((size_t)NT * 512));
    const int blk = ch >> 6, d = ch & 63;
    const float* xf = WSP(float, WS_XF) + (gid - ch) + blk * 64;
    const float* wr = P.in[11] + ((size_t)dir * 8 + blk) * 64 * 64 + d; const float* wi = P.in[13] + ((size_t)dir * 8 + blk) * 64 * 64 + d;
    float ar = P.in[12][dir * 512 + ch], ai = P.in[14][dir * 512 + ch];
    for (int c = 0; c < 64; ++c) { const float x = xf[c]; ar += x * wr[c * 64]; ai += x * wi[c * 64]; }
    const float r = sigmoidf_(ar), gi = sigmoidf_(ai);
    const float lam = P.in[15][dir * 512 + ch];
    const float sp = log1pf(__expf(-lam));
    const float log_a = -8.f * r * sp; const float a = __expf(log_a);
    const float bb = sqrtf(-expm1f(2.f * log_a)) * (gi * xf[d]);
    WSP(float, WS_LA)[gid] = a; WSP(float, WS_LB)[gid] = bb;
}
__global__ void __launch_bounds__(256) k_lru_scan(Ptrs P) {
    const int gid = blockIdx.x * 256 + threadIdx.x; if (gid >= NB * 2 * 512) return;
    const int ch = gid & 511, dir = (gid >> 9) & 1, b = gid >> 10;
    const float* LA = WSP(float, WS_LA) + (size_t)dir * NT * 512 + ch; const float* LB = WSP(float, WS_LB) + (size_t)dir * NT * 512 + ch;
    float* LH = WSP(float, WS_LH) + (size_t)dir * NT * 512 + ch;
    float h = 0.f;
    for (int i = 0; i < CTX; ++i) { const int t = dir == 0 ? i : CTX - 1 - i; const size_t row = NL + b * CTX + t; h = LA[row * 512] * h + LB[row * 512]; LH[row * 512] = h; }
    for (int i = 0; i < SEQ; ++i) { const int t = dir == 0 ? i : SEQ - 1 - i; const size_t row = (size_t)b * SEQ + t; h = LA[row * 512] * h + LB[row * 512]; LH[row * 512] = h; }
}
__global__ void __launch_bounds__(256) k_lru_out(Ptrs P) {
    const size_t gid = (size_t)blockIdx.x * 256 + threadIdx.x; if (gid >= (size_t)NT * 512) return;
    const int ch = (int)(gid & 511); const size_t row = gid >> 9;
    const float* LH = WSP(float, WS_LH);
    const float h = LH[gid] + LH[(size_t)NT * 512 + gid];
    WSP(bf16, WS_YM)[row * D + ch] = (bf16)f2bf(h * gelu_tanh(WSP(float, WS_Z)[row * ZLD + 512 + ch]));
}

__global__ void __launch_bounds__(256) k_oprep(Ptrs P) {
    const int lane = threadIdx.x & 63; const int nw = gridDim.x * 4;
    const float* Z = WSP(float, WS_Z); bf16* QG = WSP(bf16, WS_QG); bf16* KG = WSP(bf16, WS_KG); bf16* VG = WSP(bf16, WS_VG);
    const float* ropeG = WSP(float, WS_ROPEG);
    const float gq = P.in[24][lane], gk = P.in[24][64 + lane];
    for (int r = blockIdx.x * 4 + (threadIdx.x >> 6); r < NT; r += nw) {
        const float* z = Z + (size_t)r * ZLD; int b, s; row_bs(r, b, s);
        float cs = 1.f, sn = 0.f;
        if (r < NL) { cs = ropeG[((size_t)s * 32 + (lane & 31)) * 2]; sn = ropeG[((size_t)s * 32 + (lane & 31)) * 2 + 1]; }
        if (r < NL) for (int h = 0; h < 16; ++h) {
            float q = z[h * 64 + lane]; const float rs = rsqrtf(wave_sum(q * q) * (1.f / 64.f) + 1e-6f); q = q * rs * gq;
            const float other = __shfl_xor(q, 32); const float o = lane < 32 ? q * cs - other * sn : q * cs + other * sn;
            QG[(((size_t)b * 16 + h) * SEQ + s) * 64 + lane] = (bf16)f2bf(o); }
        for (int h = 0; h < 4; ++h) {
            float k = z[1024 + h * 64 + lane]; const float rs = rsqrtf(wave_sum(k * k) * (1.f / 64.f) + 1e-6f); k = k * rs * gk;
            const float other = __shfl_xor(k, 32); const float o = lane < 32 ? k * cs - other * sn : k * cs + other * sn;
            KG[(((size_t)b * 4 + h) * TA + s) * 64 + lane] = (bf16)f2bf(o);
            VG[(((size_t)b * 4 + h) * TA + s) * 64 + lane] = (bf16)f2bf(z[1280 + h * 64 + lane]); }
    }
}
__global__ void __launch_bounds__(256) k_attn_gqa_naive(Ptrs P) {
    const int bh = blockIdx.x >> 4, qb = blockIdx.x & 15, b = bh >> 4, h = bh & 15, kh = h >> 2;
    const int t = qb * 256 + threadIdx.x;
    const bf16* QG = WSP(bf16, WS_QG); const bf16* KG = WSP(bf16, WS_KG) + ((size_t)b * 4 + kh) * TA * 64; const bf16* VG = WSP(bf16, WS_VG) + ((size_t)b * 4 + kh) * TA * 64;
    float qr[64];
    { const u32x4* q = (const u32x4*)(QG + ((size_t)bh * SEQ + t) * 64);
#pragma unroll
      for (int i = 0; i < 8; ++i) { const u32x4 u = q[i]; qr[8 * i] = bflo(u.x) * 0.125f; qr[8 * i + 1] = bfhi(u.x) * 0.125f; qr[8 * i + 2] = bflo(u.y) * 0.125f; qr[8 * i + 3] = bfhi(u.y) * 0.125f;
          qr[8 * i + 4] = bflo(u.z) * 0.125f; qr[8 * i + 5] = bfhi(u.z) * 0.125f; qr[8 * i + 6] = bflo(u.w) * 0.125f; qr[8 * i + 7] = bfhi(u.w) * 0.125f; } }
    float m = -1e30f, l = 0.f, o[64];
#pragma unroll
    for (int i = 0; i < 64; ++i) o[i] = 0.f;
    for (int jj = 0; jj < 257 + CTX; ++jj) {
        int j; bool valid = true;
        if (jj < 257) { j = t - 128 + jj; valid = (j >= 0 && j < SEQ); if (!valid) j = 0; } else j = SEQ + (jj - 257);
        const u32x4* kr = (const u32x4*)(KG + (size_t)j * 64);
        float sc = 0.f;
#pragma unroll
        for (int i = 0; i < 8; ++i) { const u32x4 u = kr[i];
            sc += qr[8 * i] * bflo(u.x) + qr[8 * i + 1] * bfhi(u.x) + qr[8 * i + 2] * bflo(u.y) + qr[8 * i + 3] * bfhi(u.y) + qr[8 * i + 4] * bflo(u.z) + qr[8 * i + 5] * bfhi(u.z) + qr[8 * i + 6] * bflo(u.w) + qr[8 * i + 7] * bfhi(u.w); }
        if (!valid) sc = -1e30f;
        const float mn = fmaxf(m, sc), al = __expf(m - mn), p = valid ? __expf(sc - mn) : 0.f;
        l = l * al + p; m = mn;
        const u32x4* vr = (const u32x4*)(VG + (size_t)j * 64);
#pragma unroll
        for (int i = 0; i < 8; ++i) { const u32x4 u = vr[i];
            o[8 * i] = o[8 * i] * al + p * bflo(u.x); o[8 * i + 1] = o[8 * i + 1] * al + p * bfhi(u.x); o[8 * i + 2] = o[8 * i + 2] * al + p * bflo(u.y); o[8 * i + 3] = o[8 * i + 3] * al + p * bfhi(u.y);
            o[8 * i + 4] = o[8 * i + 4] * al + p * bflo(u.z); o[8 * i + 5] = o[8 * i + 5] * al + p * bfhi(u.z); o[8 * i + 6] = o[8 * i + 6] * al + p * bflo(u.w); o[8 * i + 7] = o[8 * i + 7] * al + p * bfhi(u.w); }
    }
    { const float sk = P.in[25][h]; const float mn = fmaxf(m, sk), al = __expf(m - mn); l = l * al + __expf(sk - mn);
      const float il = al / l;
      bf16* y = WSP(bf16, WS_YM) + ((size_t)b * SEQ + t) * D + h * 64;
#pragma unroll
      for (int i = 0; i < 32; ++i) *(unsigned*)(y + 2 * i) = pk2(o[2 * i] * il, o[2 * i + 1] * il); }
}

__global__ void __launch_bounds__(256) k_router(Ptrs P, int layer, int nrows) {
    const int lane = threadIdx.x & 63; const int nw = gridDim.x * 4;
    const float* MOD = WSP(float, WS_MOD); const float* X1 = WSP(float, WS_X1);
    const float* wrt = WSP(float, WS_WRT) + (size_t)layer * 32 * 1024;
    int* cnt = (int*)(P.ws + WS_CTL + CW_CNT) + layer * NE;
    for (int r = blockIdx.x * 4 + (threadIdx.x >> 6); r < nrows; r += nw) {
        RowV v = load_row(X1 + (size_t)r * D, lane);
        const float* m = MOD + (size_t)(layer * 5 + mod_row(r)) * 6144;
        norm_mod(v, P.in[7] + layer * D, m + 4 * 1024, m + 3 * 1024, lane);
        store_row_bf16(WSP(bf16, WS_F) + (size_t)r * D, v, lane);
        float mylg = -3.4e38f;
#pragma unroll 4
        for (int e = 0; e < NE; ++e) { const f32x4* w = (const f32x4*)(wrt + e * 1024) + lane; float s = 0.f;
#pragma unroll
            for (int j = 0; j < 4; ++j) { const f32x4 wv = w[64 * j]; s += v.v[j].x * wv.x + v.v[j].y * wv.y + v.v[j].z * wv.z + v.v[j].w * wv.w; }
            s = wave_sum(s) + P.in[28][layer * NE + e]; mylg = (lane == e) ? s : mylg; }
        int te[4]; float tv[4];
#pragma unroll
        for (int k = 0; k < 4; ++k) { float bv = mylg; int bi = lane;
#pragma unroll
            for (int o = 1; o < 64; o <<= 1) { const float ov = __shfl_xor(bv, o); const int oi = __shfl_xor(bi, o); const bool take = ov > bv || (ov == bv && oi < bi); bv = take ? ov : bv; bi = take ? oi : bi; }
            te[k] = bi; tv[k] = bv; mylg = (lane == bi) ? -3.4e38f : mylg; }
        const float e1 = __expf(tv[1] - tv[0]), e2 = __expf(tv[2] - tv[0]), e3 = __expf(tv[3] - tv[0]); const float inv = 1.f / (1.f + e1 + e2 + e3);
        const float gate[4] = {inv, e1 * inv, e2 * inv, e3 * inv};
        if (lane < 4) { const int e = lane == 0 ? te[0] : lane == 1 ? te[1] : lane == 2 ? te[2] : te[3]; const float g = lane == 0 ? gate[0] : lane == 1 ? gate[1] : lane == 2 ? gate[2] : gate[3];
            const int slot = atomicAdd(&cnt[e], 1);
            WSP(int, WS_TOK)[(size_t)e * NT + slot] = r;
            WSP(int, WS_PE)[r * 4 + lane] = e; WSP(int, WS_PS)[r * 4 + lane] = slot; WSP(float, WS_PG)[r * 4 + lane] = g; }
    }
}
template <int MODE>
__global__ void __launch_bounds__(256) k_combine(Ptrs P, int layer, int nrows) {
    __shared__ int pre[NE + 1];
    const int* cnt = (const int*)(P.ws + WS_CTL + CW_CNT) + layer * NE;
    moe_prefix(cnt, pre);
    const int lane = threadIdx.x & 63; const int nw = gridDim.x * 4;
    const float* MOD = WSP(float, WS_MOD); const float* X1 = WSP(float, WS_X1); const bf16* Y = WSP(bf16, WS_Y);
    for (int r = blockIdx.x * 4 + (threadIdx.x >> 6); r < nrows; r += nw) {
        RowV v = load_row(X1 + (size_t)r * D, lane);
        const float* g2 = MOD + (size_t)(layer * 5 + mod_row(r)) * 6144 + 5 * 1024;
        RowV acc;
#pragma unroll
        for (int j = 0; j < 4; ++j) acc.v[j] = (f32x4){0.f, 0.f, 0.f, 0.f};
#pragma unroll
        for (int k = 0; k < 4; ++k) { const int e = WSP(int, WS_PE)[r * 4 + k], slot = WSP(int, WS_PS)[r * 4 + k]; const float g = WSP(float, WS_PG)[r * 4 + k];
            const u32x2* y = (const u32x2*)(Y + ((size_t)pre[e] * 256 + slot) * D) + lane;
#pragma unroll
            for (int j = 0; j < 4; ++j) { const u32x2 u = y[64 * j]; acc.v[j] += (f32x4){bflo(u.x), bfhi(u.x), bflo(u.y), bfhi(u.y)} * g; } }
#pragma unroll
        for (int j = 0; j < 4; ++j) v.v[j] += ((const f32x4*)g2)[lane + 64 * j] * acc.v[j];
        if (MODE == 0) {
            f32x4* xo = (f32x4*)(WSP(float, WS_X2) + (size_t)r * D) + lane;
#pragma unroll
            for (int j = 0; j < 4; ++j) xo[64 * j] = v.v[j];
            const float* m = MOD + (size_t)(1 * 5 + mod_row(r)) * 6144;
            norm_mod(v, P.in[6] + D, m + 1024, m, lane);
            store_row_bf16(WSP(bf16, WS_HN) + (size_t)r * D, v, lane);
        } else {
            f32x4* xo = (f32x4*)(P.out + (size_t)r * D) + lane;
#pragma unroll
            for (int j = 0; j < 4; ++j) xo[64 * j] = v.v[j];
        }
    }
}

static void launch_transpose(hipStream_t st, const float* W, bf16* WT, int K, int N, int ldw, int ldt, int row_off, int col_off, int map, long wstride, long tstride, int count) {
    TJob j; j.W = W; j.WT = WT; j.K = K; j.N = N; j.ldw = ldw; j.ldt = ldt; j.row_off = row_off; j.col_off = col_off; j.map = map; j.wstride = wstride; j.tstride = tstride; j.count = count;
    long items = (long)(K / 64) * (N / 32) * count; int grid = (int)((items + 3) / 4); if (grid > 8192) grid = 8192;
    hipLaunchKernelGGL(k_transpose, dim3(grid), dim3(256), 0, st, j);
}
extern "C" void kernel_launch(void* const* d_in, const int* in_sizes, int n_in, void* d_out, int out_size, void* d_ws, size_t ws_size, hipStream_t stream) {
    if (n_in != 33 || ws_size < WS_END) { fprintf(stderr, "kernel_launch: unexpected n_in %d or ws_size %zu < %zu\n", n_in, ws_size, (size_t)WS_END); return; }
    Ptrs P{};
    for (int i = 0; i < 33; ++i) P.in[i] = (const float*)d_in[i];
    P.out = (float*)d_out; P.ws = (unsigned char*)d_ws;
    unsigned char* ws = P.ws;
    hipMemsetAsync(ws + WS_CTL, 0, CTL_BYTES, stream);
    hipLaunchKernelGGL(k_mod, dim3(48), dim3(256), 0, stream, P);
    hipLaunchKernelGGL(k_rope, dim3((4096 * 48 + 255) / 256), dim3(256), 0, stream, P);
    hipLaunchKernelGGL(k_router_t, dim3(256), dim3(256), 0, stream, P);
    hipLaunchKernelGGL(k_lru_w, dim3(512), dim3(256), 0, stream, P);
    hipLaunchKernelGGL(k_zero16, dim3(512), dim3(256), 0, stream, (u32x4*)(ws + WS_WIN), (size_t)1536 * 1024 * 2 / 16);
    hipLaunchKernelGGL(k_zero16, dim3(512), dim3(256), 0, stream, (u32x4*)(ws + WS_WQKVB), (size_t)1792 * 384 * 2 / 16);
    launch_transpose(stream, P.in[8], (bf16*)(ws + WS_WIN), 1024, 1440, 1440, 1024, 0, 0, 0, 0, 0, 1);
    launch_transpose(stream, P.in[17], (bf16*)(ws + WS_WQKVB), 256, 768, 768, 384, 0, 0, 0, 0, 0, 1);
    launch_transpose(stream, P.in[19], (bf16*)(ws + WS_WQKVB), 128, 1024, 1024, 384, 768, 256, 0, 0, 0, 1);
    launch_transpose(stream, P.in[22], (bf16*)(ws + WS_WOE), 1024, 1024, 1024, 1024, 0, 0, 0, 0, 0, 1);
    launch_transpose(stream, P.in[23], (bf16*)(ws + WS_WQO), 1024, 1536, 1536, 1024, 0, 0, 0, 0, 0, 1);
    launch_transpose(stream, P.in[26], (bf16*)(ws + WS_WOO), 1024, 1024, 1024, 1024, 0, 0, 0, 0, 0, 1);
    launch_transpose(stream, P.in[29], (bf16*)(ws + WS_WGU), 1024, 2048, 2048, 1024, 0, 0, 1, (long)1024 * 2048, (long)2048 * 1024, 64);
    launch_transpose(stream, P.in[31], (bf16*)(ws + WS_WDN), 1024, 1024, 1024, 1024, 0, 0, 0, (long)1024 * 1024, (long)1024 * 1024, 64);
    const float* MOD = (const float*)(ws + WS_MOD);
    const int RG = 2048;
    hipLaunchKernelGGL(k_norm0, dim3(RG), dim3(256), 0, stream, P);
    hipLaunchKernelGGL(k_sgemm<EpiF32>, dim3(4096), dim3(256), 0, stream, (const bf16*)(ws + WS_HN), 1024, (const bf16*)(ws + WS_WIN), 1024, NT, 1536, 1024, EpiF32{(float*)(ws + WS_Z), ZLD, EVEN_IN});
    hipLaunchKernelGGL(k_e3, dim3(RG), dim3(256), 0, stream, P);
    hipLaunchKernelGGL(k_sgemm<EpiF32>, dim3(4096), dim3(256), 0, stream, (const bf16*)(ws + WS_QKVN), 384, (const bf16*)(ws + WS_WQKVB), 384, NT, 1792, 384, EpiF32{(float*)(ws + WS_QKVR), 1792, 1792});
    hipLaunchKernelGGL(k_e5, dim3(RG), dim3(256), 0, stream, P);
    { const size_t n = (size_t)2 * NT * 512; const int g = (int)((n + 255) / 256);
      hipLaunchKernelGGL(k_lru_xf, dim3(g), dim3(256), 0, stream, P);
      hipLaunchKernelGGL(k_lru_ab, dim3(g), dim3(256), 0, stream, P);
      hipLaunchKernelGGL(k_lru_scan, dim3(16), dim3(256), 0, stream, P);
      hipLaunchKernelGGL(k_lru_out, dim3(g / 2), dim3(256), 0, stream, P); }
    hipLaunchKernelGGL(k_attn_mla_naive, dim3(NB * 8 * 17), dim3(256), 0, stream, P);
    hipLaunchKernelGGL(k_sgemm<EpiResid>, dim3(4096), dim3(256), 0, stream, (const bf16*)(ws + WS_YM), 1024, (const bf16*)(ws + WS_WOE), 1024, NT, 1024, 1024,
                       EpiResid{P.in[0], P.in[2], (float*)(ws + WS_X1), MOD + 2 * 1024});
    hipLaunchKernelGGL(k_router, dim3(RG), dim3(256), 0, stream, P, 0, NT);
    hipLaunchKernelGGL(k_moe_gemm<1>, dim3(8192), dim3(256), 0, stream, P, 0);
    hipLaunchKernelGGL(k_moe_gemm<2>, dim3(8192), dim3(256), 0, stream, P, 0);
    hipLaunchKernelGGL(k_combine<0>, dim3(RG), dim3(256), 0, stream, P, 0, NT);
    hipLaunchKernelGGL(k_sgemm<EpiF32>, dim3(4096), dim3(256), 0, stream, (const bf16*)(ws + WS_HN), 1024, (const bf16*)(ws + WS_WQO), 1024, NT, 1536, 1024, EpiF32{(float*)(ws + WS_Z), ZLD, 1536});
    hipLaunchKernelGGL(k_oprep, dim3(RG), dim3(256), 0, stream, P);
    hipLaunchKernelGGL(k_attn_gqa_naive, dim3(NB * 16 * 16), dim3(256), 0, stream, P);
    hipLaunchKernelGGL(k_sgemm<EpiResid>, dim3(4096), dim3(256), 0, stream, (const bf16*)(ws + WS_YM), 1024, (const bf16*)(ws + WS_WOO), 1024, NL, 1024, 1024,
                       EpiResid{(const float*)(ws + WS_X2), (const float*)(ws + WS_X2) + (size_t)NL * D, (float*)(ws + WS_X1), MOD + 5 * 6144 + 2 * 1024});
    hipLaunchKernelGGL(k_router, dim3(RG), dim3(256), 0, stream, P, 1, NL);
    hipLaunchKernelGGL(k_moe_gemm<1>, dim3(8192), dim3(256), 0, stream, P, 1);
    hipLaunchKernelGGL(k_moe_gemm<2>, dim3(8192), dim3(256), 0, stream, P, 1);
    hipLaunchKernelGGL(k_combine<1>, dim3(RG), dim3(256), 0, stream, P, 1, NL);
}
```

```cpp
#include <hip/hip_runtime.h>
#include <stdint.h>
#include <stdio.h>

typedef unsigned short bf16;
typedef short bf16x8 __attribute__((ext_vector_type(8)));
typedef float f32x4 __attribute__((ext_vector_type(4)));
typedef unsigned u32x2 __attribute__((ext_vector_type(2)));
typedef unsigned u32x4 __attribute__((ext_vector_type(4)));

constexpr int D = 1024, NB = 4, SEQ = 4096, CTX = 256;
constexpr int NL = NB * SEQ, NC = NB * CTX, NT = NL + NC;
constexpr int TA = SEQ + CTX;
constexpr int NE = 32, TOPK = 4;
constexpr int EVEN_IN = 1440, ZLD = 1536;
constexpr int MAXT256 = 304;
constexpr int ACT_ROWS = MAXT256 * 256;

constexpr size_t al256(size_t x) { return (x + 255) & ~(size_t)255; }
constexpr size_t WS_CTL = 0, CTL_BYTES = 1u << 20;
constexpr size_t CW_CNT = 65536;
constexpr size_t WS_MOD = WS_CTL + CTL_BYTES;
constexpr size_t WS_ROPEM = al256(WS_MOD + 2 * 5 * 6144 * 4);
constexpr size_t WS_ROPEG = al256(WS_ROPEM + 4096 * 16 * 2 * 4);
constexpr size_t WS_WRT = al256(WS_ROPEG + 4096 * 32 * 2 * 4);
constexpr size_t WS_WRI = al256(WS_WRT + 2 * 32 * 1024 * 4);
constexpr size_t WS_WIN = al256(WS_WRI + 2 * 8 * 128 * 64 * 2);
constexpr size_t WS_WQKVB = al256(WS_WIN + 1536 * 1024 * 2);
constexpr size_t WS_WOE = al256(WS_WQKVB + 1792 * 384 * 2);
constexpr size_t WS_WQO = al256(WS_WOE + 1024 * 1024 * 2);
constexpr size_t WS_WOO = al256(WS_WQO + 1536 * 1024 * 2);
constexpr size_t WS_WGU = al256(WS_WOO + 1024 * 1024 * 2);
constexpr size_t WS_WDN = al256(WS_WGU + (size_t)2 * 32 * 2048 * 1024 * 2);
constexpr size_t WS_HN = al256(WS_WDN + (size_t)2 * 32 * 1024 * 1024 * 2);
constexpr size_t WS_Z = al256(WS_HN + (size_t)NT * D * 2);
constexpr size_t WS_QKVN = al256(WS_Z + (size_t)NT * ZLD * 4);
constexpr size_t WS_QKVR = al256(WS_QKVN + (size_t)NT * 384 * 2);
constexpr size_t WS_QM = al256(WS_QKVR + (size_t)NT * 1792 * 4);
constexpr size_t WS_KM = al256(WS_QM + (size_t)NB * 8 * TA * 96 * 2);
constexpr size_t WS_VM = al256(WS_KM + (size_t)NB * 8 * TA * 96 * 2);
constexpr size_t WS_QG = al256(WS_VM + (size_t)NB * 8 * TA * 64 * 2);
constexpr size_t WS_KG = al256(WS_QG + (size_t)NB * 16 * SEQ * 64 * 2);
constexpr size_t WS_VG = al256(WS_KG + (size_t)NB * 4 * TA * 64 * 2);
constexpr size_t WS_YM = al256(WS_VG + (size_t)NB * 4 * TA * 64 * 2);
constexpr size_t WS_X1 = al256(WS_YM + (size_t)NT * D * 2);
constexpr size_t WS_X2 = al256(WS_X1 + (size_t)NT * D * 4);
constexpr size_t WS_F = al256(WS_X2 + (size_t)NT * D * 4);
constexpr size_t WS_LA = al256(WS_F + (size_t)NT * D * 2);
constexpr size_t WS_LB = al256(WS_LA + (size_t)2 * NT * 512 * 4);
constexpr size_t WS_LH = al256(WS_LB + (size_t)2 * NT * 512 * 4);
constexpr size_t WS_XF = al256(WS_LH + (size_t)2 * NT * 512 * 4);
constexpr size_t WS_PE = al256(WS_XF + (size_t)2 * NT * 512 * 4);
constexpr size_t WS_PS = al256(WS_PE + (size_t)NT * 4 * 4);
constexpr size_t WS_PG = al256(WS_PS + (size_t)NT * 4 * 4);
constexpr size_t WS_TOK = al256(WS_PG + (size_t)NT * 4 * 4);
constexpr size_t WS_ACT = al256(WS_TOK + (size_t)NE * NT * 4);
constexpr size_t WS_Y = al256(WS_ACT + (size_t)ACT_ROWS * D * 2);
constexpr size_t WS_END = al256(WS_Y + (size_t)ACT_ROWS * D * 2);

__device__ __forceinline__ unsigned f2bf(float f) { unsigned u = __float_as_uint(f); u += 0x7FFFu + ((u >> 16) & 1u); return u >> 16; }
__device__ __forceinline__ unsigned pk2(float a, float b) { return f2bf(a) | (f2bf(b) << 16); }
__device__ __forceinline__ float bf2f(unsigned b) { return __uint_as_float(b << 16); }
__device__ __forceinline__ float bflo(unsigned u) { return __uint_as_float(u << 16); }
__device__ __forceinline__ float bfhi(unsigned u) { return __uint_as_float(u & 0xffff0000u); }
__device__ __forceinline__ float wave_sum(float v) {
#pragma unroll
    for (int o = 1; o < 64; o <<= 1) v += __shfl_xor(v, o);
    return v;
}
__device__ __forceinline__ float sigmoidf_(float x) { return 1.f / (1.f + __expf(-x)); }
__device__ __forceinline__ float gelu_tanh(float x) { const float u = 0.7978845608028654f * (x + 0.044715f * x * x * x); return 0.5f * x * (1.f + tanhf(u)); }
__device__ __forceinline__ int mod_row(int r) { return r < NL ? (r >> 12) : 4; }
__device__ __forceinline__ void row_bs(int r, int& b, int& s) { if (r < NL) { b = r >> 12; s = r & 4095; } else { const int rc = r - NL; b = rc >> 8; s = SEQ + (rc & 255); } }


struct Ptrs {
    const float* in[33];
    float* out;
    unsigned char* ws;
};
#define WSP(T, off) ((T*)(P.ws + (off)))
#define LAS __attribute__((address_space(3)))

#define XB_TMO      128
#define XB_XCNT(j)  (256  + 64 * (j))
#define XB_XSUB(j)  (1280 + 64 * (j))
#define XB_XGEN(j)  (2304 + 64 * (j))
#define XB_TOP      3328
#define XB_TOPGEN   3392
#define XCD_BAR_WORDS 3456
#define XB_SPIN_CAP (1u << 18)
__device__ __forceinline__ unsigned xb_ld(unsigned* p)              { return __hip_atomic_load(p, __ATOMIC_RELAXED, __HIP_MEMORY_SCOPE_AGENT); }
__device__ __forceinline__ unsigned xb_add(unsigned* p, unsigned v) { return __hip_atomic_fetch_add(p, v, __ATOMIC_RELAXED, __HIP_MEMORY_SCOPE_AGENT); }
__device__ __forceinline__ unsigned xb_xcc_id() { return (unsigned)__builtin_amdgcn_s_getreg((3 << 11) | 20) & 0xFu; }
#define XB_SPIN(cond, bar) do { unsigned _sp = 0; while (cond) { __builtin_amdgcn_s_sleep(1); \
    if ((++_sp & 255u) == 0u) { if (xb_ld(&(bar)[XB_TMO])) break; if (_sp > XB_SPIN_CAP) { atomicAdd(&(bar)[XB_TMO], 1u); break; } } } } while (0)
struct XcdBarrier { unsigned* bar; unsigned x; volatile LAS unsigned* st; };
__device__ __forceinline__ XcdBarrier xcd_barrier_post(unsigned* bar, volatile LAS unsigned* st) {
    XcdBarrier b; b.bar = bar; b.x = xb_xcc_id(); b.st = st;
    if (threadIdx.x == 0) (void)xb_add(&bar[XB_XCNT(b.x)], 1u);
    return b;
}
__device__ __forceinline__ void xcd_barrier_complete(unsigned* bar, unsigned x, unsigned& nloc, unsigned& nx) {
    const unsigned G = gridDim.x * gridDim.y * gridDim.z;
    unsigned sum, cnt, mine, sp = 0u;
    for (;;) {
        sum = 0u; cnt = 0u; mine = 0u;
#pragma unroll
        for (unsigned j = 0; j < 16; ++j) { const unsigned c = xb_ld(&bar[XB_XCNT(j)]); sum += c; cnt += (c > 0u) ? 1u : 0u; mine = (j == x) ? c : mine; }
        if (sum == G) break;
        __builtin_amdgcn_s_sleep(1);
        if ((++sp & 255u) == 0u) { if (xb_ld(&bar[XB_TMO])) break; if (sp > XB_SPIN_CAP) { atomicAdd(&bar[XB_TMO], 1u); break; } }
    }
    nloc = mine > 0u ? mine : 1u; nx = cnt > 0u ? cnt : 1u;
}
__device__ __forceinline__ void xcd_barrier(const XcdBarrier& b) {
    asm volatile("s_waitcnt vmcnt(0)" ::: "memory");
    __syncthreads();
    if (threadIdx.x == 0) {
        unsigned* bar = b.bar;
        __builtin_amdgcn_s_waitcnt(0);
        unsigned nloc = b.st[0], nx = b.st[1];
        if (nloc == 0u) { xcd_barrier_complete(bar, b.x, nloc, nx); b.st[0] = nloc; b.st[1] = nx; }
        const unsigned old = xb_add(&bar[XB_XSUB(b.x)], 1u);
        const unsigned gen = old / nloc;
        if (old + 1u == (gen + 1u) * nloc) {
            __builtin_amdgcn_fence(__ATOMIC_RELEASE, "agent");
            asm volatile("s_waitcnt vmcnt(0)" ::: "memory");
            const unsigned og = xb_add(&bar[XB_TOP], 1u);
            const unsigned tg = og / nx;
            if (og + 1u == (tg + 1u) * nx) xb_add(&bar[XB_TOPGEN], 1u);
            else XB_SPIN(xb_ld(&bar[XB_TOPGEN]) == tg, bar);
            __builtin_amdgcn_fence(__ATOMIC_ACQUIRE, "agent");
            xb_add(&bar[XB_XGEN(b.x)], 1u);
            asm volatile("s_waitcnt vmcnt(0)" ::: "memory");
        } else {
            XB_SPIN(xb_ld(&bar[XB_XGEN(b.x)]) == gen, bar);
            __builtin_amdgcn_fence(__ATOMIC_ACQUIRE, "agent");
            asm volatile("s_waitcnt vmcnt(0)" ::: "memory");
        }
    }
    __syncthreads();
}

constexpr int NTHR = 512, NWAVES = 8;
constexpr int LDS_RING = 131072;
constexpr int LDS_MISC = LDS_RING;
constexpr int LDS_BYTES = LDS_RING + 4096;
struct Fr {
    Ptrs P; unsigned char* lds;
    int tid, lane, wave, gw, ngw, nblk, blk; size_t gtid, gsz;
};

__device__ __forceinline__ void transpose_item(const float* W, int ldw, bf16* WT, int ldt, int k0, int n0, int row_off, int col_off, int map, float* scr, int lane) {
#pragma unroll 8
    for (int i = 0; i < 32; ++i) { const int kk = 2 * i + (lane >> 5); scr[kk * 33 + (lane & 31)] = W[(size_t)(k0 + kk) * ldw + n0 + (lane & 31)]; }
    __builtin_amdgcn_s_waitcnt(0xc07f); asm volatile("" ::: "memory");
    const int c = lane & 7;
#pragma unroll
    for (int j = 0; j < 4; ++j) { const int n = (lane >> 3) + 8 * j; const float* s = scr + (8 * c) * 33 + n;
        u32x4 o; o.x = pk2(s[0 * 33], s[1 * 33]); o.y = pk2(s[2 * 33], s[3 * 33]); o.z = pk2(s[4 * 33], s[5 * 33]); o.w = pk2(s[6 * 33], s[7 * 33]);
        int nn = n0 + n;
        if (map == 1) { const int up = nn >= 1024, jj = nn & 1023; nn = (jj >> 4) * 32 + up * 16 + (jj & 15); }
        *(u32x4*)(WT + (size_t)(row_off + nn) * ldt + col_off + k0 + 8 * c) = o; }
    __builtin_amdgcn_s_waitcnt(0xc07f); asm volatile("" ::: "memory");
}
struct TJob { const float* W; bf16* WT; int K, N, ldw, ldt, row_off, col_off, map; long wstride, tstride; int count; };
constexpr int NJOBS = 8;
__device__ __forceinline__ TJob get_job(const Ptrs& P, int j) {
    TJob t; t.row_off = 0; t.col_off = 0; t.map = 0; t.wstride = 0; t.tstride = 0; t.count = 1;
    switch (j) {
    case 0: t.W = P.in[29]; t.WT = WSP(bf16, WS_WGU); t.K = 1024; t.N = 2048; t.ldw = 2048; t.ldt = 1024; t.map = 1; t.wstride = (long)1024 * 2048; t.tstride = (long)2048 * 1024; t.count = 64; break;
    case 1: t.W = P.in[31]; t.WT = WSP(bf16, WS_WDN); t.K = 1024; t.N = 1024; t.ldw = 1024; t.ldt = 1024; t.wstride = (long)1024 * 1024; t.tstride = (long)1024 * 1024; t.count = 64; break;
    case 2: t.W = P.in[8]; t.WT = WSP(bf16, WS_WIN); t.K = 1024; t.N = 1440; t.ldw = 1440; t.ldt = 1024; break;
    case 3: t.W = P.in[17]; t.WT = WSP(bf16, WS_WQKVB); t.K = 256; t.N = 768; t.ldw = 768; t.ldt = 384; break;
    case 4: t.W = P.in[19]; t.WT = WSP(bf16, WS_WQKVB); t.K = 128; t.N = 1024; t.ldw = 1024; t.ldt = 384; t.row_off = 768; t.col_off = 256; break;
    case 5: t.W = P.in[22]; t.WT = WSP(bf16, WS_WOE); t.K = 1024; t.N = 1024; t.ldw = 1024; t.ldt = 1024; break;
    case 6: t.W = P.in[23]; t.WT = WSP(bf16, WS_WQO); t.K = 1024; t.N = 1536; t.ldw = 1536; t.ldt = 1024; break;
    default: t.W = P.in[26]; t.WT = WSP(bf16, WS_WOO); t.K = 1024; t.N = 1024; t.ldw = 1024; t.ldt = 1024; break;
    }
    return t;
}
__device__ __forceinline__ void ph_prologue(Fr& F) {
    const Ptrs& P = F.P;
    if (F.blk < 24) {
        float* sl = (float*)(F.lds + 8 * 64 * 33 * 4);
        const float* c = P.in[1]; const float* cc = P.in[3];
        for (int i = F.tid; i < 5 * 1024; i += NTHR) { const int r = i >> 10, k = i & 1023; const float v = r < 4 ? c[r * 1024 + k] : cc[k]; sl[i] = v / (1.f + __expf(-v)); }
        __syncthreads();
        const int gid = F.blk * NTHR + F.tid, l = gid / 6144, j = gid % 6144;
        const float* w = P.in[4] + (size_t)l * 1024 * 6144 + j;
        float acc[5] = {0.f, 0.f, 0.f, 0.f, 0.f};
#pragma unroll 8
        for (int k = 0; k < 1024; ++k) { const float wv = w[(size_t)k * 6144];
#pragma unroll
            for (int r = 0; r < 5; ++r) acc[r] += sl[r * 1024 + k] * wv; }
        float* MOD = WSP(float, WS_MOD);
        const float bm = P.in[5][l * 6144 + j];
#pragma unroll
        for (int r = 0; r < 5; ++r) MOD[(l * 5 + r) * 6144 + j] = acc[r] + bm;
    }
    for (size_t gid = F.gtid; gid < 4096 * 48; gid += F.gsz) {
        const int s = (int)(gid / 48), i = (int)(gid % 48); const int row = s >> 6, col = s & 63;
        if (i < 16) { const int fi = i & 7; const float fr = powf(10000.f, -(float)fi / 8.f); const float ang = (float)(i < 8 ? row : col) * fr;
            float* T = WSP(float, WS_ROPEM) + ((size_t)s * 16 + i) * 2; T[0] = cosf(ang); T[1] = sinf(ang); }
        else { const int ii = i - 16, fi = ii & 15; const float fr = powf(10000.f, -(float)fi / 16.f); const float ang = (float)(ii < 16 ? row : col) * fr;
            float* T = WSP(float, WS_ROPEG) + ((size_t)s * 32 + ii) * 2; T[0] = cosf(ang); T[1] = sinf(ang); }
    }
    for (size_t gid = F.gtid; gid < 2 * 32 * 1024; gid += F.gsz) { const int l = (int)(gid >> 15), e = (int)(gid >> 10) & 31, k = (int)gid & 1023;
        WSP(float, WS_WRT)[gid] = P.in[27][((size_t)l * 1024 + k) * 32 + e]; }
    for (size_t gid = F.gtid; gid < 2 * 8 * 128 * 64; gid += F.gsz) { const int c = (int)gid & 63, o = (int)(gid >> 6) & 127, blk = (int)(gid >> 13) & 7, dir = (int)(gid >> 16);
        const float* src = o < 64 ? P.in[11] : P.in[13];
        WSP(bf16, WS_WRI)[gid] = (bf16)f2bf(src[(((size_t)dir * 8 + blk) * 64 + c) * 64 + (o & 63)]); }
    { u32x4* z = (u32x4*)(WSP(bf16, WS_WIN) + (size_t)1440 * 1024); for (size_t i = F.gtid; i < (size_t)96 * 1024 * 2 / 16; i += F.gsz) z[i] = (u32x4){0u, 0u, 0u, 0u};
      bf16* q = WSP(bf16, WS_WQKVB);
      for (size_t i = F.gtid; i < (size_t)768 * 16; i += F.gsz) { const int r = (int)(i >> 4), c = (int)(i & 15); *(u32x4*)(q + (size_t)r * 384 + 256 + c * 8) = (u32x4){0u, 0u, 0u, 0u}; }
      for (size_t i = F.gtid; i < (size_t)1024 * 32; i += F.gsz) { const int r = (int)(i >> 5), c = (int)(i & 31); *(u32x4*)(q + (size_t)(768 + r) * 384 + c * 8) = (u32x4){0u, 0u, 0u, 0u}; } }
    float* scr = (float*)(F.lds + F.wave * 64 * 33 * 4);
    long base = 0;
#pragma unroll 1
    for (int j = 0; j < NJOBS; ++j) {
        const TJob t = get_job(P, j);
        const int nnb = t.N / 32; const long per = (long)(t.K / 64) * nnb, total = per * t.count;
        long first = ((long)F.gw - base % F.ngw + F.ngw) % F.ngw;
        for (long it = first; it < total; it += F.ngw) {
            const int m = (int)(it / per); const int r = (int)(it % per); const int kb = r / nnb, nb = r % nnb;
            transpose_item(t.W + (size_t)m * t.wstride, t.ldw, t.WT + (size_t)m * t.tstride, t.ldt, kb * 64, nb * 32, t.row_off, t.col_off, t.map, scr, F.lane);
        }
        base += total;
    }
}

struct RowV { f32x4 v[4]; };
__device__ __forceinline__ RowV load_row(const float* p, int lane) { RowV r; const f32x4* q = (const f32x4*)p + lane;
#pragma unroll
    for (int j = 0; j < 4; ++j) r.v[j] = q[64 * j]; return r; }
__device__ __forceinline__ void norm_mod(RowV& r, const float* g, const float* sc, const float* sh, int lane) {
    float s = 0.f;
#pragma unroll
    for (int j = 0; j < 4; ++j) s += r.v[j].x * r.v[j].x + r.v[j].y * r.v[j].y + r.v[j].z * r.v[j].z + r.v[j].w * r.v[j].w;
    const float rs = rsqrtf(wave_sum(s) * (1.f / D) + 1e-6f);
#pragma unroll
    for (int j = 0; j < 4; ++j) { const f32x4 gv = ((const f32x4*)g)[lane + 64 * j], scv = ((const f32x4*)sc)[lane + 64 * j], shv = ((const f32x4*)sh)[lane + 64 * j];
        r.v[j] = (r.v[j] * rs * gv) * (scv + 1.f) + shv; }
}
__device__ __forceinline__ void store_row_bf16(bf16* p, const RowV& r, int lane) { u32x2* q = (u32x2*)p + lane;
#pragma unroll
    for (int j = 0; j < 4; ++j) { u32x2 o; o.x = pk2(r.v[j].x, r.v[j].y); o.y = pk2(r.v[j].z, r.v[j].w); q[64 * j] = o; } }
__device__ __forceinline__ const float* xrow0(const Ptrs& P, int r) { return r < NL ? P.in[0] + (size_t)r * D : P.in[2] + (size_t)(r - NL) * D; }

__device__ __forceinline__ void ph_norm0(Fr& F) {
    const Ptrs& P = F.P; const float* MOD = WSP(float, WS_MOD);
    for (int r = F.gw; r < NT; r += F.ngw) {
        RowV v = load_row(xrow0(P, r), F.lane);
        const float* m = MOD + (size_t)mod_row(r) * 6144;
        norm_mod(v, P.in[6], m + 1024, m, F.lane);
        store_row_bf16(WSP(bf16, WS_HN) + (size_t)r * D, v, F.lane);
    }
}

__device__ __forceinline__ void wtile(const bf16* a0, const bf16* a1, const bf16* b0, const bf16* b1, int K, f32x4 (&acc)[2][2]) {
#pragma unroll
    for (int m = 0; m < 2; ++m)
#pragma unroll
        for (int n = 0; n < 2; ++n) acc[m][n] = (f32x4){0.f, 0.f, 0.f, 0.f};
#pragma unroll 2
    for (int k = 0; k < K; k += 32) {
        const bf16x8 A0 = *(const bf16x8*)(a0 + k), A1 = *(const bf16x8*)(a1 + k), B0 = *(const bf16x8*)(b0 + k), B1 = *(const bf16x8*)(b1 + k);
        acc[0][0] = __builtin_amdgcn_mfma_f32_16x16x32_bf16(B0, A0, acc[0][0], 0, 0, 0);
        acc[0][1] = __builtin_amdgcn_mfma_f32_16x16x32_bf16(B1, A0, acc[0][1], 0, 0, 0);
        acc[1][0] = __builtin_amdgcn_mfma_f32_16x16x32_bf16(B0, A1, acc[1][0], 0, 0, 0);
        acc[1][1] = __builtin_amdgcn_mfma_f32_16x16x32_bf16(B1, A1, acc[1][1], 0, 0, 0);
    }
}
struct EpiF32 { float* C; int ldc, nvalid;
    __device__ __forceinline__ void operator()(int row, int col, f32x4 a, f32x4 b) const {
        if (col < nvalid) *(f32x4*)(C + (size_t)row * ldc + col) = a;
        if (col + 16 < nvalid) *(f32x4*)(C + (size_t)row * ldc + col + 16) = b; } };
struct EpiResid { const float* xin0; const float* xin1; float* xout; const float* g;
    __device__ __forceinline__ void operator()(int row, int col, f32x4 a, f32x4 b) const {
        const float* xi = row < NL ? xin0 + (size_t)row * D : xin1 + (size_t)(row - NL) * D; const float* gg = g + (size_t)mod_row(row) * 6144;
        float* xo = xout + (size_t)row * D;
        *(f32x4*)(xo + col) = *(const f32x4*)(xi + col) + *(const f32x4*)(gg + col) * a;
        *(f32x4*)(xo + col + 16) = *(const f32x4*)(xi + col + 16) + *(const f32x4*)(gg + col + 16) * b; } };
struct EpiSwiglu { bf16* act; const float* bias;
    __device__ __forceinline__ void operator()(int row, int col, f32x4 a, f32x4 b) const {
        const int j = (col >> 5) * 16 + (col & 15);
        const f32x4 bg = *(const f32x4*)(bias + j), bu = *(const f32x4*)(bias + 1024 + j);
        float o[4];
#pragma unroll
        for (int i = 0; i < 4; ++i) { float hg = a[i] + bg[i], hu = b[i] + bu[i]; hg = fminf(hg, 7.f); hu = fminf(fmaxf(hu, -7.f), 7.f);
            o[i] = hg * sigmoidf_(1.702f * hg) * (hu + 1.f); }
        u32x2 w; w.x = pk2(o[0], o[1]); w.y = pk2(o[2], o[3]);
        *(u32x2*)(act + (size_t)row * D + j) = w; } };
struct EpiBiasBf16 { bf16* Y; const float* bias;
    __device__ __forceinline__ void operator()(int row, int col, f32x4 a, f32x4 b) const {
        const f32x4 b0 = *(const f32x4*)(bias + col), b1 = *(const f32x4*)(bias + col + 16);
        u32x2 w; w.x = pk2(a[0] + b0[0], a[1] + b0[1]); w.y = pk2(a[2] + b0[2], a[3] + b0[3]); *(u32x2*)(Y + (size_t)row * D + col) = w;
        w.x = pk2(b[0] + b1[0], b[1] + b1[1]); w.y = pk2(b[2] + b1[2], b[3] + b1[3]); *(u32x2*)(Y + (size_t)row * D + col + 16) = w; } };

template <class Epi>
__device__ __forceinline__ void ph_sgemm(Fr& F, const bf16* A, int lda, const bf16* Bt, int ldb, int M, int N, int K, const Epi& E) {
    const int fr = F.lane & 15, fq = F.lane >> 4; const int ng = N / 32, nt = (M / 32) * ng;
    for (int t = F.gw; t < nt; t += F.ngw) {
        const int row0 = (t / ng) * 32, col0 = (t % ng) * 32;
        f32x4 acc[2][2];
        wtile(A + (size_t)(row0 + fr) * lda + 8 * fq, A + (size_t)(row0 + 16 + fr) * lda + 8 * fq,
              Bt + (size_t)(col0 + fr) * ldb + 8 * fq, Bt + (size_t)(col0 + 16 + fr) * ldb + 8 * fq, K, acc);
#pragma unroll
        for (int m = 0; m < 2; ++m) E(row0 + m * 16 + fr, col0 + 4 * fq, acc[m][0], acc[m][1]);
    }
}
__device__ __forceinline__ void moe_prefix(Fr& F, int layer) {
    int* pre = (int*)(F.lds + LDS_MISC + 64);
    const int* cnt = (const int*)(F.P.ws + WS_CTL + CW_CNT) + layer * NE;
    __syncthreads();
    if (F.tid == 0) { int s = 0; for (int e = 0; e < NE; ++e) { pre[e] = s; s += (cnt[e] + 255) >> 8; } pre[NE] = s; }
    __syncthreads();
}
__device__ __forceinline__ int moe_find(const int* pre, int t256) { int e = 0;
#pragma unroll 1
    for (int i = 0; i < NE; ++i) e = (pre[i + 1] <= t256) ? i + 1 : e;
    return e; }
template <int STAGE>
__device__ __forceinline__ void ph_moe_sgemm(Fr& F, int layer) {
    const Ptrs& P = F.P;
    moe_prefix(F, layer);
    const int* pre = (const int*)(F.lds + LDS_MISC + 64);
    const int* cnt = (const int*)(P.ws + WS_CTL + CW_CNT) + layer * NE;
    const int fr = F.lane & 15, fq = F.lane >> 4;
    constexpr int N = STAGE == 1 ? 2048 : 1024, ng = N / 32;
    const int nt = pre[NE] * 8 * ng;
    const int* toklist = WSP(int, WS_TOK);
    for (int t = F.gw; t < nt; t += F.ngw) {
        const int t256 = t / (8 * ng), rem = t % (8 * ng), sub = rem / ng, g = rem % ng;
        const int e = moe_find(pre, t256), mt = t256 - pre[e];
        const int row0 = t256 * 256 + sub * 32, col0 = g * 32;
        f32x4 acc[2][2];
        if (STAGE == 1) {
            const int s0 = mt * 256 + sub * 32 + fr, s1 = s0 + 16; const int c = cnt[e];
            const int tk0 = s0 < c ? toklist[(size_t)e * NT + s0] : 0, tk1 = s1 < c ? toklist[(size_t)e * NT + s1] : 0;
            const bf16* Fb = WSP(bf16, WS_F); const bf16* Bt = WSP(bf16, WS_WGU) + ((size_t)layer * NE + e) * 2048 * 1024;
            wtile(Fb + (size_t)tk0 * D + 8 * fq, Fb + (size_t)tk1 * D + 8 * fq, Bt + (size_t)(col0 + fr) * D + 8 * fq, Bt + (size_t)(col0 + 16 + fr) * D + 8 * fq, D, acc);
            EpiSwiglu E{WSP(bf16, WS_ACT), P.in[30] + ((size_t)layer * NE + e) * 2048};
#pragma unroll
            for (int m = 0; m < 2; ++m) E(row0 + m * 16 + fr, col0 + 4 * fq, acc[m][0], acc[m][1]);
        } else {
            const bf16* A = WSP(bf16, WS_ACT); const bf16* Bt = WSP(bf16, WS_WDN) + ((size_t)layer * NE + e) * 1024 * 1024;
            wtile(A + (size_t)(row0 + fr) * D + 8 * fq, A + (size_t)(row0 + 16 + fr) * D + 8 * fq, Bt + (size_t)(col0 + fr) * D + 8 * fq, Bt + (size_t)(col0 + 16 + fr) * D + 8 * fq, D, acc);
            EpiBiasBf16 E{WSP(bf16, WS_Y), P.in[32] + ((size_t)layer * NE + e) * 1024};
#pragma unroll
            for (int m = 0; m < 2; ++m) E(row0 + m * 16 + fr, col0 + 4 * fq, acc[m][0], acc[m][1]);
        }
    }
}

__device__ __forceinline__ void ph_e3(Fr& F) {
    const Ptrs& P = F.P; const int lane = F.lane;
    const float* Z = WSP(float, WS_Z); bf16* QKVN = WSP(bf16, WS_QKVN); bf16* KM = WSP(bf16, WS_KM);
    const float* ropeM = WSP(float, WS_ROPEM);
    for (int r = F.gw; r < NT; r += F.ngw) {
        const float* z = Z + (size_t)r * ZLD;
        const f32x4 qa = *(const f32x4*)(z + 1024 + 4 * lane);
        float ss = wave_sum(qa.x * qa.x + qa.y * qa.y + qa.z * qa.z + qa.w * qa.w);
        float rs = rsqrtf(ss * (1.f / 256.f) + 1e-6f);
        const f32x4 gq = *(const f32x4*)(P.in[16] + 4 * lane);
        u32x2 o; o.x = pk2(qa.x * rs * gq.x, qa.y * rs * gq.y); o.y = pk2(qa.z * rs * gq.z, qa.w * rs * gq.w);
        *(u32x2*)(QKVN + (size_t)r * 384 + 4 * lane) = o;
        const float k0 = z[1280 + 2 * lane], k1 = z[1280 + 2 * lane + 1];
        ss = wave_sum(k0 * k0 + k1 * k1); rs = rsqrtf(ss * (1.f / 128.f) + 1e-6f);
        *(unsigned*)(QKVN + (size_t)r * 384 + 256 + 2 * lane) = pk2(k0 * rs * P.in[18][2 * lane], k1 * rs * P.in[18][2 * lane + 1]);
        float kr = lane < 32 ? z[1408 + lane] : 0.f;
        ss = wave_sum(kr * kr); rs = rsqrtf(ss * (1.f / 32.f) + 1e-6f);
        kr = kr * rs * (lane < 32 ? P.in[21][32 + lane] : 0.f);
        int b, s; row_bs(r, b, s);
        const float other = __shfl_xor(kr, 16);
        float outv = kr;
        if (r < NL && lane < 32) { const int i = lane & 15; const float cs = ropeM[((size_t)s * 16 + i) * 2], sn = ropeM[((size_t)s * 16 + i) * 2 + 1];
            outv = lane < 16 ? kr * cs - other * sn : kr * cs + other * sn; }
        if (lane < 32) { const bf16 ov = (bf16)f2bf(outv);
#pragma unroll
            for (int h = 0; h < 8; ++h) KM[(((size_t)b * 8 + h) * TA + s) * 96 + 64 + lane] = ov; }
    }
}
__device__ __forceinline__ void ph_e5(Fr& F) {
    const Ptrs& P = F.P; const int lane = F.lane;
    const float* R = WSP(float, WS_QKVR); bf16* QM = WSP(bf16, WS_QM); bf16* KM = WSP(bf16, WS_KM); bf16* VM = WSP(bf16, WS_VM);
    const float* ropeM = WSP(float, WS_ROPEM);
    const float gqn = P.in[20][lane], gkn = P.in[20][64 + lane], gqr = lane < 32 ? P.in[21][lane] : 0.f;
    for (int r = F.gw; r < NT; r += F.ngw) {
        const float* q = R + (size_t)r * 1792; int b, s; row_bs(r, b, s);
#pragma unroll 2
        for (int h = 0; h < 8; ++h) {
            const size_t qo = (((size_t)b * 8 + h) * TA + s) * 96, vo = (((size_t)b * 8 + h) * TA + s) * 64;
            const float qn = q[h * 96 + lane];
            float rs = rsqrtf(wave_sum(qn * qn) * (1.f / 64.f) + 1e-6f);
            QM[qo + lane] = (bf16)f2bf(qn * rs * gqn);
            float qr = lane < 32 ? q[h * 96 + 64 + lane] : 0.f;
            rs = rsqrtf(wave_sum(qr * qr) * (1.f / 32.f) + 1e-6f);
            qr = qr * rs * gqr;
            const float other = __shfl_xor(qr, 16); float outv = qr;
            if (r < NL && lane < 32) { const int i = lane & 15; const float cs = ropeM[((size_t)s * 16 + i) * 2], sn = ropeM[((size_t)s * 16 + i) * 2 + 1];
                outv = lane < 16 ? qr * cs - other * sn : qr * cs + other * sn; }
            if (lane < 32) QM[qo + 64 + lane] = (bf16)f2bf(outv);
            const float kn = q[768 + h * 128 + lane];
            rs = rsqrtf(wave_sum(kn * kn) * (1.f / 64.f) + 1e-6f);
            KM[qo + lane] = (bf16)f2bf(kn * rs * gkn);
            VM[vo + lane] = (bf16)f2bf(q[768 + h * 128 + 64 + lane]);
        }
    }
}
__device__ __forceinline__ void ph_attn_mla_naive(Fr& F) {
    const Ptrs& P = F.P;
    const bf16* QM = WSP(bf16, WS_QM); const bf16* KM = WSP(bf16, WS_KM); const bf16* VM = WSP(bf16, WS_VM);
    const int half = F.tid >> 8, t256 = F.tid & 255;
    for (int u = F.blk * 2 + half; u < NB * 8 * 17; u += F.nblk * 2) {
        const int bh = u / 17, qb = u % 17, b = bh >> 3, h = bh & 7;
        const int s = qb * 256 + t256;
        float qr[96];
        { const u32x4* q = (const u32x4*)(QM + ((size_t)bh * TA + s) * 96); const float sc = 0.10206207261596577f;
#pragma unroll
          for (int i = 0; i < 12; ++i) { const u32x4 w = q[i]; qr[8 * i] = bflo(w.x) * sc; qr[8 * i + 1] = bfhi(w.x) * sc; qr[8 * i + 2] = bflo(w.y) * sc; qr[8 * i + 3] = bfhi(w.y) * sc;
              qr[8 * i + 4] = bflo(w.z) * sc; qr[8 * i + 5] = bfhi(w.z) * sc; qr[8 * i + 6] = bflo(w.w) * sc; qr[8 * i + 7] = bfhi(w.w) * sc; } }
        const int k0 = qb < 16 ? 0 : SEQ;
        float m = -1e30f, l = 0.f, o[64];
#pragma unroll
        for (int i = 0; i < 64; ++i) o[i] = 0.f;
#pragma unroll 1
        for (int j = k0; j < TA; ++j) {
            const u32x4* kr = (const u32x4*)(KM + ((size_t)bh * TA + j) * 96);
            float sc = 0.f;
#pragma unroll
            for (int i = 0; i < 12; ++i) { const u32x4 w = kr[i];
                sc += qr[8 * i] * bflo(w.x) + qr[8 * i + 1] * bfhi(w.x) + qr[8 * i + 2] * bflo(w.y) + qr[8 * i + 3] * bfhi(w.y) + qr[8 * i + 4] * bflo(w.z) + qr[8 * i + 5] * bfhi(w.z) + qr[8 * i + 6] * bflo(w.w) + qr[8 * i + 7] * bfhi(w.w); }
            const float mn = fmaxf(m, sc), al = __expf(m - mn), p = __expf(sc - mn);
            l = l * al + p; m = mn;
            const u32x4* vr = (const u32x4*)(VM + ((size_t)bh * TA + j) * 64);
#pragma unroll
            for (int i = 0; i < 8; ++i) { const u32x4 w = vr[i];
                o[8 * i] = o[8 * i] * al + p * bflo(w.x); o[8 * i + 1] = o[8 * i + 1] * al + p * bfhi(w.x); o[8 * i + 2] = o[8 * i + 2] * al + p * bflo(w.y); o[8 * i + 3] = o[8 * i + 3] * al + p * bfhi(w.y);
                o[8 * i + 4] = o[8 * i + 4] * al + p * bflo(w.z); o[8 * i + 5] = o[8 * i + 5] * al + p * bfhi(w.z); o[8 * i + 6] = o[8 * i + 6] * al + p * bflo(w.w); o[8 * i + 7] = o[8 * i + 7] * al + p * bfhi(w.w); }
        }
        const int row = s < SEQ ? b * SEQ + s : NL + b * CTX + (s - SEQ);
        bf16* y = WSP(bf16, WS_YM) + (size_t)row * D + 512 + h * 64; const float il = 1.f / l;
#pragma unroll
        for (int i = 0; i < 32; ++i) *(unsigned*)(y + 2 * i) = pk2(o[2 * i] * il, o[2 * i + 1] * il);
    }
}

__device__ __forceinline__ void ph_lru_xf(Fr& F) {
    const Ptrs& P = F.P; const float* Z = WSP(float, WS_Z);
    for (size_t gid = F.gtid; gid < (size_t)2 * NT * 512; gid += F.gsz) {
        const int ch = (int)(gid & 511); const int row = (int)((gid >> 9) % NT); const int dir = (int)(gid / ((size_t)NT * 512));
        int t, T, base; if (row < NL) { t = row & 4095; T = SEQ; base = row - t; } else { t = (row - NL) & 255; T = CTX; base = row - t; }
        const float* cw = P.in[9] + (size_t)dir * 4 * 512 + ch;
        float acc = P.in[10][dir * 512 + ch];
#pragma unroll
        for (int j = 0; j < 4; ++j) { const int tt = dir == 0 ? t - 3 + j : t + 3 - j; if (tt >= 0 && tt < T) acc += cw[j * 512] * Z[(size_t)(base + tt) * ZLD + ch]; }
        WSP(float, WS_XF)[gid] = acc;
    }
}
__device__ __forceinline__ void ph_lru_ab(Fr& F) {
    const Ptrs& P = F.P;
    for (size_t gid = F.gtid; gid < (size_t)2 * NT * 512; gid += F.gsz) {
        const int ch = (int)(gid & 511); const int dir = (int)(gid / ((size_t)NT * 512));
        const int blk = ch >> 6, d = ch & 63;
        const float* xf = WSP(float, WS_XF) + (gid - ch) + blk * 64;
        const float* wr = P.in[11] + ((size_t)dir * 8 + blk) * 64 * 64 + d; const float* wi = P.in[13] + ((size_t)dir * 8 + blk) * 64 * 64 + d;
        float ar = P.in[12][dir * 512 + ch], ai = P.in[14][dir * 512 + ch];
#pragma unroll 8
        for (int c = 0; c < 64; ++c) { const float x = xf[c]; ar += x * wr[c * 64]; ai += x * wi[c * 64]; }
        const float r = sigmoidf_(ar), gi = sigmoidf_(ai);
        const float lam = P.in[15][dir * 512 + ch];
        const float sp = log1pf(__expf(-lam));
        const float log_a = -8.f * r * sp; const float a = __expf(log_a);
        const float bb = sqrtf(-expm1f(2.f * log_a)) * (gi * xf[d]);
        WSP(float, WS_LA)[gid] = a; WSP(float, WS_LB)[gid] = bb;
    }
}
__device__ __forceinline__ void ph_lru_scan(Fr& F) {
    const Ptrs& P = F.P;
    if (F.gtid >= NB * 2 * 512) return;
    const int gid = (int)F.gtid; const int ch = gid & 511, dir = (gid >> 9) & 1, b = gid >> 10;
    const float* LA = WSP(float, WS_LA) + (size_t)dir * NT * 512 + ch; const float* LB = WSP(float, WS_LB) + (size_t)dir * NT * 512 + ch;
    float* LH = WSP(float, WS_LH) + (size_t)dir * NT * 512 + ch;
    float h = 0.f;
#pragma unroll 4
    for (int i = 0; i < CTX; ++i) { const int t = dir == 0 ? i : CTX - 1 - i; const size_t row = NL + b * CTX + t; h = LA[row * 512] * h + LB[row * 512]; LH[row * 512] = h; }
#pragma unroll 4
    for (int i = 0; i < SEQ; ++i) { const int t = dir == 0 ? i : SEQ - 1 - i; const size_t row = (size_t)b * SEQ + t; h = LA[row * 512] * h + LB[row * 512]; LH[row * 512] = h; }
}
__device__ __forceinline__ void ph_lru_out(Fr& F) {
    const Ptrs& P = F.P; const float* LH = WSP(float, WS_LH);
    for (size_t gid = F.gtid; gid < (size_t)NT * 512; gid += F.gsz) {
        const int ch = (int)(gid & 511); const size_t row = gid >> 9;
        const float h = LH[gid] + LH[(size_t)NT * 512 + gid];
        WSP(bf16, WS_YM)[row * D + ch] = (bf16)f2bf(h * gelu_tanh(WSP(float, WS_Z)[row * ZLD + 512 + ch]));
    }
}

__device__ __forceinline__ void ph_oprep(Fr& F) {
    const Ptrs& P = F.P; const int lane = F.lane;
    const float* Z = WSP(float, WS_Z); bf16* QG = WSP(bf16, WS_QG); bf16* KG = WSP(bf16, WS_KG); bf16* VG = WSP(bf16, WS_VG);
    const float* ropeG = WSP(float, WS_ROPEG);
    const float gq = P.in[24][lane], gk = P.in[24][64 + lane];
    for (int r = F.gw; r < NT; r += F.ngw) {
        const float* z = Z + (size_t)r * ZLD; int b, s; row_bs(r, b, s);
        float cs = 1.f, sn = 0.f;
        if (r < NL) { cs = ropeG[((size_t)s * 32 + (lane & 31)) * 2]; sn = ropeG[((size_t)s * 32 + (lane & 31)) * 2 + 1]; }
        if (r < NL) {
#pragma unroll 2
            for (int h = 0; h < 16; ++h) {
                float q = z[h * 64 + lane]; const float rs = rsqrtf(wave_sum(q * q) * (1.f / 64.f) + 1e-6f); q = q * rs * gq;
                const float other = __shfl_xor(q, 32); const float o = lane < 32 ? q * cs - other * sn : q * cs + other * sn;
                QG[(((size_t)b * 16 + h) * SEQ + s) * 64 + lane] = (bf16)f2bf(o); } }
#pragma unroll 2
        for (int h = 0; h < 4; ++h) {
            float k = z[1024 + h * 64 + lane]; const float rs = rsqrtf(wave_sum(k * k) * (1.f / 64.f) + 1e-6f); k = k * rs * gk;
            const float other = __shfl_xor(k, 32); const float o = lane < 32 ? k * cs - other * sn : k * cs + other * sn;
            KG[(((size_t)b * 4 + h) * TA + s) * 64 + lane] = (bf16)f2bf(o);
            VG[(((size_t)b * 4 + h) * TA + s) * 64 + lane] = (bf16)f2bf(z[1280 + h * 64 + lane]); }
    }
}
__device__ __forceinline__ void ph_attn_gqa_naive(Fr& F) {
    const Ptrs& P = F.P;
    const int half = F.tid >> 8, t256 = F.tid & 255;
    for (int u = F.blk * 2 + half; u < NB * 16 * 16; u += F.nblk * 2) {
        const int bh = u >> 4, qb = u & 15, b = bh >> 4, h = bh & 15, kh = h >> 2;
        const int t = qb * 256 + t256;
        const bf16* QG = WSP(bf16, WS_QG); const bf16* KG = WSP(bf16, WS_KG) + ((size_t)b * 4 + kh) * TA * 64; const bf16* VG = WSP(bf16, WS_VG) + ((size_t)b * 4 + kh) * TA * 64;
        float qr[64];
        { const u32x4* q = (const u32x4*)(QG + ((size_t)bh * SEQ + t) * 64);
#pragma unroll
          for (int i = 0; i < 8; ++i) { const u32x4 w = q[i]; qr[8 * i] = bflo(w.x) * 0.125f; qr[8 * i + 1] = bfhi(w.x) * 0.125f; qr[8 * i + 2] = bflo(w.y) * 0.125f; qr[8 * i + 3] = bfhi(w.y) * 0.125f;
              qr[8 * i + 4] = bflo(w.z) * 0.125f; qr[8 * i + 5] = bfhi(w.z) * 0.125f; qr[8 * i + 6] = bflo(w.w) * 0.125f; qr[8 * i + 7] = bfhi(w.w) * 0.125f; } }
        float m = -1e30f, l = 0.f, o[64];
#pragma unroll
        for (int i = 0; i < 64; ++i) o[i] = 0.f;
#pragma unroll 1
        for (int jj = 0; jj < 257 + CTX; ++jj) {
            int j; bool valid = true;
            if (jj < 257) { j = t - 128 + jj; valid = (j >= 0 && j < SEQ); if (!valid) j = 0; } else j = SEQ + (jj - 257);
            const u32x4* kr = (const u32x4*)(KG + (size_t)j * 64);
            float sc = 0.f;
#pragma unroll
            for (int i = 0; i < 8; ++i) { const u32x4 w = kr[i];
                sc += qr[8 * i] * bflo(w.x) + qr[8 * i + 1] * bfhi(w.x) + qr[8 * i + 2] * bflo(w.y) + qr[8 * i + 3] * bfhi(w.y) + qr[8 * i + 4] * bflo(w.z) + qr[8 * i + 5] * bfhi(w.z) + qr[8 * i + 6] * bflo(w.w) + qr[8 * i + 7] * bfhi(w.w); }
            if (!valid) sc = -1e30f;
            const float mn = fmaxf(m, sc), al = __expf(m - mn), p = valid ? __expf(sc - mn) : 0.f;
            l = l * al + p; m = mn;
            const u32x4* vr = (const u32x4*)(VG + (size_t)j * 64);
#pragma unroll
            for (int i = 0; i < 8; ++i) { const u32x4 w = vr[i];
                o[8 * i] = o[8 * i] * al + p * bflo(w.x); o[8 * i + 1] = o[8 * i + 1] * al + p * bfhi(w.x); o[8 * i + 2] = o[8 * i + 2] * al + p * bflo(w.y); o[8 * i + 3] = o[8 * i + 3] * al + p * bfhi(w.y);
                o[8 * i + 4] = o[8 * i + 4] * al + p * bflo(w.z); o[8 * i + 5] = o[8 * i + 5] * al + p * bfhi(w.z); o[8 * i + 6] = o[8 * i + 6] * al + p * bflo(w.w); o[8 * i + 7] = o[8 * i + 7] * al + p * bfhi(w.w); }
        }
        { const float sk = P.in[25][h]; const float mn = fmaxf(m, sk), al = __expf(m - mn); l = l * al + __expf(sk - mn);
          const float il = al / l;
          bf16* y = WSP(bf16, WS_YM) + ((size_t)b * SEQ + t) * D + h * 64;
#pragma unroll
          for (int i = 0; i < 32; ++i) *(unsigned*)(y + 2 * i) = pk2(o[2 * i] * il, o[2 * i + 1] * il); }
    }
}

__device__ __forceinline__ void ph_router(Fr& F, int layer, int nrows) {
    const Ptrs& P = F.P; const int lane = F.lane;
    const float* MOD = WSP(float, WS_MOD); const float* X1 = WSP(float, WS_X1);
    const float* wrt = WSP(float, WS_WRT) + (size_t)layer * 32 * 1024;
    int* cnt = (int*)(P.ws + WS_CTL + CW_CNT) + layer * NE;
    for (int r = F.gw; r < nrows; r += F.ngw) {
        RowV v = load_row(X1 + (size_t)r * D, lane);
        const float* m = MOD + (size_t)(layer * 5 + mod_row(r)) * 6144;
        norm_mod(v, P.in[7] + layer * D, m + 4 * 1024, m + 3 * 1024, lane);
        store_row_bf16(WSP(bf16, WS_F) + (size_t)r * D, v, lane);
        float mylg = -3.4e38f;
#pragma unroll 4
        for (int e = 0; e < NE; ++e) { const f32x4* w = (const f32x4*)(wrt + e * 1024) + lane; float s = 0.f;
#pragma unroll
            for (int j = 0; j < 4; ++j) { const f32x4 wv = w[64 * j]; s += v.v[j].x * wv.x + v.v[j].y * wv.y + v.v[j].z * wv.z + v.v[j].w * wv.w; }
            s = wave_sum(s) + P.in[28][layer * NE + e]; mylg = (lane == e) ? s : mylg; }
        int te[4]; float tv[4];
#pragma unroll
        for (int k = 0; k < 4; ++k) { float bv = mylg; int bi = lane;
#pragma unroll
            for (int o = 1; o < 64; o <<= 1) { const float ov = __shfl_xor(bv, o); const int oi = __shfl_xor(bi, o); const bool take = ov > bv || (ov == bv && oi < bi); bv = take ? ov : bv; bi = take ? oi : bi; }
            te[k] = bi; tv[k] = bv; mylg = (lane == bi) ? -3.4e38f : mylg; }
        const float e1 = __expf(tv[1] - tv[0]), e2 = __expf(tv[2] - tv[0]), e3 = __expf(tv[3] - tv[0]); const float inv = 1.f / (1.f + e1 + e2 + e3);
        const float gate[4] = {inv, e1 * inv, e2 * inv, e3 * inv};
        if (lane < 4) { const int e = lane == 0 ? te[0] : lane == 1 ? te[1] : lane == 2 ? te[2] : te[3]; const float g = lane == 0 ? gate[0] : lane == 1 ? gate[1] : lane == 2 ? gate[2] : gate[3];
            const int slot = atomicAdd(&cnt[e], 1);
            WSP(int, WS_TOK)[(size_t)e * NT + slot] = r;
            WSP(int, WS_PE)[r * 4 + lane] = e; WSP(int, WS_PS)[r * 4 + lane] = slot; WSP(float, WS_PG)[r * 4 + lane] = g; }
    }
}
template <int MODE>
__device__ __forceinline__ void ph_combine(Fr& F, int layer, int nrows) {
    const Ptrs& P = F.P; const int lane = F.lane;
    moe_prefix(F, layer);
    const int* pre = (const int*)(F.lds + LDS_MISC + 64);
    const float* MOD = WSP(float, WS_MOD); const float* X1 = WSP(float, WS_X1); const bf16* Y = WSP(bf16, WS_Y);
    for (int r = F.gw; r < nrows; r += F.ngw) {
        RowV v = load_row(X1 + (size_t)r * D, lane);
        const float* g2 = MOD + (size_t)(layer * 5 + mod_row(r)) * 6144 + 5 * 1024;
        RowV acc;
#pragma unroll
        for (int j = 0; j < 4; ++j) acc.v[j] = (f32x4){0.f, 0.f, 0.f, 0.f};
#pragma unroll
        for (int k = 0; k < 4; ++k) { const int e = WSP(int, WS_PE)[r * 4 + k], slot = WSP(int, WS_PS)[r * 4 + k]; const float g = WSP(float, WS_PG)[r * 4 + k];
            const u32x2* y = (const u32x2*)(Y + ((size_t)pre[e] * 256 + slot) * D) + lane;
#pragma unroll
            for (int j = 0; j < 4; ++j) { const u32x2 w = y[64 * j]; acc.v[j] += (f32x4){bflo(w.x), bfhi(w.x), bflo(w.y), bfhi(w.y)} * g; } }
#pragma unroll
        for (int j = 0; j < 4; ++j) v.v[j] += ((const f32x4*)g2)[lane + 64 * j] * acc.v[j];
        if (MODE == 0) {
            f32x4* xo = (f32x4*)(WSP(float, WS_X2) + (size_t)r * D) + lane;
#pragma unroll
            for (int j = 0; j < 4; ++j) xo[64 * j] = v.v[j];
            const float* m = MOD + (size_t)(1 * 5 + mod_row(r)) * 6144;
            norm_mod(v, P.in[6] + D, m + 1024, m, lane);
            store_row_bf16(WSP(bf16, WS_HN) + (size_t)r * D, v, lane);
        } else {
            f32x4* xo = (f32x4*)(P.out + (size_t)r * D) + lane;
#pragma unroll
            for (int j = 0; j < 4; ++j) xo[64 * j] = v.v[j];
        }
    }
}

constexpr int NPHASE = 20;
struct Args { Ptrs P; int ph_lo, ph_hi; };
__global__ void __launch_bounds__(NTHR, 2) mk_fwd(Args args) {
    extern __shared__ __attribute__((aligned(16))) unsigned char lds[];
    Fr F; F.P = args.P; F.lds = lds;
    F.tid = threadIdx.x; F.lane = F.tid & 63; F.wave = __builtin_amdgcn_readfirstlane(F.tid >> 6);
    F.nblk = gridDim.x; F.blk = blockIdx.x; F.gw = F.blk * NWAVES + F.wave; F.ngw = F.nblk * NWAVES;
    F.gtid = (size_t)F.blk * NTHR + F.tid; F.gsz = (size_t)F.nblk * NTHR;
    const Ptrs& P = F.P;
    if (F.tid < 64) ((unsigned*)(lds + LDS_MISC))[F.tid] = 0u;
    __syncthreads();
    const int lo = args.ph_lo, hi = args.ph_hi;
    XcdBarrier bar; bar.bar = (unsigned*)(P.ws + WS_CTL); bar.x = 0; bar.st = nullptr;
    if (hi - lo > 1) bar = xcd_barrier_post((unsigned*)(P.ws + WS_CTL), (volatile LAS unsigned*)(lds + LDS_MISC));
#define IN(k) (lo <= (k) && (k) < hi)
#define SEAM(k) do { if (IN(k) && IN((k) + 1)) xcd_barrier(bar); } while (0)
    const float* MOD = WSP(float, WS_MOD);
    if (IN(0)) { ph_prologue(F); } SEAM(0);
    if (IN(1)) { ph_norm0(F); } SEAM(1);
    if (IN(2)) { ph_sgemm(F, WSP(bf16, WS_HN), 1024, WSP(bf16, WS_WIN), 1024, NT, 1536, 1024, EpiF32{WSP(float, WS_Z), ZLD, EVEN_IN}); } SEAM(2);
    if (IN(3)) { ph_e3(F); ph_lru_xf(F); } SEAM(3);
    if (IN(4)) { ph_sgemm(F, WSP(bf16, WS_QKVN), 384, WSP(bf16, WS_WQKVB), 384, NT, 1792, 384, EpiF32{WSP(float, WS_QKVR), 1792, 1792}); ph_lru_ab(F); } SEAM(4);
    if (IN(5)) { ph_lru_scan(F); ph_e5(F); } SEAM(5);
    if (IN(6)) { ph_lru_out(F); ph_attn_mla_naive(F); } SEAM(6);
    if (IN(7)) { ph_sgemm(F, WSP(bf16, WS_YM), 1024, WSP(bf16, WS_WOE), 1024, NT, 1024, 1024, EpiResid{P.in[0], P.in[2], WSP(float, WS_X1), MOD + 2 * 1024}); } SEAM(7);
    if (IN(8)) { ph_router(F, 0, NT); } SEAM(8);
    if (IN(9)) { ph_moe_sgemm<1>(F, 0); } SEAM(9);
    if (IN(10)) { ph_moe_sgemm<2>(F, 0); } SEAM(10);
    if (IN(11)) { ph_combine<0>(F, 0, NT); } SEAM(11);
    if (IN(12)) { ph_sgemm(F, WSP(bf16, WS_HN), 1024, WSP(bf16, WS_WQO), 1024, NT, 1536, 1024, EpiF32{WSP(float, WS_Z), ZLD, 1536}); } SEAM(12);
    if (IN(13)) { ph_oprep(F); } SEAM(13);
    if (IN(14)) { ph_attn_gqa_naive(F); } SEAM(14);
    if (IN(15)) { ph_sgemm(F, WSP(bf16, WS_YM), 1024, WSP(bf16, WS_WOO), 1024, NL, 1024, 1024, EpiResid{WSP(float, WS_X2), WSP(float, WS_X2) + (size_t)NL * D, WSP(float, WS_X1), MOD + 5 * 6144 + 2 * 1024}); } SEAM(15);
    if (IN(16)) { ph_router(F, 1, NL); } SEAM(16);
    if (IN(17)) { ph_moe_sgemm<1>(F, 1); } SEAM(17);
    if (IN(18)) { ph_moe_sgemm<2>(F, 1); } SEAM(18);
    if (IN(19)) { ph_combine<1>(F, 1, NL); }
#undef IN
#undef SEAM
}

#ifndef MK_N_LAUNCHES
#define MK_N_LAUNCHES 1
#endif
extern "C" void kernel_launch(void* const* d_in, const int* in_sizes, int n_in, void* d_out, int out_size, void* d_ws, size_t ws_size, hipStream_t stream) {
    static int grid = 0;
    if (grid == 0) {
        if (n_in != 33 || ws_size < WS_END) { fprintf(stderr, "kernel_launch: unexpected n_in %d or ws_size %zu < %zu\n", n_in, ws_size, (size_t)WS_END); grid = -1; return; }
        int dev = 0, cus = 0, per_cu = 0;
        if (hipGetDevice(&dev) != hipSuccess || hipDeviceGetAttribute(&cus, hipDeviceAttributeMultiprocessorCount, dev) != hipSuccess) { grid = -1; return; }
        if (hipFuncSetAttribute((const void*)mk_fwd, hipFuncAttributeMaxDynamicSharedMemorySize, LDS_BYTES) != hipSuccess) { fprintf(stderr, "kernel_launch: hipFuncSetAttribute failed\n"); grid = -1; return; }
        if (hipOccupancyMaxActiveBlocksPerMultiprocessor(&per_cu, (const void*)mk_fwd, NTHR, LDS_BYTES) != hipSuccess || per_cu < 1) { fprintf(stderr, "kernel_launch: occupancy query says %d blocks per CU\n", per_cu); grid = -1; return; }
        (void)hipGetLastError();
        grid = cus;
    }
    if (grid < 0) return;
    Args a{};
    for (int i = 0; i < 33; ++i) a.P.in[i] = (const float*)d_in[i];
    a.P.out = (float*)d_out; a.P.ws = (unsigned char*)d_ws;
    (void)hipMemsetAsync((unsigned char*)d_ws + WS_CTL, 0, CTL_BYTES, stream);
    if (MK_N_LAUNCHES == 1) { a.ph_lo = 0; a.ph_hi = NPHASE; hipLaunchKernelGGL(mk_fwd, dim3(grid), dim3(NTHR), LDS_BYTES, stream, a); }
    else for (int p = 0; p < NPHASE; ++p) { a.ph_lo = p; a.ph_hi = p + 1; hipLaunchKernelGGL(mk_fwd, dim3(grid), dim3(NTHR), LDS_BYTES, stream, a); }
}
```

```cpp
#include <hip/hip_runtime.h>
#include <stdint.h>
#include <stdio.h>

typedef unsigned short bf16;
typedef short bf16x8 __attribute__((ext_vector_type(8)));
typedef float f32x4 __attribute__((ext_vector_type(4)));
typedef unsigned u32x2 __attribute__((ext_vector_type(2)));
typedef unsigned u32x4 __attribute__((ext_vector_type(4)));

constexpr int D = 1024, NB = 4, SEQ = 4096, CTX = 256;
constexpr int NL = NB * SEQ, NC = NB * CTX, NT = NL + NC;
constexpr int TA = SEQ + CTX;
constexpr int NE = 32, TOPK = 4;
constexpr int EVEN_IN = 1440, ZLD = 1536;
constexpr int MAXT256 = 304;
constexpr int ACT_ROWS = MAXT256 * 256;

constexpr size_t al256(size_t x) { return (x + 255) & ~(size_t)255; }
constexpr size_t WS_CTL = 0, CTL_BYTES = 1u << 20;
constexpr size_t CW_CNT = 65536;
constexpr size_t WS_MOD = WS_CTL + CTL_BYTES;
constexpr size_t WS_ROPEM = al256(WS_MOD + 2 * 5 * 6144 * 4);
constexpr size_t WS_ROPEG = al256(WS_ROPEM + 4096 * 16 * 2 * 4);
constexpr size_t WS_WRT = al256(WS_ROPEG + 4096 * 32 * 2 * 4);
constexpr size_t WS_WRI = al256(WS_WRT + 2 * 32 * 1024 * 4);
constexpr size_t WS_WIN = al256(WS_WRI + 2 * 8 * 128 * 64 * 2);
constexpr size_t WS_WQKVB = al256(WS_WIN + 1536 * 1024 * 2);
constexpr size_t WS_WOE = al256(WS_WQKVB + 1792 * 384 * 2);
constexpr size_t WS_WQO = al256(WS_WOE + 1024 * 1024 * 2);
constexpr size_t WS_WOO = al256(WS_WQO + 1536 * 1024 * 2);
constexpr size_t WS_WGU = al256(WS_WOO + 1024 * 1024 * 2);
constexpr size_t WS_WDN = al256(WS_WGU + (size_t)2 * 32 * 2048 * 1024 * 2);
constexpr size_t WS_HN = al256(WS_WDN + (size_t)2 * 32 * 1024 * 1024 * 2);
constexpr size_t WS_Z = al256(WS_HN + (size_t)NT * D * 2);
constexpr size_t WS_QKVN = al256(WS_Z + (size_t)NT * ZLD * 4);
constexpr size_t WS_QKVR = al256(WS_QKVN + (size_t)NT * 384 * 2);
constexpr size_t WS_QM = al256(WS_QKVR + (size_t)NT * 1792 * 4);
constexpr size_t WS_KM = al256(WS_QM + (size_t)NB * 8 * TA * 96 * 2);
constexpr size_t WS_VM = al256(WS_KM + (size_t)NB * 8 * TA * 96 * 2);
constexpr size_t WS_QG = al256(WS_VM + (size_t)NB * 8 * TA * 64 * 2);
constexpr size_t WS_KG = al256(WS_QG + (size_t)NB * 16 * SEQ * 64 * 2);
constexpr size_t WS_VG = al256(WS_KG + (size_t)NB * 4 * TA * 64 * 2);
constexpr size_t WS_YM = al256(WS_VG + (size_t)NB * 4 * TA * 64 * 2);
constexpr size_t WS_X1 = al256(WS_YM + (size_t)NT * D * 2);
constexpr size_t WS_X2 = al256(WS_X1 + (size_t)NT * D * 4);
constexpr size_t WS_F = al256(WS_X2 + (size_t)NT * D * 4);
constexpr size_t WS_LA = al256(WS_F + (size_t)NT * D * 2);
constexpr size_t WS_LB = al256(WS_LA + (size_t)2 * NT * 512 * 4);
constexpr size_t WS_LH = al256(WS_LB + (size_t)2 * NT * 512 * 4);
constexpr size_t WS_XF = al256(WS_LH + (size_t)2 * NT * 512 * 4);
constexpr size_t WS_PE = al256(WS_XF + (size_t)2 * NT * 512 * 4);
constexpr size_t WS_PS = al256(WS_PE + (size_t)NT * 4 * 4);
constexpr size_t WS_PG = al256(WS_PS + (size_t)NT * 4 * 4);
constexpr size_t WS_TOK = al256(WS_PG + (size_t)NT * 4 * 4);
constexpr size_t WS_ACT = al256(WS_TOK + (size_t)NE * NT * 4);
constexpr size_t WS_Y = al256(WS_ACT + (size_t)ACT_ROWS * D * 2);
constexpr size_t WS_END = al256(WS_Y + (size_t)ACT_ROWS * D * 2);

__device__ __forceinline__ unsigned f2bf(float f) { unsigned u = __float_as_uint(f); u += 0x7FFFu + ((u >> 16) & 1u); return u >> 16; }
__device__ __forceinline__ unsigned pk2(float a, float b) { return f2bf(a) | (f2bf(b) << 16); }
__device__ __forceinline__ float bf2f(unsigned b) { return __uint_as_float(b << 16); }
__device__ __forceinline__ float bflo(unsigned u) { return __uint_as_float(u << 16); }
__device__ __forceinline__ float bfhi(unsigned u) { return __uint_as_float(u & 0xffff0000u); }
__device__ __forceinline__ float wave_sum(float v) {
#pragma unroll
    for (int o = 1; o < 64; o <<= 1) v += __shfl_xor(v, o);
    return v;
}
__device__ __forceinline__ float sigmoidf_(float x) { return 1.f / (1.f + __expf(-x)); }
__device__ __forceinline__ float gelu_tanh(float x) { const float u = 0.7978845608028654f * (x + 0.044715f * x * x * x); return 0.5f * x * (1.f + tanhf(u)); }
__device__ __forceinline__ int mod_row(int r) { return r < NL ? (r >> 12) : 4; }
__device__ __forceinline__ void row_bs(int r, int& b, int& s) { if (r < NL) { b = r >> 12; s = r & 4095; } else { const int rc = r - NL; b = rc >> 8; s = SEQ + (rc & 255); } }


struct Ptrs {
    const float* in[33];
    float* out;
    unsigned char* ws;
};
#define WSP(T, off) ((T*)(P.ws + (off)))
#define LAS __attribute__((address_space(3)))

#define XB_TMO      128
#define XB_XCNT(j)  (256  + 64 * (j))
#define XB_XSUB(j)  (1280 + 64 * (j))
#define XB_XGEN(j)  (2304 + 64 * (j))
#define XB_TOP      3328
#define XB_TOPGEN   3392
#define XCD_BAR_WORDS 3456
#define XB_SPIN_CAP (1u << 18)
__device__ __forceinline__ unsigned xb_ld(unsigned* p)              { return __hip_atomic_load(p, __ATOMIC_RELAXED, __HIP_MEMORY_SCOPE_AGENT); }
__device__ __forceinline__ unsigned xb_add(unsigned* p, unsigned v) { return __hip_atomic_fetch_add(p, v, __ATOMIC_RELAXED, __HIP_MEMORY_SCOPE_AGENT); }
__device__ __forceinline__ unsigned xb_xcc_id() { return (unsigned)__builtin_amdgcn_s_getreg((3 << 11) | 20) & 0xFu; }
#define XB_SPIN(cond, bar) do { unsigned _sp = 0; while (cond) { __builtin_amdgcn_s_sleep(1); \
    if ((++_sp & 255u) == 0u) { if (xb_ld(&(bar)[XB_TMO])) break; if (_sp > XB_SPIN_CAP) { atomicAdd(&(bar)[XB_TMO], 1u); break; } } } } while (0)
struct XcdBarrier { unsigned* bar; unsigned x; volatile LAS unsigned* st; };
__device__ __forceinline__ XcdBarrier xcd_barrier_post(unsigned* bar, volatile LAS unsigned* st) {
    XcdBarrier b; b.bar = bar; b.x = xb_xcc_id(); b.st = st;
    if (threadIdx.x == 0) (void)xb_add(&bar[XB_XCNT(b.x)], 1u);
    return b;
}
__device__ __forceinline__ void xcd_barrier_complete(unsigned* bar, unsigned x, unsigned& nloc, unsigned& nx) {
    const unsigned G = gridDim.x * gridDim.y * gridDim.z;
    unsigned sum, cnt, mine, sp = 0u;
    for (;;) {
        sum = 0u; cnt = 0u; mine = 0u;
#pragma unroll
        for (unsigned j = 0; j < 16; ++j) { const unsigned c = xb_ld(&bar[XB_XCNT(j)]); sum += c; cnt += (c > 0u) ? 1u : 0u; mine = (j == x) ? c : mine; }
        if (sum == G) break;
        __builtin_amdgcn_s_sleep(1);
        if ((++sp & 255u) == 0u) { if (xb_ld(&bar[XB_TMO])) break; if (sp > XB_SPIN_CAP) { atomicAdd(&bar[XB_TMO], 1u); break; } }
    }
    nloc = mine > 0u ? mine : 1u; nx = cnt > 0u ? cnt : 1u;
}
__device__ __forceinline__ void xcd_barrier(const XcdBarrier& b) {
    asm volatile("s_waitcnt vmcnt(0)" ::: "memory");
    __syncthreads();
    if (threadIdx.x == 0) {
        unsigned* bar = b.bar;
        __builtin_amdgcn_s_waitcnt(0);
        unsigned nloc = b.st[0], nx = b.st[1];
        if (nloc == 0u) { xcd_barrier_complete(bar, b.x, nloc, nx); b.st[0] = nloc; b.st[1] = nx; }
        const unsigned old = xb_add(&bar[XB_XSUB(b.x)], 1u);
        const unsigned gen = old / nloc;
        if (old + 1u == (gen + 1u) * nloc) {
            __builtin_amdgcn_fence(__ATOMIC_RELEASE, "agent");
            asm volatile("s_waitcnt vmcnt(0)" ::: "memory");
            const unsigned og = xb_add(&bar[XB_TOP], 1u);
            const unsigned tg = og / nx;
            if (og + 1u == (tg + 1u) * nx) xb_add(&bar[XB_TOPGEN], 1u);
            else XB_SPIN(xb_ld(&bar[XB_TOPGEN]) == tg, bar);
            __builtin_amdgcn_fence(__ATOMIC_ACQUIRE, "agent");
            xb_add(&bar[XB_XGEN(b.x)], 1u);
            asm volatile("s_waitcnt vmcnt(0)" ::: "memory");
        } else {
            XB_SPIN(xb_ld(&bar[XB_XGEN(b.x)]) == gen, bar);
            __builtin_amdgcn_fence(__ATOMIC_ACQUIRE, "agent");
            asm volatile("s_waitcnt vmcnt(0)" ::: "memory");
        }
    }
    __syncthreads();
}

constexpr int NTHR = 512, NWAVES = 8;
constexpr int LDS_RING = 131072;
constexpr int LDS_MISC = LDS_RING;
constexpr int LDS_BYTES = LDS_RING + 4096;
struct Fr {
    Ptrs P; unsigned char* lds;
    int tid, lane, wave, gw, ngw, nblk, blk; size_t gtid, gsz;
};

__device__ __forceinline__ void transpose_item(const float* W, int ldw, bf16* WT, int ldt, int k0, int n0, int row_off, int col_off, int map, float* scr, int lane) {
#pragma unroll 8
    for (int i = 0; i < 32; ++i) { const int kk = 2 * i + (lane >> 5); scr[kk * 33 + (lane & 31)] = W[(size_t)(k0 + kk) * ldw + n0 + (lane & 31)]; }
    __builtin_amdgcn_s_waitcnt(0xc07f); asm volatile("" ::: "memory");
    const int c = lane & 7;
#pragma unroll
    for (int j = 0; j < 4; ++j) { const int n = (lane >> 3) + 8 * j; const float* s = scr + (8 * c) * 33 + n;
        u32x4 o; o.x = pk2(s[0 * 33], s[1 * 33]); o.y = pk2(s[2 * 33], s[3 * 33]); o.z = pk2(s[4 * 33], s[5 * 33]); o.w = pk2(s[6 * 33], s[7 * 33]);
        int nn = n0 + n;
        if (map == 1) { const int up = nn >= 1024, jj = nn & 1023; nn = (jj >> 4) * 32 + up * 16 + (jj & 15); }
        *(u32x4*)(WT + (size_t)(row_off + nn) * ldt + col_off + k0 + 8 * c) = o; }
    __builtin_amdgcn_s_waitcnt(0xc07f); asm volatile("" ::: "memory");
}
struct TJob { const float* W; bf16* WT; int K, N, ldw, ldt, row_off, col_off, map; long wstride, tstride; int count; };
constexpr int NJOBS = 8;
__device__ __forceinline__ TJob get_job(const Ptrs& P, int j) {
    TJob t; t.row_off = 0; t.col_off = 0; t.map = 0; t.wstride = 0; t.tstride = 0; t.count = 1;
    switch (j) {
    case 0: t.W = P.in[29]; t.WT = WSP(bf16, WS_WGU); t.K = 1024; t.N = 2048; t.ldw = 2048; t.ldt = 1024; t.map = 1; t.wstride = (long)1024 * 2048; t.tstride = (long)2048 * 1024; t.count = 64; break;
    case 1: t.W = P.in[31]; t.WT = WSP(bf16, WS_WDN); t.K = 1024; t.N = 1024; t.ldw = 1024; t.ldt = 1024; t.wstride = (long)1024 * 1024; t.tstride = (long)1024 * 1024; t.count = 64; break;
    case 2: t.W = P.in[8]; t.WT = WSP(bf16, WS_WIN); t.K = 1024; t.N = 1440; t.ldw = 1440; t.ldt = 1024; break;
    case 3: t.W = P.in[17]; t.WT = WSP(bf16, WS_WQKVB); t.K = 256; t.N = 768; t.ldw = 768; t.ldt = 384; break;
    case 4: t.W = P.in[19]; t.WT = WSP(bf16, WS_WQKVB); t.K = 128; t.N = 1024; t.ldw = 1024; t.ldt = 384; t.row_off = 768; t.col_off = 256; break;
    case 5: t.W = P.in[22]; t.WT = WSP(bf16, WS_WOE); t.K = 1024; t.N = 1024; t.ldw = 1024; t.ldt = 1024; break;
    case 6: t.W = P.in[23]; t.WT = WSP(bf16, WS_WQO); t.K = 1024; t.N = 1536; t.ldw = 1536; t.ldt = 1024; break;
    default: t.W = P.in[26]; t.WT = WSP(bf16, WS_WOO); t.K = 1024; t.N = 1024; t.ldw = 1024; t.ldt = 1024; break;
    }
    return t;
}
__device__ __forceinline__ void ph_prologue(Fr& F) {
    const Ptrs& P = F.P;
    if (F.blk < 24) {
        float* sl = (float*)(F.lds + 8 * 64 * 33 * 4);
        const float* c = P.in[1]; const float* cc = P.in[3];
        for (int i = F.tid; i < 5 * 1024; i += NTHR) { const int r = i >> 10, k = i & 1023; const float v = r < 4 ? c[r * 1024 + k] : cc[k]; sl[i] = v / (1.f + __expf(-v)); }
        __syncthreads();
        const int gid = F.blk * NTHR + F.tid, l = gid / 6144, j = gid % 6144;
        const float* w = P.in[4] + (size_t)l * 1024 * 6144 + j;
        float acc[5] = {0.f, 0.f, 0.f, 0.f, 0.f};
#pragma unroll 8
        for (int k = 0; k < 1024; ++k) { const float wv = w[(size_t)k * 6144];
#pragma unroll
            for (int r = 0; r < 5; ++r) acc[r] += sl[r * 1024 + k] * wv; }
        float* MOD = WSP(float, WS_MOD);
        const float bm = P.in[5][l * 6144 + j];
#pragma unroll
        for (int r = 0; r < 5; ++r) MOD[(l * 5 + r) * 6144 + j] = acc[r] + bm;
    }
    for (size_t gid = F.gtid; gid < 4096 * 48; gid += F.gsz) {
        const int s = (int)(gid / 48), i = (int)(gid % 48); const int row = s >> 6, col = s & 63;
        if (i < 16) { const int fi = i & 7; const float fr = powf(10000.f, -(float)fi / 8.f); const float ang = (float)(i < 8 ? row : col) * fr;
            float* T = WSP(float, WS_ROPEM) + ((size_t)s * 16 + i) * 2; T[0] = cosf(ang); T[1] = sinf(ang); }
        else { const int ii = i - 16, fi = ii & 15; const float fr = powf(10000.f, -(float)fi / 16.f); const float ang = (float)(ii < 16 ? row : col) * fr;
            float* T = WSP(float, WS_ROPEG) + ((size_t)s * 32 + ii) * 2; T[0] = cosf(ang); T[1] = sinf(ang); }
    }
    for (size_t gid = F.gtid; gid < 2 * 32 * 1024; gid += F.gsz) { const int l = (int)(gid >> 15), e = (int)(gid >> 10) & 31, k = (int)gid & 1023;
        WSP(float, WS_WRT)[gid] = P.in[27][((size_t)l * 1024 + k) * 32 + e]; }
    for (size_t gid = F.gtid; gid < 2 * 8 * 128 * 64; gid += F.gsz) { const int c = (int)gid & 63, o = (int)(gid >> 6) & 127, blk = (int)(gid >> 13) & 7, dir = (int)(gid >> 16);
        const float* src = o < 64 ? P.in[11] : P.in[13];
        WSP(bf16, WS_WRI)[gid] = (bf16)f2bf(src[(((size_t)dir * 8 + blk) * 64 + c) * 64 + (o & 63)]); }
    { u32x4* z = (u32x4*)(WSP(bf16, WS_WIN) + (size_t)1440 * 1024); for (size_t i = F.gtid; i < (size_t)96 * 1024 * 2 / 16; i += F.gsz) z[i] = (u32x4){0u, 0u, 0u, 0u};
      bf16* q = WSP(bf16, WS_WQKVB);
      for (size_t i = F.gtid; i < (size_t)768 * 16; i += F.gsz) { const int r = (int)(i >> 4), c = (int)(i & 15); *(u32x4*)(q + (size_t)r * 384 + 256 + c * 8) = (u32x4){0u, 0u, 0u, 0u}; }
      for (size_t i = F.gtid; i < (size_t)1024 * 32; i += F.gsz) { const int r = (int)(i >> 5), c = (int)(i & 31); *(u32x4*)(q + (size_t)(768 + r) * 384 + c * 8) = (u32x4){0u, 0u, 0u, 0u}; } }
    float* scr = (float*)(F.lds + F.wave * 64 * 33 * 4);
    long base = 0;
#pragma unroll 1
    for (int j = 0; j < NJOBS; ++j) {
        const TJob t = get_job(P, j);
        const int nnb = t.N / 32; const long per = (long)(t.K / 64) * nnb, total = per * t.count;
        long first = ((long)F.gw - base % F.ngw + F.ngw) % F.ngw;
        for (long it = first; it < total; it += F.ngw) {
            const int m = (int)(it / per); const int r = (int)(it % per); const int kb = r / nnb, nb = r % nnb;
            transpose_item(t.W + (size_t)m * t.wstride, t.ldw, t.WT + (size_t)m * t.tstride, t.ldt, kb * 64, nb * 32, t.row_off, t.col_off, t.map, scr, F.lane);
        }
        base += total;
    }
}

struct RowV { f32x4 v[4]; };
__device__ __forceinline__ RowV load_row(const float* p, int lane) { RowV r; const f32x4* q = (const f32x4*)p + lane;
#pragma unroll
    for (int j = 0; j < 4; ++j) r.v[j] = q[64 * j]; return r; }
__device__ __forceinline__ void norm_mod(RowV& r, const float* g, const float* sc, const float* sh, int lane) {
    float s = 0.f;
#pragma unroll
    for (int j = 0; j < 4; ++j) s += r.v[j].x * r.v[j].x + r.v[j].y * r.v[j].y + r.v[j].z * r.v[j].z + r.v[j].w * r.v[j].w;
    const float rs = rsqrtf(wave_sum(s) * (1.f / D) + 1e-6f);
#pragma unroll
    for (int j = 0; j < 4; ++j) { const f32x4 gv = ((const f32x4*)g)[lane + 64 * j], scv = ((const f32x4*)sc)[lane + 64 * j], shv = ((const f32x4*)sh)[lane + 64 * j];
        r.v[j] = (r.v[j] * rs * gv) * (scv + 1.f) + shv; }
}
__device__ __forceinline__ void store_row_bf16(bf16* p, const RowV& r, int lane) { u32x2* q = (u32x2*)p + lane;
#pragma unroll
    for (int j = 0; j < 4; ++j) { u32x2 o; o.x = pk2(r.v[j].x, r.v[j].y); o.y = pk2(r.v[j].z, r.v[j].w); q[64 * j] = o; } }
__device__ __forceinline__ const float* xrow0(const Ptrs& P, int r) { return r < NL ? P.in[0] + (size_t)r * D : P.in[2] + (size_t)(r - NL) * D; }

__device__ __forceinline__ void ph_norm0(Fr& F) {
    const Ptrs& P = F.P; const float* MOD = WSP(float, WS_MOD);
    for (int r = F.gw; r < NT; r += F.ngw) {
        RowV v = load_row(xrow0(P, r), F.lane);
        const float* m = MOD + (size_t)mod_row(r) * 6144;
        norm_mod(v, P.in[6], m + 1024, m, F.lane);
        store_row_bf16(WSP(bf16, WS_HN) + (size_t)r * D, v, F.lane);
    }
}

__device__ __forceinline__ void wtile(const bf16* a0, const bf16* a1, const bf16* b0, const bf16* b1, int K, f32x4 (&acc)[2][2]) {
#pragma unroll
    for (int m = 0; m < 2; ++m)
#pragma unroll
        for (int n = 0; n < 2; ++n) acc[m][n] = (f32x4){0.f, 0.f, 0.f, 0.f};
#pragma unroll 2
    for (int k = 0; k < K; k += 32) {
        const bf16x8 A0 = *(const bf16x8*)(a0 + k), A1 = *(const bf16x8*)(a1 + k), B0 = *(const bf16x8*)(b0 + k), B1 = *(const bf16x8*)(b1 + k);
        acc[0][0] = __builtin_amdgcn_mfma_f32_16x16x32_bf16(B0, A0, acc[0][0], 0, 0, 0);
        acc[0][1] = __builtin_amdgcn_mfma_f32_16x16x32_bf16(B1, A0, acc[0][1], 0, 0, 0);
        acc[1][0] = __builtin_amdgcn_mfma_f32_16x16x32_bf16(B0, A1, acc[1][0], 0, 0, 0);
        acc[1][1] = __builtin_amdgcn_mfma_f32_16x16x32_bf16(B1, A1, acc[1][1], 0, 0, 0);
    }
}
struct EpiF32 { float* C; int ldc, nvalid;
    __device__ __forceinline__ void operator()(int row, int col, f32x4 a, f32x4 b) const {
        if (col < nvalid) *(f32x4*)(C + (size_t)row * ldc + col) = a;
        if (col + 16 < nvalid) *(f32x4*)(C + (size_t)row * ldc + col + 16) = b; } };
struct EpiResid { const float* xin0; const float* xin1; float* xout; const float* g;
    __device__ __forceinline__ void operator()(int row, int col, f32x4 a, f32x4 b) const {
        const float* xi = row < NL ? xin0 + (size_t)row * D : xin1 + (size_t)(row - NL) * D; const float* gg = g + (size_t)mod_row(row) * 6144;
        float* xo = xout + (size_t)row * D;
        *(f32x4*)(xo + col) = *(const f32x4*)(xi + col) + *(const f32x4*)(gg + col) * a;
        *(f32x4*)(xo + col + 16) = *(const f32x4*)(xi + col + 16) + *(const f32x4*)(gg + col + 16) * b; } };
struct EpiSwiglu { bf16* act; const float* bias;
    __device__ __forceinline__ void operator()(int row, int col, f32x4 a, f32x4 b) const {
        const int j = (col >> 5) * 16 + (col & 15);
        const f32x4 bg = *(const f32x4*)(bias + j), bu = *(const f32x4*)(bias + 1024 + j);
        float o[4];
#pragma unroll
        for (int i = 0; i < 4; ++i) { float hg = a[i] + bg[i], hu = b[i] + bu[i]; hg = fminf(hg, 7.f); hu = fminf(fmaxf(hu, -7.f), 7.f);
            o[i] = hg * sigmoidf_(1.702f * hg) * (hu + 1.f); }
        u32x2 w; w.x = pk2(o[0], o[1]); w.y = pk2(o[2], o[3]);
        *(u32x2*)(act + (size_t)row * D + j) = w; } };
struct EpiBiasBf16 { bf16* Y; const float* bias;
    __device__ __forceinline__ void operator()(int row, int col, f32x4 a, f32x4 b) const {
        const f32x4 b0 = *(const f32x4*)(bias + col), b1 = *(const f32x4*)(bias + col + 16);
        u32x2 w; w.x = pk2(a[0] + b0[0], a[1] + b0[1]); w.y = pk2(a[2] + b0[2], a[3] + b0[3]); *(u32x2*)(Y + (size_t)row * D + col) = w;
        w.x = pk2(b[0] + b1[0], b[1] + b1[1]); w.y = pk2(b[2] + b1[2], b[3] + b1[3]); *(u32x2*)(Y + (size_t)row * D + col + 16) = w; } };

template <class Epi>
__device__ __forceinline__ void ph_sgemm(Fr& F, const bf16* A, int lda, const bf16* Bt, int ldb, int M, int N, int K, const Epi& E) {
    const int fr = F.lane & 15, fq = F.lane >> 4; const int ng = N / 32, nt = (M / 32) * ng;
    for (int t = F.gw; t < nt; t += F.ngw) {
        const int row0 = (t / ng) * 32, col0 = (t % ng) * 32;
        f32x4 acc[2][2];
        wtile(A + (size_t)(row0 + fr) * lda + 8 * fq, A + (size_t)(row0 + 16 + fr) * lda + 8 * fq,
              Bt + (size_t)(col0 + fr) * ldb + 8 * fq, Bt + (size_t)(col0 + 16 + fr) * ldb + 8 * fq, K, acc);
#pragma unroll
        for (int m = 0; m < 2; ++m) E(row0 + m * 16 + fr, col0 + 4 * fq, acc[m][0], acc[m][1]);
    }
}
__device__ __forceinline__ void moe_prefix(Fr& F, int layer) {
    int* pre = (int*)(F.lds + LDS_MISC + 64);
    const int* cnt = (const int*)(F.P.ws + WS_CTL + CW_CNT) + layer * NE;
    __syncthreads();
    if (F.tid == 0) { int s = 0; for (int e = 0; e < NE; ++e) { pre[e] = s; s += (cnt[e] + 255) >> 8; } pre[NE] = s; }
    __syncthreads();
}
__device__ __forceinline__ int moe_find(const int* pre, int t256) { int e = 0;
#pragma unroll 1
    for (int i = 0; i < NE; ++i) e = (pre[i + 1] <= t256) ? i + 1 : e;
    return e; }
template <int STAGE>
__device__ __forceinline__ void ph_moe_sgemm(Fr& F, int layer) {
    const Ptrs& P = F.P;
    moe_prefix(F, layer);
    const int* pre = (const int*)(F.lds + LDS_MISC + 64);
    const int* cnt = (const int*)(P.ws + WS_CTL + CW_CNT) + layer * NE;
    const int fr = F.lane & 15, fq = F.lane >> 4;
    constexpr int N = STAGE == 1 ? 2048 : 1024, ng = N / 32;
    const int nt = pre[NE] * 8 * ng;
    const int* toklist = WSP(int, WS_TOK);
    for (int t = F.gw; t < nt; t += F.ngw) {
        const int t256 = t / (8 * ng), rem = t % (8 * ng), sub = rem / ng, g = rem % ng;
        const int e = moe_find(pre, t256), mt = t256 - pre[e];
        const int row0 = t256 * 256 + sub * 32, col0 = g * 32;
        f32x4 acc[2][2];
        if (STAGE == 1) {
            const int s0 = mt * 256 + sub * 32 + fr, s1 = s0 + 16; const int c = cnt[e];
            const int tk0 = s0 < c ? toklist[(size_t)e * NT + s0] : 0, tk1 = s1 < c ? toklist[(size_t)e * NT + s1] : 0;
            const bf16* Fb = WSP(bf16, WS_F); const bf16* Bt = WSP(bf16, WS_WGU) + ((size_t)layer * NE + e) * 2048 * 1024;
            wtile(Fb + (size_t)tk0 * D + 8 * fq, Fb + (size_t)tk1 * D + 8 * fq, Bt + (size_t)(col0 + fr) * D + 8 * fq, Bt + (size_t)(col0 + 16 + fr) * D + 8 * fq, D, acc);
            EpiSwiglu E{WSP(bf16, WS_ACT), P.in[30] + ((size_t)layer * NE + e) * 2048};
#pragma unroll
            for (int m = 0; m < 2; ++m) E(row0 + m * 16 + fr, col0 + 4 * fq, acc[m][0], acc[m][1]);
        } else {
            const bf16* A = WSP(bf16, WS_ACT); const bf16* Bt = WSP(bf16, WS_WDN) + ((size_t)layer * NE + e) * 1024 * 1024;
            wtile(A + (size_t)(row0 + fr) * D + 8 * fq, A + (size_t)(row0 + 16 + fr) * D + 8 * fq, Bt + (size_t)(col0 + fr) * D + 8 * fq, Bt + (size_t)(col0 + 16 + fr) * D + 8 * fq, D, acc);
            EpiBiasBf16 E{WSP(bf16, WS_Y), P.in[32] + ((size_t)layer * NE + e) * 1024};
#pragma unroll
            for (int m = 0; m < 2; ++m) E(row0 + m * 16 + fr, col0 + 4 * fq, acc[m][0], acc[m][1]);
        }
    }
}


namespace pg {
constexpr int BM = 256, BK = 64, HALF = 128, HTB = HALF * BK * 2, STAGE_BYTES = 8 * HTB, NXCD = 8, WGM = 8;
__device__ __forceinline__ int lds_byte(int r, int c) { const int st = (r >> 4) * 2 + (c >> 5), rr = r & 15, cc = c & 31, ob = rr * 64 + cc * 2; return st * 1024 + (ob ^ (((ob >> 9) & 1) << 5)); }
__device__ __forceinline__ void stage_rc(int b, int& R, int& C) { const int st = b / 1024, sb = b % 1024, swz = sb ^ (((sb >> 9) & 1) << 5); R = (st >> 1) * 16 + swz / 64; C = (st & 1) * 32 + (swz % 64) / 2; }
struct Unit { int pm, pn, e, mt; };
struct DenseSched {
    const bf16* A; const bf16* Bt; int lda, ldb, K; int nM, nN, nwg, G, c;
    __device__ __forceinline__ void init(const bf16* A_, int lda_, const bf16* Bt_, int ldb_, int M, int N, int K_, int G_, int c_) { A = A_; Bt = Bt_; lda = lda_; ldb = ldb_; K = K_; nM = M / BM; nN = N / BM; nwg = nM * nN; G = G_; c = c_; }
    __device__ __forceinline__ bool next(int i, Unit& u) const {
        const long L = (long)i * G + c; if (L >= nwg) return false;
        int wgid = (int)L; { const int q = nwg / NXCD, r = nwg % NXCD, xcd = wgid % NXCD, off = wgid / NXCD; wgid = (xcd < r ? xcd * (q + 1) : r * (q + 1) + (xcd - r) * q) + off; }
        const int nig = WGM * nN, gid = wgid / nig, fm = gid * WGM, gsz = (nM - fm) < WGM ? (nM - fm) : WGM;
        u.pm = fm + ((wgid % nig) % gsz); u.pn = (wgid % nig) / gsz; u.e = 0; u.mt = 0; return true;
    }
    __device__ __forceinline__ unsigned aoff(const Unit& u, int r, int C) const { return (unsigned)((u.pm * BM + r) * lda + C) * 2u; }
    __device__ __forceinline__ const char* bbase(const Unit& u) const { return (const char*)(Bt + (size_t)u.pn * BM * ldb); }
};
template <int STAGE> struct MoeSched {
    const bf16* A; const bf16* Bt; int lda, ldb, K; int G, c, NN, nunits; const int* pre; const int* cnt; const int* toklist;
    __device__ __forceinline__ bool next(int i, Unit& u) const {
        const long L = (long)i * G + c; if (L >= nunits) return false;
        const int t256 = (int)(L / NN); u.pn = (int)(L % NN); u.pm = t256; u.e = moe_find(pre, t256); u.mt = t256 - pre[u.e]; return true;
    }
    __device__ __forceinline__ unsigned aoff(const Unit& u, int r, int C) const {
        if (STAGE == 1) { const int slot = u.mt * BM + r; const int tok = slot < cnt[u.e] ? toklist[(size_t)u.e * NT + slot] : 0; return (unsigned)(tok * lda + C) * 2u; }
        return (unsigned)((u.pm * BM + r) * lda + C) * 2u;
    }
    __device__ __forceinline__ const char* bbase(const Unit& u) const { return (const char*)(Bt + ((size_t)u.e * NN * BM + (size_t)u.pn * BM) * ldb); }
};

template <class Sched, class Epi>
__device__ __forceinline__ void gemm_phase(LAS unsigned char* lds, const Sched& S, const Epi& E) {
    const int tid = threadIdx.x, wid = __builtin_amdgcn_readfirstlane(tid >> 6), lane = tid & 63, wr = wid >> 2, wc = wid & 3, fr = lane & 15, fq = lane >> 4;
    const int K = S.K, nt = K / BK;
    int Rr[2], Cc[2]; unsigned voffB[2];
#pragma unroll
    for (int i = 0; i < 2; ++i) { stage_rc(tid * 16 + i * 8192, Rr[i], Cc[i]); voffB[i] = (unsigned)(Rr[i] * S.ldb + Cc[i]) * 2u; }
    const size_t kstep = (size_t)(BK * 2);
    const size_t hstepB = (size_t)HALF * S.ldb * 2;
    const unsigned ldsw = (unsigned)wid * 1024u;
    const int aoff = lds_byte(wr * 64 + fr, fq * 8), boff = lds_byte(wc * 32 + fr, fq * 8);
#define PG_SA(b, h) (((b) * 2 + (h)) * HTB)
#define PG_SB(b, h) ((4 + (b) * 2 + (h)) * HTB)
#define PG_STAGE(bufoff, gbase, voff) do { _Pragma("unroll") for (int _i = 0; _i < 2; ++_i) \
        __builtin_amdgcn_global_load_lds((const unsigned*)((const char*)(gbase) + (voff)[_i]), (LAS unsigned*)(lds + (bufoff) + ldsw + _i * 8192), 16, 0, 0); } while (0)
#define PG_LDA(dst, b, h) do { _Pragma("unroll") for (int m = 0; m < 4; ++m) _Pragma("unroll") for (int k = 0; k < 2; ++k) dst[m][k] = *(const LAS bf16x8*)(lds + PG_SA(b, h) + aoff + m * 2048 + k * 1024); } while (0)
#define PG_LDB(dst, b, h) do { _Pragma("unroll") for (int n = 0; n < 2; ++n) _Pragma("unroll") for (int k = 0; k < 2; ++k) dst[n][k] = *(const LAS bf16x8*)(lds + PG_SB(b, h) + boff + n * 2048 + k * 1024); } while (0)
#define PG_MMA(ai, bj, At, Bt) do { __builtin_amdgcn_s_setprio(1); _Pragma("unroll") for (int m = 0; m < 4; ++m) _Pragma("unroll") for (int n = 0; n < 2; ++n) _Pragma("unroll") for (int k = 0; k < 2; ++k) \
        acc[ai][bj][m][n] = __builtin_amdgcn_mfma_f32_16x16x32_bf16(Bt[n][k], At[m][k], acc[ai][bj][m][n], 0, 0, 0); __builtin_amdgcn_s_setprio(0); } while (0)
#define PG_WAIT_V(n) asm volatile("s_waitcnt vmcnt(" #n ")" ::: "memory")
#define PG_WAIT_L(n) asm volatile("s_waitcnt lgkmcnt(" #n ")" ::: "memory")
#define PG_BAR __builtin_amdgcn_s_barrier()
#define PG_SCHED __builtin_amdgcn_sched_barrier(0)
    Unit cur, nxt; int ui = 0;
    if (!S.next(0, cur)) return;
    f32x4 acc[2][2][4][2];
#pragma unroll
    for (int a = 0; a < 2; ++a)
#pragma unroll
        for (int b = 0; b < 2; ++b)
#pragma unroll
            for (int m = 0; m < 4; ++m)
#pragma unroll
                for (int n = 0; n < 2; ++n) acc[a][b][m][n] = (f32x4){0.f, 0.f, 0.f, 0.f};
    bf16x8 At[4][2], B0[2][2], B1[2][2];
    unsigned voA0[2], voA1[2], vnA0[2], vnA1[2];
#pragma unroll
    for (int i = 0; i < 2; ++i) { voA0[i] = S.aoff(cur, Rr[i], Cc[i]); voA1[i] = S.aoff(cur, HALF + Rr[i], Cc[i]); }
    const char* Ab = (const char*)S.A; const char* cB = S.bbase(cur);
    PG_STAGE(PG_SB(0, 0), cB, voffB); PG_STAGE(PG_SA(0, 0), Ab, voA0); PG_STAGE(PG_SB(0, 1), cB + hstepB, voffB); PG_STAGE(PG_SA(0, 1), Ab, voA1);
    if (wr == 1) PG_BAR;
    PG_WAIT_V(4); PG_BAR;
    PG_STAGE(PG_SB(1, 0), cB + kstep, voffB); PG_STAGE(PG_SA(1, 0), Ab + kstep, voA0); PG_STAGE(PG_SB(1, 1), cB + hstepB + kstep, voffB);
    PG_WAIT_V(6); PG_BAR;
    for (;;) {
        const bool has_next = S.next(ui + 1, nxt);
        const char* nB = has_next ? S.bbase(nxt) : cB;
#pragma unroll
        for (int i = 0; i < 2; ++i) { vnA0[i] = has_next ? S.aoff(nxt, Rr[i], Cc[i]) : voA0[i]; vnA1[i] = has_next ? S.aoff(nxt, HALF + Rr[i], Cc[i]) : voA1[i]; }
        for (int t = 0; t < nt; t += 2) {
            const bool last = (t == nt - 2);
            const char* a1 = Ab + (size_t)(t + 1) * kstep;
            const char* a2 = last ? Ab : Ab + (size_t)(t + 2) * kstep; const char* b2 = last ? nB : cB + (size_t)(t + 2) * kstep;
            const char* a3 = a2 + kstep; const char* b3 = b2 + kstep;
            unsigned o20[2], o21[2];
#pragma unroll
            for (int i = 0; i < 2; ++i) { o20[i] = last ? vnA0[i] : voA0[i]; o21[i] = last ? vnA1[i] : voA1[i]; }
            PG_LDB(B0, 0, 0); PG_SCHED; PG_LDA(At, 0, 0); PG_STAGE(PG_SA(1, 1), a1, voA1);
            PG_WAIT_L(8); PG_BAR; PG_WAIT_L(0); PG_MMA(0, 0, At, B0); PG_BAR; PG_SCHED;
            PG_LDB(B1, 0, 1); PG_STAGE(PG_SB(0, 0), b2, voffB);
            PG_BAR; PG_WAIT_L(0); PG_MMA(0, 1, At, B1); PG_BAR;
            PG_LDA(At, 0, 1); PG_STAGE(PG_SA(0, 0), a2, o20);
            PG_BAR; PG_WAIT_L(0); PG_MMA(1, 0, At, B0); PG_BAR; PG_SCHED;
            PG_STAGE(PG_SB(0, 1), b2 + hstepB, voffB);
            PG_WAIT_V(6); PG_BAR; PG_MMA(1, 1, At, B1); PG_BAR;
            PG_LDB(B0, 1, 0); PG_SCHED; PG_LDA(At, 1, 0); PG_STAGE(PG_SA(0, 1), a2, o21);
            PG_WAIT_L(8); PG_BAR; PG_WAIT_L(0); PG_MMA(0, 0, At, B0); PG_BAR; PG_SCHED;
            PG_LDB(B1, 1, 1); PG_STAGE(PG_SB(1, 0), b3, voffB);
            PG_BAR; PG_WAIT_L(0); PG_MMA(0, 1, At, B1); PG_BAR;
            PG_LDA(At, 1, 1); PG_STAGE(PG_SA(1, 0), a3, o20);
            PG_BAR; PG_WAIT_L(0); PG_MMA(1, 0, At, B0); PG_BAR; PG_SCHED;
            PG_STAGE(PG_SB(1, 1), b3 + hstepB, voffB);
            PG_WAIT_V(6); PG_BAR; PG_MMA(1, 1, At, B1); PG_BAR;
        }
        { const int row0 = cur.pm * BM + wr * 64 + fr, col0 = cur.pn * BM + wc * 32 + 4 * fq;
#pragma unroll
          for (int ai = 0; ai < 2; ++ai)
#pragma unroll
              for (int m = 0; m < 4; ++m)
#pragma unroll
                  for (int bj = 0; bj < 2; ++bj) E(cur, row0 + ai * HALF + m * 16, col0 + bj * HALF, acc[ai][bj][m][0], acc[ai][bj][m][1]); }
        if (!has_next) break;
#pragma unroll
        for (int a = 0; a < 2; ++a)
#pragma unroll
            for (int b = 0; b < 2; ++b)
#pragma unroll
                for (int m = 0; m < 4; ++m)
#pragma unroll
                    for (int n = 0; n < 2; ++n) acc[a][b][m][n] = (f32x4){0.f, 0.f, 0.f, 0.f};
        cur = nxt; cB = nB; ++ui;
#pragma unroll
        for (int i = 0; i < 2; ++i) { voA0[i] = vnA0[i]; voA1[i] = vnA1[i]; }
    }
    PG_WAIT_V(0);
    if (wr == 0) PG_BAR;
    PG_BAR;
#undef PG_SA
#undef PG_SB
#undef PG_STAGE
#undef PG_LDA
#undef PG_LDB
#undef PG_MMA
#undef PG_WAIT_V
#undef PG_WAIT_L
#undef PG_BAR
#undef PG_SCHED
}
}
struct GF32 { EpiF32 e; __device__ __forceinline__ void operator()(const pg::Unit&, int row, int col, f32x4 a, f32x4 b) const { e(row, col, a, b); } };
struct GResid { EpiResid e; __device__ __forceinline__ void operator()(const pg::Unit&, int row, int col, f32x4 a, f32x4 b) const { e(row, col, a, b); } };
struct GSwiglu { bf16* act; const float* bias;
    __device__ __forceinline__ void operator()(const pg::Unit& u, int row, int col, f32x4 a, f32x4 b) const { EpiSwiglu e{act, bias + (size_t)u.e * 2048}; e(row, col, a, b); } };
struct GBiasBf16 { bf16* Y; const float* bias;
    __device__ __forceinline__ void operator()(const pg::Unit& u, int row, int col, f32x4 a, f32x4 b) const { EpiBiasBf16 e{Y, bias + (size_t)u.e * 1024}; e(row, col, a, b); } };
template <class Epi>
__device__ __forceinline__ void ph_gemm(Fr& F, const bf16* A, int lda, const bf16* Bt, int ldb, int M, int N, int K, const Epi& E) {
    pg::DenseSched S; S.init(A, lda, Bt, ldb, M, N, K, F.nblk, F.blk);
    pg::gemm_phase((LAS unsigned char*)F.lds, S, E);
}
template <int STAGE>
__device__ __forceinline__ void ph_moe_gemm(Fr& F, int layer) {
    const Ptrs& P = F.P;
    moe_prefix(F, layer);
    const int* pre = (const int*)(F.lds + LDS_MISC + 64);
    pg::MoeSched<STAGE> S; S.lda = 1024; S.ldb = 1024; S.K = 1024; S.G = F.nblk; S.c = F.blk; S.NN = STAGE == 1 ? 8 : 4; S.nunits = pre[NE] * S.NN;
    S.pre = pre; S.cnt = (const int*)(P.ws + WS_CTL + CW_CNT) + layer * NE; S.toklist = WSP(int, WS_TOK);
    if (STAGE == 1) { S.A = WSP(bf16, WS_F); S.Bt = WSP(bf16, WS_WGU) + (size_t)layer * NE * 2048 * 1024; pg::gemm_phase((LAS unsigned char*)F.lds, S, GSwiglu{WSP(bf16, WS_ACT), P.in[30] + (size_t)layer * NE * 2048}); }
    else { S.A = WSP(bf16, WS_ACT); S.Bt = WSP(bf16, WS_WDN) + (size_t)layer * NE * 1024 * 1024; pg::gemm_phase((LAS unsigned char*)F.lds, S, GBiasBf16{WSP(bf16, WS_Y), P.in[32] + (size_t)layer * NE * 1024}); }
}

__device__ __forceinline__ void ph_e3(Fr& F) {
    const Ptrs& P = F.P; const int lane = F.lane;
    const float* Z = WSP(float, WS_Z); bf16* QKVN = WSP(bf16, WS_QKVN); bf16* KM = WSP(bf16, WS_KM);
    const float* ropeM = WSP(float, WS_ROPEM);
    for (int r = F.gw; r < NT; r += F.ngw) {
        const float* z = Z + (size_t)r * ZLD;
        const f32x4 qa = *(const f32x4*)(z + 1024 + 4 * lane);
        float ss = wave_sum(qa.x * qa.x + qa.y * qa.y + qa.z * qa.z + qa.w * qa.w);
        float rs = rsqrtf(ss * (1.f / 256.f) + 1e-6f);
        const f32x4 gq = *(const f32x4*)(P.in[16] + 4 * lane);
        u32x2 o; o.x = pk2(qa.x * rs * gq.x, qa.y * rs * gq.y); o.y = pk2(qa.z * rs * gq.z, qa.w * rs * gq.w);
        *(u32x2*)(QKVN + (size_t)r * 384 + 4 * lane) = o;
        const float k0 = z[1280 + 2 * lane], k1 = z[1280 + 2 * lane + 1];
        ss = wave_sum(k0 * k0 + k1 * k1); rs = rsqrtf(ss * (1.f / 128.f) + 1e-6f);
        *(unsigned*)(QKVN + (size_t)r * 384 + 256 + 2 * lane) = pk2(k0 * rs * P.in[18][2 * lane], k1 * rs * P.in[18][2 * lane + 1]);
        float kr = lane < 32 ? z[1408 + lane] : 0.f;
        ss = wave_sum(kr * kr); rs = rsqrtf(ss * (1.f / 32.f) + 1e-6f);
        kr = kr * rs * (lane < 32 ? P.in[21][32 + lane] : 0.f);
        int b, s; row_bs(r, b, s);
        const float other = __shfl_xor(kr, 16);
        float outv = kr;
        if (r < NL && lane < 32) { const int i = lane & 15; const float cs = ropeM[((size_t)s * 16 + i) * 2], sn = ropeM[((size_t)s * 16 + i) * 2 + 1];
            outv = lane < 16 ? kr * cs - other * sn : kr * cs + other * sn; }
        if (lane < 32) { const bf16 ov = (bf16)f2bf(outv);
#pragma unroll
            for (int h = 0; h < 8; ++h) KM[(((size_t)b * 8 + h) * TA + s) * 96 + 64 + lane] = ov; }
    }
}
__device__ __forceinline__ void ph_e5(Fr& F) {
    const Ptrs& P = F.P; const int lane = F.lane;
    const float* R = WSP(float, WS_QKVR); bf16* QM = WSP(bf16, WS_QM); bf16* KM = WSP(bf16, WS_KM); bf16* VM = WSP(bf16, WS_VM);
    const float* ropeM = WSP(float, WS_ROPEM);
    const float gqn = P.in[20][lane], gkn = P.in[20][64 + lane], gqr = lane < 32 ? P.in[21][lane] : 0.f;
    for (int r = F.gw; r < NT; r += F.ngw) {
        const float* q = R + (size_t)r * 1792; int b, s; row_bs(r, b, s);
#pragma unroll 2
        for (int h = 0; h < 8; ++h) {
            const size_t qo = (((size_t)b * 8 + h) * TA + s) * 96, vo = (((size_t)b * 8 + h) * TA + s) * 64;
            const float qn = q[h * 96 + lane];
            float rs = rsqrtf(wave_sum(qn * qn) * (1.f / 64.f) + 1e-6f);
            QM[qo + lane] = (bf16)f2bf(qn * rs * gqn);
            float qr = lane < 32 ? q[h * 96 + 64 + lane] : 0.f;
            rs = rsqrtf(wave_sum(qr * qr) * (1.f / 32.f) + 1e-6f);
            qr = qr * rs * gqr;
            const float other = __shfl_xor(qr, 16); float outv = qr;
            if (r < NL && lane < 32) { const int i = lane & 15; const float cs = ropeM[((size_t)s * 16 + i) * 2], sn = ropeM[((size_t)s * 16 + i) * 2 + 1];
                outv = lane < 16 ? qr * cs - other * sn : qr * cs + other * sn; }
            if (lane < 32) QM[qo + 64 + lane] = (bf16)f2bf(outv);
            const float kn = q[768 + h * 128 + lane];
            rs = rsqrtf(wave_sum(kn * kn) * (1.f / 64.f) + 1e-6f);
            KM[qo + lane] = (bf16)f2bf(kn * rs * gkn);
            VM[vo + lane] = (bf16)f2bf(q[768 + h * 128 + 64 + lane]);
        }
    }
}
__device__ __forceinline__ void ph_attn_mla_naive(Fr& F) {
    const Ptrs& P = F.P;
    const bf16* QM = WSP(bf16, WS_QM); const bf16* KM = WSP(bf16, WS_KM); const bf16* VM = WSP(bf16, WS_VM);
    const int half = F.tid >> 8, t256 = F.tid & 255;
    for (int u = F.blk * 2 + half; u < NB * 8 * 17; u += F.nblk * 2) {
        const int bh = u / 17, qb = u % 17, b = bh >> 3, h = bh & 7;
        const int s = qb * 256 + t256;
        float qr[96];
        { const u32x4* q = (const u32x4*)(QM + ((size_t)bh * TA + s) * 96); const float sc = 0.10206207261596577f;
#pragma unroll
          for (int i = 0; i < 12; ++i) { const u32x4 w = q[i]; qr[8 * i] = bflo(w.x) * sc; qr[8 * i + 1] = bfhi(w.x) * sc; qr[8 * i + 2] = bflo(w.y) * sc; qr[8 * i + 3] = bfhi(w.y) * sc;
              qr[8 * i + 4] = bflo(w.z) * sc; qr[8 * i + 5] = bfhi(w.z) * sc; qr[8 * i + 6] = bflo(w.w) * sc; qr[8 * i + 7] = bfhi(w.w) * sc; } }
        const int k0 = qb < 16 ? 0 : SEQ;
        float m = -1e30f, l = 0.f, o[64];
#pragma unroll
        for (int i = 0; i < 64; ++i) o[i] = 0.f;
#pragma unroll 1
        for (int j = k0; j < TA; ++j) {
            const u32x4* kr = (const u32x4*)(KM + ((size_t)bh * TA + j) * 96);
            float sc = 0.f;
#pragma unroll
            for (int i = 0; i < 12; ++i) { const u32x4 w = kr[i];
                sc += qr[8 * i] * bflo(w.x) + qr[8 * i + 1] * bfhi(w.x) + qr[8 * i + 2] * bflo(w.y) + qr[8 * i + 3] * bfhi(w.y) + qr[8 * i + 4] * bflo(w.z) + qr[8 * i + 5] * bfhi(w.z) + qr[8 * i + 6] * bflo(w.w) + qr[8 * i + 7] * bfhi(w.w); }
            const float mn = fmaxf(m, sc), al = __expf(m - mn), p = __expf(sc - mn);
            l = l * al + p; m = mn;
            const u32x4* vr = (const u32x4*)(VM + ((size_t)bh * TA + j) * 64);
#pragma unroll
            for (int i = 0; i < 8; ++i) { const u32x4 w = vr[i];
                o[8 * i] = o[8 * i] * al + p * bflo(w.x); o[8 * i + 1] = o[8 * i + 1] * al + p * bfhi(w.x); o[8 * i + 2] = o[8 * i + 2] * al + p * bflo(w.y); o[8 * i + 3] = o[8 * i + 3] * al + p * bfhi(w.y);
                o[8 * i + 4] = o[8 * i + 4] * al + p * bflo(w.z); o[8 * i + 5] = o[8 * i + 5] * al + p * bfhi(w.z); o[8 * i + 6] = o[8 * i + 6] * al + p * bflo(w.w); o[8 * i + 7] = o[8 * i + 7] * al + p * bfhi(w.w); }
        }
        const int row = s < SEQ ? b * SEQ + s : NL + b * CTX + (s - SEQ);
        bf16* y = WSP(bf16, WS_YM) + (size_t)row * D + 512 + h * 64; const float il = 1.f / l;
#pragma unroll
        for (int i = 0; i < 32; ++i) *(unsigned*)(y + 2 * i) = pk2(o[2 * i] * il, o[2 * i + 1] * il);
    }
}

__device__ __forceinline__ void ph_lru_xf(Fr& F) {
    const Ptrs& P = F.P; const float* Z = WSP(float, WS_Z);
    for (size_t gid = F.gtid; gid < (size_t)2 * NT * 512; gid += F.gsz) {
        const int ch = (int)(gid & 511); const int row = (int)((gid >> 9) % NT); const int dir = (int)(gid / ((size_t)NT * 512));
        int t, T, base; if (row < NL) { t = row & 4095; T = SEQ; base = row - t; } else { t = (row - NL) & 255; T = CTX; base = row - t; }
        const float* cw = P.in[9] + (size_t)dir * 4 * 512 + ch;
        float acc = P.in[10][dir * 512 + ch];
#pragma unroll
        for (int j = 0; j < 4; ++j) { const int tt = dir == 0 ? t - 3 + j : t + 3 - j; if (tt >= 0 && tt < T) acc += cw[j * 512] * Z[(size_t)(base + tt) * ZLD + ch]; }
        WSP(float, WS_XF)[gid] = acc;
    }
}
__device__ __forceinline__ void ph_lru_ab(Fr& F) {
    const Ptrs& P = F.P;
    for (size_t gid = F.gtid; gid < (size_t)2 * NT * 512; gid += F.gsz) {
        const int ch = (int)(gid & 511); const int dir = (int)(gid / ((size_t)NT * 512));
        const int blk = ch >> 6, d = ch & 63;
        const float* xf = WSP(float, WS_XF) + (gid - ch) + blk * 64;
        const float* wr = P.in[11] + ((size_t)dir * 8 + blk) * 64 * 64 + d; const float* wi = P.in[13] + ((size_t)dir * 8 + blk) * 64 * 64 + d;
        float ar = P.in[12][dir * 512 + ch], ai = P.in[14][dir * 512 + ch];
#pragma unroll 8
        for (int c = 0; c < 64; ++c) { const float x = xf[c]; ar += x * wr[c * 64]; ai += x * wi[c * 64]; }
        const float r = sigmoidf_(ar), gi = sigmoidf_(ai);
        const float lam = P.in[15][dir * 512 + ch];
        const float sp = log1pf(__expf(-lam));
        const float log_a = -8.f * r * sp; const float a = __expf(log_a);
        const float bb = sqrtf(-expm1f(2.f * log_a)) * (gi * xf[d]);
        WSP(float, WS_LA)[gid] = a; WSP(float, WS_LB)[gid] = bb;
    }
}
__device__ __forceinline__ void ph_lru_scan(Fr& F) {
    const Ptrs& P = F.P;
    if (F.gtid >= NB * 2 * 512) return;
    const int gid = (int)F.gtid; const int ch = gid & 511, dir = (gid >> 9) & 1, b = gid >> 10;
    const float* LA = WSP(float, WS_LA) + (size_t)dir * NT * 512 + ch; const float* LB = WSP(float, WS_LB) + (size_t)dir * NT * 512 + ch;
    float* LH = WSP(float, WS_LH) + (size_t)dir * NT * 512 + ch;
    float h = 0.f;
#pragma unroll 4
    for (int i = 0; i < CTX; ++i) { const int t = dir == 0 ? i : CTX - 1 - i; const size_t row = NL + b * CTX + t; h = LA[row * 512] * h + LB[row * 512]; LH[row * 512] = h; }
#pragma unroll 4
    for (int i = 0; i < SEQ; ++i) { const int t = dir == 0 ? i : SEQ - 1 - i; const size_t row = (size_t)b * SEQ + t; h = LA[row * 512] * h + LB[row * 512]; LH[row * 512] = h; }
}
__device__ __forceinline__ void ph_lru_out(Fr& F) {
    const Ptrs& P = F.P; const float* LH = WSP(float, WS_LH);
    for (size_t gid = F.gtid; gid < (size_t)NT * 512; gid += F.gsz) {
        const int ch = (int)(gid & 511); const size_t row = gid >> 9;
        const float h = LH[gid] + LH[(size_t)NT * 512 + gid];
        WSP(bf16, WS_YM)[row * D + ch] = (bf16)f2bf(h * gelu_tanh(WSP(float, WS_Z)[row * ZLD + 512 + ch]));
    }
}

__device__ __forceinline__ void ph_oprep(Fr& F) {
    const Ptrs& P = F.P; const int lane = F.lane;
    const float* Z = WSP(float, WS_Z); bf16* QG = WSP(bf16, WS_QG); bf16* KG = WSP(bf16, WS_KG); bf16* VG = WSP(bf16, WS_VG);
    const float* ropeG = WSP(float, WS_ROPEG);
    const float gq = P.in[24][lane], gk = P.in[24][64 + lane];
    for (int r = F.gw; r < NT; r += F.ngw) {
        const float* z = Z + (size_t)r * ZLD; int b, s; row_bs(r, b, s);
        float cs = 1.f, sn = 0.f;
        if (r < NL) { cs = ropeG[((size_t)s * 32 + (lane & 31)) * 2]; sn = ropeG[((size_t)s * 32 + (lane & 31)) * 2 + 1]; }
        if (r < NL) {
#pragma unroll 2
            for (int h = 0; h < 16; ++h) {
                float q = z[h * 64 + lane]; const float rs = rsqrtf(wave_sum(q * q) * (1.f / 64.f) + 1e-6f); q = q * rs * gq;
                const float other = __shfl_xor(q, 32); const float o = lane < 32 ? q * cs - other * sn : q * cs + other * sn;
                QG[(((size_t)b * 16 + h) * SEQ + s) * 64 + lane] = (bf16)f2bf(o); } }
#pragma unroll 2
        for (int h = 0; h < 4; ++h) {
            float k = z[1024 + h * 64 + lane]; const float rs = rsqrtf(wave_sum(k * k) * (1.f / 64.f) + 1e-6f); k = k * rs * gk;
            const float other = __shfl_xor(k, 32); const float o = lane < 32 ? k * cs - other * sn : k * cs + other * sn;
            KG[(((size_t)b * 4 + h) * TA + s) * 64 + lane] = (bf16)f2bf(o);
            VG[(((size_t)b * 4 + h) * TA + s) * 64 + lane] = (bf16)f2bf(z[1280 + h * 64 + lane]); }
    }
}
__device__ __forceinline__ void ph_attn_gqa_naive(Fr& F) {
    const Ptrs& P = F.P;
    const int half = F.tid >> 8, t256 = F.tid & 255;
    for (int u = F.blk * 2 + half; u < NB * 16 * 16; u += F.nblk * 2) {
        const int bh = u >> 4, qb = u & 15, b = bh >> 4, h = bh & 15, kh = h >> 2;
        const int t = qb * 256 + t256;
        const bf16* QG = WSP(bf16, WS_QG); const bf16* KG = WSP(bf16, WS_KG) + ((size_t)b * 4 + kh) * TA * 64; const bf16* VG = WSP(bf16, WS_VG) + ((size_t)b * 4 + kh) * TA * 64;
        float qr[64];
        { const u32x4* q = (const u32x4*)(QG + ((size_t)bh * SEQ + t) * 64);
#pragma unroll
          for (int i = 0; i < 8; ++i) { const u32x4 w = q[i]; qr[8 * i] = bflo(w.x) * 0.125f; qr[8 * i + 1] = bfhi(w.x) * 0.125f; qr[8 * i + 2] = bflo(w.y) * 0.125f; qr[8 * i + 3] = bfhi(w.y) * 0.125f;
              qr[8 * i + 4] = bflo(w.z) * 0.125f; qr[8 * i + 5] = bfhi(w.z) * 0.125f; qr[8 * i + 6] = bflo(w.w) * 0.125f; qr[8 * i + 7] = bfhi(w.w) * 0.125f; } }
        float m = -1e30f, l = 0.f, o[64];
#pragma unroll
        for (int i = 0; i < 64; ++i) o[i] = 0.f;
#pragma unroll 1
        for (int jj = 0; jj < 257 + CTX; ++jj) {
            int j; bool valid = true;
            if (jj < 257) { j = t - 128 + jj; valid = (j >= 0 && j < SEQ); if (!valid) j = 0; } else j = SEQ + (jj - 257);
            const u32x4* kr = (const u32x4*)(KG + (size_t)j * 64);
            float sc = 0.f;
#pragma unroll
            for (int i = 0; i < 8; ++i) { const u32x4 w = kr[i];
                sc += qr[8 * i] * bflo(w.x) + qr[8 * i + 1] * bfhi(w.x) + qr[8 * i + 2] * bflo(w.y) + qr[8 * i + 3] * bfhi(w.y) + qr[8 * i + 4] * bflo(w.z) + qr[8 * i + 5] * bfhi(w.z) + qr[8 * i + 6] * bflo(w.w) + qr[8 * i + 7] * bfhi(w.w); }
            if (!valid) sc = -1e30f;
            const float mn = fmaxf(m, sc), al = __expf(m - mn), p = valid ? __expf(sc - mn) : 0.f;
            l = l * al + p; m = mn;
            const u32x4* vr = (const u32x4*)(VG + (size_t)j * 64);
#pragma unroll
            for (int i = 0; i < 8; ++i) { const u32x4 w = vr[i];
                o[8 * i] = o[8 * i] * al + p * bflo(w.x); o[8 * i + 1] = o[8 * i + 1] * al + p * bfhi(w.x); o[8 * i + 2] = o[8 * i + 2] * al + p * bflo(w.y); o[8 * i + 3] = o[8 * i + 3] * al + p * bfhi(w.y);
                o[8 * i + 4] = o[8 * i + 4] * al + p * bflo(w.z); o[8 * i + 5] = o[8 * i + 5] * al + p * bfhi(w.z); o[8 * i + 6] = o[8 * i + 6] * al + p * bflo(w.w); o[8 * i + 7] = o[8 * i + 7] * al + p * bfhi(w.w); }
        }
        { const float sk = P.in[25][h]; const float mn = fmaxf(m, sk), al = __expf(m - mn); l = l * al + __expf(sk - mn);
          const float il = al / l;
          bf16* y = WSP(bf16, WS_YM) + ((size_t)b * SEQ + t) * D + h * 64;
#pragma unroll
          for (int i = 0; i < 32; ++i) *(unsigned*)(y + 2 * i) = pk2(o[2 * i] * il, o[2 * i + 1] * il); }
    }
}

__device__ __forceinline__ void ph_router(Fr& F, int layer, int nrows) {
    const Ptrs& P = F.P; const int lane = F.lane;
    const float* MOD = WSP(float, WS_MOD); const float* X1 = WSP(float, WS_X1);
    const float* wrt = WSP(float, WS_WRT) + (size_t)layer * 32 * 1024;
    int* cnt = (int*)(P.ws + WS_CTL + CW_CNT) + layer * NE;
    for (int r = F.gw; r < nrows; r += F.ngw) {
        RowV v = load_row(X1 + (size_t)r * D, lane);
        const float* m = MOD + (size_t)(layer * 5 + mod_row(r)) * 6144;
        norm_mod(v, P.in[7] + layer * D, m + 4 * 1024, m + 3 * 1024, lane);
        store_row_bf16(WSP(bf16, WS_F) + (size_t)r * D, v, lane);
        float mylg = -3.4e38f;
#pragma unroll 4
        for (int e = 0; e < NE; ++e) { const f32x4* w = (const f32x4*)(wrt + e * 1024) + lane; float s = 0.f;
#pragma unroll
            for (int j = 0; j < 4; ++j) { const f32x4 wv = w[64 * j]; s += v.v[j].x * wv.x + v.v[j].y * wv.y + v.v[j].z * wv.z + v.v[j].w * wv.w; }
            s = wave_sum(s) + P.in[28][layer * NE + e]; mylg = (lane == e) ? s : mylg; }
        int te[4]; float tv[4];
#pragma unroll
        for (int k = 0; k < 4; ++k) { float bv = mylg; int bi = lane;
#pragma unroll
            for (int o = 1; o < 64; o <<= 1) { const float ov = __shfl_xor(bv, o); const int oi = __shfl_xor(bi, o); const bool take = ov > bv || (ov == bv && oi < bi); bv = take ? ov : bv; bi = take ? oi : bi; }
            te[k] = bi; tv[k] = bv; mylg = (lane == bi) ? -3.4e38f : mylg; }
        const float e1 = __expf(tv[1] - tv[0]), e2 = __expf(tv[2] - tv[0]), e3 = __expf(tv[3] - tv[0]); const float inv = 1.f / (1.f + e1 + e2 + e3);
        const float gate[4] = {inv, e1 * inv, e2 * inv, e3 * inv};
        if (lane < 4) { const int e = lane == 0 ? te[0] : lane == 1 ? te[1] : lane == 2 ? te[2] : te[3]; const float g = lane == 0 ? gate[0] : lane == 1 ? gate[1] : lane == 2 ? gate[2] : gate[3];
            const int slot = atomicAdd(&cnt[e], 1);
            WSP(int, WS_TOK)[(size_t)e * NT + slot] = r;
            WSP(int, WS_PE)[r * 4 + lane] = e; WSP(int, WS_PS)[r * 4 + lane] = slot; WSP(float, WS_PG)[r * 4 + lane] = g; }
    }
}
template <int MODE>
__device__ __forceinline__ void ph_combine(Fr& F, int layer, int nrows) {
    const Ptrs& P = F.P; const int lane = F.lane;
    moe_prefix(F, layer);
    const int* pre = (const int*)(F.lds + LDS_MISC + 64);
    const float* MOD = WSP(float, WS_MOD); const float* X1 = WSP(float, WS_X1); const bf16* Y = WSP(bf16, WS_Y);
    for (int r = F.gw; r < nrows; r += F.ngw) {
        RowV v = load_row(X1 + (size_t)r * D, lane);
        const float* g2 = MOD + (size_t)(layer * 5 + mod_row(r)) * 6144 + 5 * 1024;
        RowV acc;
#pragma unroll
        for (int j = 0; j < 4; ++j) acc.v[j] = (f32x4){0.f, 0.f, 0.f, 0.f};
#pragma unroll
        for (int k = 0; k < 4; ++k) { const int e = WSP(int, WS_PE)[r * 4 + k], slot = WSP(int, WS_PS)[r * 4 + k]; const float g = WSP(float, WS_PG)[r * 4 + k];
            const u32x2* y = (const u32x2*)(Y + ((size_t)pre[e] * 256 + slot) * D) + lane;
#pragma unroll
            for (int j = 0; j < 4; ++j) { const u32x2 w = y[64 * j]; acc.v[j] += (f32x4){bflo(w.x), bfhi(w.x), bflo(w.y), bfhi(w.y)} * g; } }
#pragma unroll
        for (int j = 0; j < 4; ++j) v.v[j] += ((const f32x4*)g2)[lane + 64 * j] * acc.v[j];
        if (MODE == 0) {
            f32x4* xo = (f32x4*)(WSP(float, WS_X2) + (size_t)r * D) + lane;
#pragma unroll
            for (int j = 0; j < 4; ++j) xo[64 * j] = v.v[j];
            const float* m = MOD + (size_t)(1 * 5 + mod_row(r)) * 6144;
            norm_mod(v, P.in[6] + D, m + 1024, m, lane);
            store_row_bf16(WSP(bf16, WS_HN) + (size_t)r * D, v, lane);
        } else {
            f32x4* xo = (f32x4*)(P.out + (size_t)r * D) + lane;
#pragma unroll
            for (int j = 0; j < 4; ++j) xo[64 * j] = v.v[j];
        }
    }
}

constexpr int NPHASE = 20;
struct Args { Ptrs P; int ph_lo, ph_hi; };
__global__ void __launch_bounds__(NTHR, 2) mk_fwd(Args args) {
    extern __shared__ __attribute__((aligned(16))) unsigned char lds[];
    Fr F; F.P = args.P; F.lds = lds;
    F.tid = threadIdx.x; F.lane = F.tid & 63; F.wave = __builtin_amdgcn_readfirstlane(F.tid >> 6);
    F.nblk = gridDim.x; F.blk = blockIdx.x; F.gw = F.blk * NWAVES + F.wave; F.ngw = F.nblk * NWAVES;
    F.gtid = (size_t)F.blk * NTHR + F.tid; F.gsz = (size_t)F.nblk * NTHR;
    const Ptrs& P = F.P;
    if (F.tid < 64) ((unsigned*)(lds + LDS_MISC))[F.tid] = 0u;
    __syncthreads();
    const int lo = args.ph_lo, hi = args.ph_hi;
    XcdBarrier bar; bar.bar = (unsigned*)(P.ws + WS_CTL); bar.x = 0; bar.st = nullptr;
    if (hi - lo > 1) bar = xcd_barrier_post((unsigned*)(P.ws + WS_CTL), (volatile LAS unsigned*)(lds + LDS_MISC));
#define IN(k) (lo <= (k) && (k) < hi)
#define SEAM(k) do { if (IN(k) && IN((k) + 1)) xcd_barrier(bar); } while (0)
    const float* MOD = WSP(float, WS_MOD);
    if (IN(0)) { ph_prologue(F); } SEAM(0);
    if (IN(1)) { ph_norm0(F); } SEAM(1);
    if (IN(2)) { ph_gemm(F, WSP(bf16, WS_HN), 1024, WSP(bf16, WS_WIN), 1024, NT, 1536, 1024, GF32{EpiF32{WSP(float, WS_Z), ZLD, EVEN_IN}}); } SEAM(2);
    if (IN(3)) { ph_e3(F); ph_lru_xf(F); } SEAM(3);
    if (IN(4)) { ph_gemm(F, WSP(bf16, WS_QKVN), 384, WSP(bf16, WS_WQKVB), 384, NT, 1792, 384, GF32{EpiF32{WSP(float, WS_QKVR), 1792, 1792}}); ph_lru_ab(F); } SEAM(4);
    if (IN(5)) { ph_lru_scan(F); ph_e5(F); } SEAM(5);
    if (IN(6)) { ph_lru_out(F); ph_attn_mla_naive(F); } SEAM(6);
    if (IN(7)) { ph_gemm(F, WSP(bf16, WS_YM), 1024, WSP(bf16, WS_WOE), 1024, NT, 1024, 1024, GResid{EpiResid{P.in[0], P.in[2], WSP(float, WS_X1), MOD + 2 * 1024}}); } SEAM(7);
    if (IN(8)) { ph_router(F, 0, NT); } SEAM(8);
    if (IN(9)) { ph_moe_gemm<1>(F, 0); } SEAM(9);
    if (IN(10)) { ph_moe_gemm<2>(F, 0); } SEAM(10);
    if (IN(11)) { ph_combine<0>(F, 0, NT); } SEAM(11);
    if (IN(12)) { ph_gemm(F, WSP(bf16, WS_HN), 1024, WSP(bf16, WS_WQO), 1024, NT, 1536, 1024, GF32{EpiF32{WSP(float, WS_Z), ZLD, 1536}}); } SEAM(12);
    if (IN(13)) { ph_oprep(F); } SEAM(13);
    if (IN(14)) { ph_attn_gqa_naive(F); } SEAM(14);
    if (IN(15)) { ph_gemm(F, WSP(bf16, WS_YM), 1024, WSP(bf16, WS_WOO), 1024, NL, 1024, 1024, GResid{EpiResid{WSP(float, WS_X2), WSP(float, WS_X2) + (size_t)NL * D, WSP(float, WS_X1), MOD + 5 * 6144 + 2 * 1024}}); } SEAM(15);
    if (IN(16)) { ph_router(F, 1, NL); } SEAM(16);
    if (IN(17)) { ph_moe_gemm<1>(F, 1); } SEAM(17);
    if (IN(18)) { ph_moe_gemm<2>(F, 1); } SEAM(18);
    if (IN(19)) { ph_combine<1>(F, 1, NL); }
#undef IN
#undef SEAM
}

#ifndef MK_N_LAUNCHES
#define MK_N_LAUNCHES 1
#endif
extern "C" void kernel_launch(void* const* d_in, const int* in_sizes, int n_in, void* d_out, int out_size, void* d_ws, size_t ws_size, hipStream_t stream) {
    static int grid = 0;
    if (grid == 0) {
        if (n_in != 33 || ws_size < WS_END) { fprintf(stderr, "kernel_launch: unexpected n_in %d or ws_size %zu < %zu\n", n_in, ws_size, (size_t)WS_END); grid = -1; return; }
        int dev = 0, cus = 0, per_cu = 0;
        if (hipGetDevice(&dev) != hipSuccess || hipDeviceGetAttribute(&cus, hipDeviceAttributeMultiprocessorCount, dev) != hipSuccess) { grid = -1; return; }
        if (hipFuncSetAttribute((const void*)mk_fwd, hipFuncAttributeMaxDynamicSharedMemorySize, LDS_BYTES) != hipSuccess) { fprintf(stderr, "kernel_launch: hipFuncSetAttribute failed\n"); grid = -1; return; }
        if (hipOccupancyMaxActiveBlocksPerMultiprocessor(&per_cu, (const void*)mk_fwd, NTHR, LDS_BYTES) != hipSuccess || per_cu < 1) { fprintf(stderr, "kernel_launch: occupancy query says %d blocks per CU\n", per_cu); grid = -1; return; }
        (void)hipGetLastError();
        grid = cus;
    }
    if (grid < 0) return;
    Args a{};
    for (int i = 0; i < 33; ++i) a.P.in[i] = (const float*)d_in[i];
    a.P.out = (float*)d_out; a.P.ws = (unsigned char*)d_ws;
    (void)hipMemsetAsync((unsigned char*)d_ws + WS_CTL, 0, CTL_BYTES, stream);
    if (MK_N_LAUNCHES == 1) { a.ph_lo = 0; a.ph_hi = NPHASE; hipLaunchKernelGGL(mk_fwd, dim3(grid), dim3(NTHR), LDS_BYTES, stream, a); }
    else for (int p = 0; p < NPHASE; ++p) { a.ph_lo = p; a.ph_hi = p + 1; hipLaunchKernelGGL(mk_fwd, dim3(grid), dim3(NTHR), LDS_BYTES, stream, a); }
}
```

```cpp
#include <hip/hip_runtime.h>
#include <stdint.h>
#include <stdio.h>

typedef unsigned short bf16;
typedef short bf16x8 __attribute__((ext_vector_type(8)));
typedef float f32x4 __attribute__((ext_vector_type(4)));
typedef float f32x16 __attribute__((ext_vector_type(16)));
typedef unsigned u32x2 __attribute__((ext_vector_type(2)));
typedef unsigned u32x4 __attribute__((ext_vector_type(4)));

constexpr int D = 1024, NB = 4, SEQ = 4096, CTX = 256;
constexpr int NL = NB * SEQ, NC = NB * CTX, NT = NL + NC;
constexpr int TA = SEQ + CTX;
constexpr int NE = 32, TOPK = 4;
constexpr int EVEN_IN = 1440, ZLD = 1536;
constexpr int MAXT256 = 304;
constexpr int ACT_ROWS = MAXT256 * 256;

constexpr size_t al256(size_t x) { return (x + 255) & ~(size_t)255; }
constexpr size_t WS_CTL = 0, CTL_BYTES = 1u << 20;
constexpr size_t CW_CNT = 65536;
constexpr size_t WS_MOD = WS_CTL + CTL_BYTES;
constexpr size_t WS_ROPEM = al256(WS_MOD + 2 * 5 * 6144 * 4);
constexpr size_t WS_ROPEG = al256(WS_ROPEM + 4096 * 16 * 2 * 4);
constexpr size_t WS_WRT = al256(WS_ROPEG + 4096 * 32 * 2 * 4);
constexpr size_t WS_WRI = al256(WS_WRT + 2 * 32 * 1024 * 4);
constexpr size_t WS_WIN = al256(WS_WRI + 2 * 8 * 128 * 64 * 2);
constexpr size_t WS_WQKVB = al256(WS_WIN + 1536 * 1024 * 2);
constexpr size_t WS_WOE = al256(WS_WQKVB + 1792 * 384 * 2);
constexpr size_t WS_WQO = al256(WS_WOE + 1024 * 1024 * 2);
constexpr size_t WS_WOO = al256(WS_WQO + 1536 * 1024 * 2);
constexpr size_t WS_WGU = al256(WS_WOO + 1024 * 1024 * 2);
constexpr size_t WS_WDN = al256(WS_WGU + (size_t)2 * 32 * 2048 * 1024 * 2);
constexpr size_t WS_HN = al256(WS_WDN + (size_t)2 * 32 * 1024 * 1024 * 2);
constexpr size_t WS_Z = al256(WS_HN + (size_t)NT * D * 2);
constexpr size_t WS_QKVN = al256(WS_Z + (size_t)NT * ZLD * 4);
constexpr size_t WS_QKVR = al256(WS_QKVN + (size_t)NT * 384 * 2);
constexpr size_t WS_QM = al256(WS_QKVR + (size_t)NT * 1792 * 4);
constexpr size_t WS_KM = al256(WS_QM + (size_t)NB * 8 * TA * 96 * 2);
constexpr size_t WS_VM = al256(WS_KM + (size_t)NB * 8 * TA * 96 * 2);
constexpr size_t WS_QG = al256(WS_VM + (size_t)NB * 8 * TA * 64 * 2);
constexpr size_t WS_KG = al256(WS_QG + (size_t)NB * 16 * SEQ * 64 * 2);
constexpr size_t WS_VG = al256(WS_KG + (size_t)NB * 4 * TA * 64 * 2);
constexpr size_t WS_YM = al256(WS_VG + (size_t)NB * 4 * TA * 64 * 2);
constexpr size_t WS_X1 = al256(WS_YM + (size_t)NT * D * 2);
constexpr size_t WS_X2 = al256(WS_X1 + (size_t)NT * D * 4);
constexpr size_t WS_F = al256(WS_X2 + (size_t)NT * D * 4);
constexpr size_t WS_LA = al256(WS_F + (size_t)NT * D * 2);
constexpr size_t WS_LB = al256(WS_LA + (size_t)2 * NT * 512 * 4);
constexpr size_t WS_LH = al256(WS_LB + (size_t)2 * NT * 512 * 4);
constexpr size_t WS_XF = al256(WS_LH + (size_t)2 * NT * 512 * 4);
constexpr size_t WS_PE = al256(WS_XF + (size_t)2 * NT * 512 * 4);
constexpr size_t WS_PS = al256(WS_PE + (size_t)NT * 4 * 4);
constexpr size_t WS_PG = al256(WS_PS + (size_t)NT * 4 * 4);
constexpr size_t WS_TOK = al256(WS_PG + (size_t)NT * 4 * 4);
constexpr size_t WS_ACT = al256(WS_TOK + (size_t)NE * NT * 4);
constexpr size_t WS_Y = al256(WS_ACT + (size_t)ACT_ROWS * D * 2);
constexpr size_t WS_END = al256(WS_Y + (size_t)ACT_ROWS * D * 2);

__device__ __forceinline__ unsigned f2bf(float f) { unsigned u = __float_as_uint(f); u += 0x7FFFu + ((u >> 16) & 1u); return u >> 16; }
typedef float f32x2_t __attribute__((ext_vector_type(2)));
typedef __bf16 bf16x2_t __attribute__((ext_vector_type(2)));
__device__ __forceinline__ unsigned pk2(float a, float b) { const f32x2_t v = {a, b}; return __builtin_bit_cast(unsigned, __builtin_convertvector(v, bf16x2_t)); }
__device__ __forceinline__ float bf2f(unsigned b) { return __uint_as_float(b << 16); }
__device__ __forceinline__ float bflo(unsigned u) { return __uint_as_float(u << 16); }
__device__ __forceinline__ float bfhi(unsigned u) { return __uint_as_float(u & 0xffff0000u); }
__device__ __forceinline__ float wave_sum(float v) {
#pragma unroll
    for (int o = 1; o < 64; o <<= 1) v += __shfl_xor(v, o);
    return v;
}
__device__ __forceinline__ float sigmoidf_(float x) { return 1.f / (1.f + __expf(-x)); }
__device__ __forceinline__ float gelu_tanh(float x) { const float u = 0.7978845608028654f * (x + 0.044715f * x * x * x); return 0.5f * x * (1.f + tanhf(u)); }
__device__ __forceinline__ int mod_row(int r) { return r < NL ? (r >> 12) : 4; }
__device__ __forceinline__ void row_bs(int r, int& b, int& s) { if (r < NL) { b = r >> 12; s = r & 4095; } else { const int rc = r - NL; b = rc >> 8; s = SEQ + (rc & 255); } }


struct Ptrs {
    const float* in[33];
    float* out;
    unsigned char* ws;
};
#define WSP(T, off) ((T*)(P.ws + (off)))
#define LAS __attribute__((address_space(3)))

#define XB_TMO      128
#define XB_XCNT(j)  (256  + 64 * (j))
#define XB_XSUB(j)  (1280 + 64 * (j))
#define XB_XGEN(j)  (2304 + 64 * (j))
#define XB_TOP      3328
#define XB_TOPGEN   3392
#define XCD_BAR_WORDS 3456
#define XB_SPIN_CAP (1u << 18)
__device__ __forceinline__ unsigned xb_ld(unsigned* p)              { return __hip_atomic_load(p, __ATOMIC_RELAXED, __HIP_MEMORY_SCOPE_AGENT); }
__device__ __forceinline__ unsigned xb_add(unsigned* p, unsigned v) { return __hip_atomic_fetch_add(p, v, __ATOMIC_RELAXED, __HIP_MEMORY_SCOPE_AGENT); }
__device__ __forceinline__ unsigned xb_xcc_id() { return (unsigned)__builtin_amdgcn_s_getreg((3 << 11) | 20) & 0xFu; }
#define XB_SPIN(cond, bar) do { unsigned _sp = 0; while (cond) { __builtin_amdgcn_s_sleep(1); \
    if ((++_sp & 255u) == 0u) { if (xb_ld(&(bar)[XB_TMO])) break; if (_sp > XB_SPIN_CAP) { atomicAdd(&(bar)[XB_TMO], 1u); break; } } } } while (0)
struct XcdBarrier { unsigned* bar; unsigned x; volatile LAS unsigned* st; };
__device__ __forceinline__ XcdBarrier xcd_barrier_post(unsigned* bar, volatile LAS unsigned* st) {
    XcdBarrier b; b.bar = bar; b.x = xb_xcc_id(); b.st = st;
    if (threadIdx.x == 0) (void)xb_add(&bar[XB_XCNT(b.x)], 1u);
    return b;
}
__device__ __forceinline__ void xcd_barrier_complete(unsigned* bar, unsigned x, unsigned& nloc, unsigned& nx) {
    const unsigned G = gridDim.x * gridDim.y * gridDim.z;
    unsigned sum, cnt, mine, sp = 0u;
    for (;;) {
        sum = 0u; cnt = 0u; mine = 0u;
#pragma unroll
        for (unsigned j = 0; j < 16; ++j) { const unsigned c = xb_ld(&bar[XB_XCNT(j)]); sum += c; cnt += (c > 0u) ? 1u : 0u; mine = (j == x) ? c : mine; }
        if (sum == G) break;
        __builtin_amdgcn_s_sleep(1);
        if ((++sp & 255u) == 0u) { if (xb_ld(&bar[XB_TMO])) break; if (sp > XB_SPIN_CAP) { atomicAdd(&bar[XB_TMO], 1u); break; } }
    }
    nloc = mine > 0u ? mine : 1u; nx = cnt > 0u ? cnt : 1u;
}
__device__ __forceinline__ void xcd_barrier(const XcdBarrier& b) {
    asm volatile("s_waitcnt vmcnt(0)" ::: "memory");
    __syncthreads();
    if (threadIdx.x == 0) {
        unsigned* bar = b.bar;
        __builtin_amdgcn_s_waitcnt(0);
        unsigned nloc = b.st[0], nx = b.st[1];
        if (nloc == 0u) { xcd_barrier_complete(bar, b.x, nloc, nx); b.st[0] = nloc; b.st[1] = nx; }
        const unsigned old = xb_add(&bar[XB_XSUB(b.x)], 1u);
        const unsigned gen = old / nloc;
        if (old + 1u == (gen + 1u) * nloc) {
            __builtin_amdgcn_fence(__ATOMIC_RELEASE, "agent");
            asm volatile("s_waitcnt vmcnt(0)" ::: "memory");
            const unsigned og = xb_add(&bar[XB_TOP], 1u);
            const unsigned tg = og / nx;
            if (og + 1u == (tg + 1u) * nx) xb_add(&bar[XB_TOPGEN], 1u);
            else XB_SPIN(xb_ld(&bar[XB_TOPGEN]) == tg, bar);
            __builtin_amdgcn_fence(__ATOMIC_ACQUIRE, "agent");
            xb_add(&bar[XB_XGEN(b.x)], 1u);
            asm volatile("s_waitcnt vmcnt(0)" ::: "memory");
        } else {
            XB_SPIN(xb_ld(&bar[XB_XGEN(b.x)]) == gen, bar);
            __builtin_amdgcn_fence(__ATOMIC_ACQUIRE, "agent");
            asm volatile("s_waitcnt vmcnt(0)" ::: "memory");
        }
    }
    __syncthreads();
}

constexpr int NTHR = 512, NWAVES = 8;
constexpr int LDS_RING = 131072;
constexpr int LDS_MISC = LDS_RING;
constexpr int LDS_BYTES = LDS_RING + 4096;
struct Fr {
    Ptrs P; unsigned char* lds;
    int tid, lane, wave, gw, ngw, nblk, blk; size_t gtid, gsz;
};

__device__ __forceinline__ void transpose_item(const float* W, int ldw, bf16* WT, int ldt, int k0, int n0, int row_off, int col_off, int map, float* scr, int lane) {
#pragma unroll 8
    for (int i = 0; i < 32; ++i) { const int kk = 2 * i + (lane >> 5); scr[kk * 33 + (lane & 31)] = W[(size_t)(k0 + kk) * ldw + n0 + (lane & 31)]; }
    __builtin_amdgcn_s_waitcnt(0xc07f); asm volatile("" ::: "memory");
    const int c = lane & 7;
#pragma unroll
    for (int j = 0; j < 4; ++j) { const int n = (lane >> 3) + 8 * j; const float* s = scr + (8 * c) * 33 + n;
        u32x4 o; o.x = pk2(s[0 * 33], s[1 * 33]); o.y = pk2(s[2 * 33], s[3 * 33]); o.z = pk2(s[4 * 33], s[5 * 33]); o.w = pk2(s[6 * 33], s[7 * 33]);
        int nn = n0 + n;
        if (map == 1) { const int up = nn >= 1024, jj = nn & 1023; nn = (jj >> 4) * 32 + up * 16 + (jj & 15); }
        *(u32x4*)(WT + (size_t)(row_off + nn) * ldt + col_off + k0 + 8 * c) = o; }
    __builtin_amdgcn_s_waitcnt(0xc07f); asm volatile("" ::: "memory");
}
struct TJob { const float* W; bf16* WT; int K, N, ldw, ldt, row_off, col_off, map; long wstride, tstride; int count; };
constexpr int NJOBS = 8;
__device__ __forceinline__ TJob get_job(const Ptrs& P, int j) {
    TJob t; t.row_off = 0; t.col_off = 0; t.map = 0; t.wstride = 0; t.tstride = 0; t.count = 1;
    switch (j) {
    case 0: t.W = P.in[29]; t.WT = WSP(bf16, WS_WGU); t.K = 1024; t.N = 2048; t.ldw = 2048; t.ldt = 1024; t.map = 1; t.wstride = (long)1024 * 2048; t.tstride = (long)2048 * 1024; t.count = 64; break;
    case 1: t.W = P.in[31]; t.WT = WSP(bf16, WS_WDN); t.K = 1024; t.N = 1024; t.ldw = 1024; t.ldt = 1024; t.wstride = (long)1024 * 1024; t.tstride = (long)1024 * 1024; t.count = 64; break;
    case 2: t.W = P.in[8]; t.WT = WSP(bf16, WS_WIN); t.K = 1024; t.N = 1440; t.ldw = 1440; t.ldt = 1024; break;
    case 3: t.W = P.in[17]; t.WT = WSP(bf16, WS_WQKVB); t.K = 256; t.N = 768; t.ldw = 768; t.ldt = 384; break;
    case 4: t.W = P.in[19]; t.WT = WSP(bf16, WS_WQKVB); t.K = 128; t.N = 1024; t.ldw = 1024; t.ldt = 384; t.row_off = 768; t.col_off = 256; break;
    case 5: t.W = P.in[22]; t.WT = WSP(bf16, WS_WOE); t.K = 1024; t.N = 1024; t.ldw = 1024; t.ldt = 1024; break;
    case 6: t.W = P.in[23]; t.WT = WSP(bf16, WS_WQO); t.K = 1024; t.N = 1536; t.ldw = 1536; t.ldt = 1024; break;
    default: t.W = P.in[26]; t.WT = WSP(bf16, WS_WOO); t.K = 1024; t.N = 1024; t.ldw = 1024; t.ldt = 1024; break;
    }
    return t;
}
__device__ __forceinline__ void ph_prologue(Fr& F) {
    const Ptrs& P = F.P;
    if (F.blk < 24) {
        float* sl = (float*)(F.lds + 8 * 64 * 33 * 4);
        const float* c = P.in[1]; const float* cc = P.in[3];
        for (int i = F.tid; i < 5 * 1024; i += NTHR) { const int r = i >> 10, k = i & 1023; const float v = r < 4 ? c[r * 1024 + k] : cc[k]; sl[i] = v / (1.f + __expf(-v)); }
        __syncthreads();
        const int gid = F.blk * NTHR + F.tid, l = gid / 6144, j = gid % 6144;
        const float* w = P.in[4] + (size_t)l * 1024 * 6144 + j;
        float acc[5] = {0.f, 0.f, 0.f, 0.f, 0.f};
#pragma unroll 8
        for (int k = 0; k < 1024; ++k) { const float wv = w[(size_t)k * 6144];
#pragma unroll
            for (int r = 0; r < 5; ++r) acc[r] += sl[r * 1024 + k] * wv; }
        float* MOD = WSP(float, WS_MOD);
        const float bm = P.in[5][l * 6144 + j];
#pragma unroll
        for (int r = 0; r < 5; ++r) MOD[(l * 5 + r) * 6144 + j] = acc[r] + bm;
    }
    for (size_t gid = F.gtid; gid < 4096 * 48; gid += F.gsz) {
        const int s = (int)(gid / 48), i = (int)(gid % 48); const int row = s >> 6, col = s & 63;
        if (i < 16) { const int fi = i & 7; const float fr = powf(10000.f, -(float)fi / 8.f); const float ang = (float)(i < 8 ? row : col) * fr;
            float* T = WSP(float, WS_ROPEM) + ((size_t)s * 16 + i) * 2; T[0] = cosf(ang); T[1] = sinf(ang); }
        else { const int ii = i - 16, fi = ii & 15; const float fr = powf(10000.f, -(float)fi / 16.f); const float ang = (float)(ii < 16 ? row : col) * fr;
            float* T = WSP(float, WS_ROPEG) + ((size_t)s * 32 + ii) * 2; T[0] = cosf(ang); T[1] = sinf(ang); }
    }
    for (size_t gid = F.gtid; gid < 2 * 32 * 1024; gid += F.gsz) { const int l = (int)(gid >> 15), e = (int)(gid >> 10) & 31, k = (int)gid & 1023;
        WSP(float, WS_WRT)[gid] = P.in[27][((size_t)l * 1024 + k) * 32 + e]; }
    for (size_t gid = F.gtid; gid < 2 * 8 * 128 * 64; gid += F.gsz) { const int c = (int)gid & 63, o = (int)(gid >> 6) & 127, blk = (int)(gid >> 13) & 7, dir = (int)(gid >> 16);
        const float* src = o < 64 ? P.in[11] : P.in[13];
        WSP(bf16, WS_WRI)[gid] = (bf16)f2bf(src[(((size_t)dir * 8 + blk) * 64 + c) * 64 + (o & 63)]); }
    { u32x4* z = (u32x4*)(WSP(bf16, WS_WIN) + (size_t)1440 * 1024); for (size_t i = F.gtid; i < (size_t)96 * 1024 * 2 / 16; i += F.gsz) z[i] = (u32x4){0u, 0u, 0u, 0u};
      bf16* q = WSP(bf16, WS_WQKVB);
      for (size_t i = F.gtid; i < (size_t)768 * 16; i += F.gsz) { const int r = (int)(i >> 4), c = (int)(i & 15); *(u32x4*)(q + (size_t)r * 384 + 256 + c * 8) = (u32x4){0u, 0u, 0u, 0u}; }
      for (size_t i = F.gtid; i < (size_t)1024 * 32; i += F.gsz) { const int r = (int)(i >> 5), c = (int)(i & 31); *(u32x4*)(q + (size_t)(768 + r) * 384 + c * 8) = (u32x4){0u, 0u, 0u, 0u}; } }
    float* scr = (float*)(F.lds + F.wave * 64 * 33 * 4);
    long base = 0;
#pragma unroll 1
    for (int j = 0; j < NJOBS; ++j) {
        const TJob t = get_job(P, j);
        const int nnb = t.N / 32; const long per = (long)(t.K / 64) * nnb, total = per * t.count;
        long first = ((long)F.gw - base % F.ngw + F.ngw) % F.ngw;
        for (long it = first; it < total; it += F.ngw) {
            const int m = (int)(it / per); const int r = (int)(it % per); const int kb = r / nnb, nb = r % nnb;
            transpose_item(t.W + (size_t)m * t.wstride, t.ldw, t.WT + (size_t)m * t.tstride, t.ldt, kb * 64, nb * 32, t.row_off, t.col_off, t.map, scr, F.lane);
        }
        base += total;
    }
}

struct RowV { f32x4 v[4]; };
__device__ __forceinline__ RowV load_row(const float* p, int lane) { RowV r; const f32x4* q = (const f32x4*)p + lane;
#pragma unroll
    for (int j = 0; j < 4; ++j) r.v[j] = q[64 * j]; return r; }
__device__ __forceinline__ void norm_mod(RowV& r, const float* g, const float* sc, const float* sh, int lane) {
    float s = 0.f;
#pragma unroll
    for (int j = 0; j < 4; ++j) s += r.v[j].x * r.v[j].x + r.v[j].y * r.v[j].y + r.v[j].z * r.v[j].z + r.v[j].w * r.v[j].w;
    const float rs = rsqrtf(wave_sum(s) * (1.f / D) + 1e-6f);
#pragma unroll
    for (int j = 0; j < 4; ++j) { const f32x4 gv = ((const f32x4*)g)[lane + 64 * j], scv = ((const f32x4*)sc)[lane + 64 * j], shv = ((const f32x4*)sh)[lane + 64 * j];
        r.v[j] = (r.v[j] * rs * gv) * (scv + 1.f) + shv; }
}
__device__ __forceinline__ void store_row_bf16(bf16* p, const RowV& r, int lane) { u32x2* q = (u32x2*)p + lane;
#pragma unroll
    for (int j = 0; j < 4; ++j) { u32x2 o; o.x = pk2(r.v[j].x, r.v[j].y); o.y = pk2(r.v[j].z, r.v[j].w); q[64 * j] = o; } }
__device__ __forceinline__ const float* xrow0(const Ptrs& P, int r) { return r < NL ? P.in[0] + (size_t)r * D : P.in[2] + (size_t)(r - NL) * D; }

__device__ __forceinline__ void ph_norm0(Fr& F) {
    const Ptrs& P = F.P; const float* MOD = WSP(float, WS_MOD);
    for (int r = F.gw; r < NT; r += F.ngw) {
        RowV v = load_row(xrow0(P, r), F.lane);
        const float* m = MOD + (size_t)mod_row(r) * 6144;
        norm_mod(v, P.in[6], m + 1024, m, F.lane);
        store_row_bf16(WSP(bf16, WS_HN) + (size_t)r * D, v, F.lane);
    }
}

__device__ __forceinline__ void wtile(const bf16* a0, const bf16* a1, const bf16* b0, const bf16* b1, int K, f32x4 (&acc)[2][2]) {
#pragma unroll
    for (int m = 0; m < 2; ++m)
#pragma unroll
        for (int n = 0; n < 2; ++n) acc[m][n] = (f32x4){0.f, 0.f, 0.f, 0.f};
#pragma unroll 2
    for (int k = 0; k < K; k += 32) {
        const bf16x8 A0 = *(const bf16x8*)(a0 + k), A1 = *(const bf16x8*)(a1 + k), B0 = *(const bf16x8*)(b0 + k), B1 = *(const bf16x8*)(b1 + k);
        acc[0][0] = __builtin_amdgcn_mfma_f32_16x16x32_bf16(B0, A0, acc[0][0], 0, 0, 0);
        acc[0][1] = __builtin_amdgcn_mfma_f32_16x16x32_bf16(B1, A0, acc[0][1], 0, 0, 0);
        acc[1][0] = __builtin_amdgcn_mfma_f32_16x16x32_bf16(B0, A1, acc[1][0], 0, 0, 0);
        acc[1][1] = __builtin_amdgcn_mfma_f32_16x16x32_bf16(B1, A1, acc[1][1], 0, 0, 0);
    }
}
struct EpiF32 { float* C; int ldc, nvalid;
    __device__ __forceinline__ void operator()(int row, int col, f32x4 a, f32x4 b) const {
        if (col < nvalid) *(f32x4*)(C + (size_t)row * ldc + col) = a;
        if (col + 16 < nvalid) *(f32x4*)(C + (size_t)row * ldc + col + 16) = b; } };
struct EpiResid { const float* xin0; const float* xin1; float* xout; const float* g;
    __device__ __forceinline__ void operator()(int row, int col, f32x4 a, f32x4 b) const {
        const float* xi = row < NL ? xin0 + (size_t)row * D : xin1 + (size_t)(row - NL) * D; const float* gg = g + (size_t)mod_row(row) * 6144;
        float* xo = xout + (size_t)row * D;
        *(f32x4*)(xo + col) = *(const f32x4*)(xi + col) + *(const f32x4*)(gg + col) * a;
        *(f32x4*)(xo + col + 16) = *(const f32x4*)(xi + col + 16) + *(const f32x4*)(gg + col + 16) * b; } };
struct EpiSwiglu { bf16* act; const float* bias;
    __device__ __forceinline__ void operator()(int row, int col, f32x4 a, f32x4 b) const {
        const int j = (col >> 5) * 16 + (col & 15);
        const f32x4 bg = *(const f32x4*)(bias + j), bu = *(const f32x4*)(bias + 1024 + j);
        float o[4];
#pragma unroll
        for (int i = 0; i < 4; ++i) { float hg = a[i] + bg[i], hu = b[i] + bu[i]; hg = fminf(hg, 7.f); hu = fminf(fmaxf(hu, -7.f), 7.f);
            o[i] = hg * sigmoidf_(1.702f * hg) * (hu + 1.f); }
        u32x2 w; w.x = pk2(o[0], o[1]); w.y = pk2(o[2], o[3]);
        *(u32x2*)(act + (size_t)row * D + j) = w; } };
struct EpiBiasBf16 { bf16* Y; const float* bias;
    __device__ __forceinline__ void operator()(int row, int col, f32x4 a, f32x4 b) const {
        const f32x4 b0 = *(const f32x4*)(bias + col), b1 = *(const f32x4*)(bias + col + 16);
        u32x2 w; w.x = pk2(a[0] + b0[0], a[1] + b0[1]); w.y = pk2(a[2] + b0[2], a[3] + b0[3]); *(u32x2*)(Y + (size_t)row * D + col) = w;
        w.x = pk2(b[0] + b1[0], b[1] + b1[1]); w.y = pk2(b[2] + b1[2], b[3] + b1[3]); *(u32x2*)(Y + (size_t)row * D + col + 16) = w; } };

template <class Epi>
__device__ __forceinline__ void ph_sgemm(Fr& F, const bf16* A, int lda, const bf16* Bt, int ldb, int M, int N, int K, const Epi& E) {
    const int fr = F.lane & 15, fq = F.lane >> 4; const int ng = N / 32, nt = (M / 32) * ng;
    for (int t = F.gw; t < nt; t += F.ngw) {
        const int row0 = (t / ng) * 32, col0 = (t % ng) * 32;
        f32x4 acc[2][2];
        wtile(A + (size_t)(row0 + fr) * lda + 8 * fq, A + (size_t)(row0 + 16 + fr) * lda + 8 * fq,
              Bt + (size_t)(col0 + fr) * ldb + 8 * fq, Bt + (size_t)(col0 + 16 + fr) * ldb + 8 * fq, K, acc);
#pragma unroll
        for (int m = 0; m < 2; ++m) E(row0 + m * 16 + fr, col0 + 4 * fq, acc[m][0], acc[m][1]);
    }
}
__device__ __forceinline__ void moe_prefix(Fr& F, int layer) {
    int* pre = (int*)(F.lds + LDS_MISC + 64);
    const int* cnt = (const int*)(F.P.ws + WS_CTL + CW_CNT) + layer * NE;
    __syncthreads();
    if (F.tid == 0) { int s = 0; for (int e = 0; e < NE; ++e) { pre[e] = s; s += (cnt[e] + 255) >> 8; } pre[NE] = s; }
    __syncthreads();
}
__device__ __forceinline__ int moe_find(const int* pre, int t256) { int e = 0;
#pragma unroll 1
    for (int i = 0; i < NE; ++i) e = (pre[i + 1] <= t256) ? i + 1 : e;
    return e; }
template <int STAGE>
__device__ __forceinline__ void ph_moe_sgemm(Fr& F, int layer) {
    const Ptrs& P = F.P;
    moe_prefix(F, layer);
    const int* pre = (const int*)(F.lds + LDS_MISC + 64);
    const int* cnt = (const int*)(P.ws + WS_CTL + CW_CNT) + layer * NE;
    const int fr = F.lane & 15, fq = F.lane >> 4;
    constexpr int N = STAGE == 1 ? 2048 : 1024, ng = N / 32;
    const int nt = pre[NE] * 8 * ng;
    const int* toklist = WSP(int, WS_TOK);
    for (int t = F.gw; t < nt; t += F.ngw) {
        const int t256 = t / (8 * ng), rem = t % (8 * ng), sub = rem / ng, g = rem % ng;
        const int e = moe_find(pre, t256), mt = t256 - pre[e];
        const int row0 = t256 * 256 + sub * 32, col0 = g * 32;
        f32x4 acc[2][2];
        if (STAGE == 1) {
            const int s0 = mt * 256 + sub * 32 + fr, s1 = s0 + 16; const int c = cnt[e];
            const int tk0 = s0 < c ? toklist[(size_t)e * NT + s0] : 0, tk1 = s1 < c ? toklist[(size_t)e * NT + s1] : 0;
            const bf16* Fb = WSP(bf16, WS_F); const bf16* Bt = WSP(bf16, WS_WGU) + ((size_t)layer * NE + e) * 2048 * 1024;
            wtile(Fb + (size_t)tk0 * D + 8 * fq, Fb + (size_t)tk1 * D + 8 * fq, Bt + (size_t)(col0 + fr) * D + 8 * fq, Bt + (size_t)(col0 + 16 + fr) * D + 8 * fq, D, acc);
            EpiSwiglu E{WSP(bf16, WS_ACT), P.in[30] + ((size_t)layer * NE + e) * 2048};
#pragma unroll
            for (int m = 0; m < 2; ++m) E(row0 + m * 16 + fr, col0 + 4 * fq, acc[m][0], acc[m][1]);
        } else {
            const bf16* A = WSP(bf16, WS_ACT); const bf16* Bt = WSP(bf16, WS_WDN) + ((size_t)layer * NE + e) * 1024 * 1024;
            wtile(A + (size_t)(row0 + fr) * D + 8 * fq, A + (size_t)(row0 + 16 + fr) * D + 8 * fq, Bt + (size_t)(col0 + fr) * D + 8 * fq, Bt + (size_t)(col0 + 16 + fr) * D + 8 * fq, D, acc);
            EpiBiasBf16 E{WSP(bf16, WS_Y), P.in[32] + ((size_t)layer * NE + e) * 1024};
#pragma unroll
            for (int m = 0; m < 2; ++m) E(row0 + m * 16 + fr, col0 + 4 * fq, acc[m][0], acc[m][1]);
        }
    }
}


namespace pg {
constexpr int BM = 256, BK = 64, HALF = 128, HTB = HALF * BK * 2, STAGE_BYTES = 8 * HTB, NXCD = 8, WGM = 8;
__device__ __forceinline__ int lds_byte(int r, int c) { const int st = (r >> 4) * 2 + (c >> 5), rr = r & 15, cc = c & 31, ob = rr * 64 + cc * 2; return st * 1024 + (ob ^ (((ob >> 9) & 1) << 5)); }
__device__ __forceinline__ void stage_rc(int b, int& R, int& C) { const int st = b / 1024, sb = b % 1024, swz = sb ^ (((sb >> 9) & 1) << 5); R = (st >> 1) * 16 + swz / 64; C = (st & 1) * 32 + (swz % 64) / 2; }
struct Unit { int pm, pn, e, mt; };
struct DenseSched {
    const bf16* A; const bf16* Bt; int lda, ldb, K; int nM, nN, nwg, G, c;
    __device__ __forceinline__ void init(const bf16* A_, int lda_, const bf16* Bt_, int ldb_, int M, int N, int K_, int G_, int c_) { A = A_; Bt = Bt_; lda = lda_; ldb = ldb_; K = K_; nM = M / BM; nN = N / BM; nwg = nM * nN; G = G_; c = c_; }
    __device__ __forceinline__ bool next(int i, Unit& u) const {
        const long L = (long)i * G + c; if (L >= nwg) return false;
        int wgid = (int)L; { const int q = nwg / NXCD, r = nwg % NXCD, xcd = wgid % NXCD, off = wgid / NXCD; wgid = (xcd < r ? xcd * (q + 1) : r * (q + 1) + (xcd - r) * q) + off; }
        const int nig = WGM * nN, gid = wgid / nig, fm = gid * WGM, gsz = (nM - fm) < WGM ? (nM - fm) : WGM;
        u.pm = fm + ((wgid % nig) % gsz); u.pn = (wgid % nig) / gsz; u.e = 0; u.mt = 0; return true;
    }
    __device__ __forceinline__ unsigned aoff(const Unit& u, int r, int C) const { return (unsigned)((u.pm * BM + r) * lda + C) * 2u; }
    __device__ __forceinline__ const char* bbase(const Unit& u) const { return (const char*)(Bt + (size_t)u.pn * BM * ldb); }
};
template <int STAGE> struct MoeSched {
    const bf16* A; const bf16* Bt; int lda, ldb, K; int G, c, NN, nunits; const int* pre; const int* cnt; const int* toklist;
    __device__ __forceinline__ bool next(int i, Unit& u) const {
        const long L = (long)i * G + c; if (L >= nunits) return false;
        const int t256 = (int)(L / NN); u.pn = (int)(L % NN); u.pm = t256; u.e = moe_find(pre, t256); u.mt = t256 - pre[u.e]; return true;
    }
    __device__ __forceinline__ unsigned aoff(const Unit& u, int r, int C) const {
        if (STAGE == 1) { const int slot = u.mt * BM + r; const int tok = slot < cnt[u.e] ? toklist[(size_t)u.e * NT + slot] : 0; return (unsigned)(tok * lda + C) * 2u; }
        return (unsigned)((u.pm * BM + r) * lda + C) * 2u;
    }
    __device__ __forceinline__ const char* bbase(const Unit& u) const { return (const char*)(Bt + ((size_t)u.e * NN * BM + (size_t)u.pn * BM) * ldb); }
};

template <class Sched, class Epi>
__device__ __forceinline__ void gemm_phase(LAS unsigned char* lds, const Sched& S, const Epi& E) {
    const int tid = threadIdx.x, wid = __builtin_amdgcn_readfirstlane(tid >> 6), lane = tid & 63, wr = wid >> 2, wc = wid & 3, fr = lane & 15, fq = lane >> 4;
    const int K = S.K, nt = K / BK;
    int Rr[2], Cc[2]; unsigned voffB[2];
#pragma unroll
    for (int i = 0; i < 2; ++i) { stage_rc(tid * 16 + i * 8192, Rr[i], Cc[i]); voffB[i] = (unsigned)(Rr[i] * S.ldb + Cc[i]) * 2u; }
    const size_t kstep = (size_t)(BK * 2);
    const size_t hstepB = (size_t)HALF * S.ldb * 2;
    const unsigned ldsw = (unsigned)wid * 1024u;
    const int aoff = lds_byte(wr * 64 + fr, fq * 8), boff = lds_byte(wc * 32 + fr, fq * 8);
#define PG_SA(b, h) (((b) * 2 + (h)) * HTB)
#define PG_SB(b, h) ((4 + (b) * 2 + (h)) * HTB)
#define PG_STAGE(bufoff, gbase, voff) do { _Pragma("unroll") for (int _i = 0; _i < 2; ++_i) \
        __builtin_amdgcn_global_load_lds((const unsigned*)((const char*)(gbase) + (voff)[_i]), (LAS unsigned*)(lds + (bufoff) + ldsw + _i * 8192), 16, 0, 0); } while (0)
#define PG_LDA(dst, b, h) do { _Pragma("unroll") for (int m = 0; m < 4; ++m) _Pragma("unroll") for (int k = 0; k < 2; ++k) dst[m][k] = *(const LAS bf16x8*)(lds + PG_SA(b, h) + aoff + m * 2048 + k * 1024); } while (0)
#define PG_LDB(dst, b, h) do { _Pragma("unroll") for (int n = 0; n < 2; ++n) _Pragma("unroll") for (int k = 0; k < 2; ++k) dst[n][k] = *(const LAS bf16x8*)(lds + PG_SB(b, h) + boff + n * 2048 + k * 1024); } while (0)
#define PG_MMA(ai, bj, At, Bt) do { __builtin_amdgcn_s_setprio(1); _Pragma("unroll") for (int m = 0; m < 4; ++m) _Pragma("unroll") for (int n = 0; n < 2; ++n) _Pragma("unroll") for (int k = 0; k < 2; ++k) \
        acc[ai][bj][m][n] = __builtin_amdgcn_mfma_f32_16x16x32_bf16(Bt[n][k], At[m][k], acc[ai][bj][m][n], 0, 0, 0); __builtin_amdgcn_s_setprio(0); } while (0)
#define PG_WAIT_V(n) asm volatile("s_waitcnt vmcnt(" #n ")" ::: "memory")
#define PG_WAIT_L(n) asm volatile("s_waitcnt lgkmcnt(" #n ")" ::: "memory")
#define PG_BAR __builtin_amdgcn_s_barrier()
#define PG_SCHED __builtin_amdgcn_sched_barrier(0)
    Unit cur, nxt; int ui = 0;
    if (!S.next(0, cur)) return;
    f32x4 acc[2][2][4][2];
#pragma unroll
    for (int a = 0; a < 2; ++a)
#pragma unroll
        for (int b = 0; b < 2; ++b)
#pragma unroll
            for (int m = 0; m < 4; ++m)
#pragma unroll
                for (int n = 0; n < 2; ++n) acc[a][b][m][n] = (f32x4){0.f, 0.f, 0.f, 0.f};
    bf16x8 At[4][2], B0[2][2], B1[2][2];
    unsigned voA0[2], voA1[2], vnA0[2], vnA1[2];
#pragma unroll
    for (int i = 0; i < 2; ++i) { voA0[i] = S.aoff(cur, Rr[i], Cc[i]); voA1[i] = S.aoff(cur, HALF + Rr[i], Cc[i]); }
    const char* Ab = (const char*)S.A; const char* cB = S.bbase(cur);
    PG_STAGE(PG_SB(0, 0), cB, voffB); PG_STAGE(PG_SA(0, 0), Ab, voA0); PG_STAGE(PG_SB(0, 1), cB + hstepB, voffB); PG_STAGE(PG_SA(0, 1), Ab, voA1);
    if (wr == 1) PG_BAR;
    PG_WAIT_V(4); PG_BAR;
    PG_STAGE(PG_SB(1, 0), cB + kstep, voffB); PG_STAGE(PG_SA(1, 0), Ab + kstep, voA0); PG_STAGE(PG_SB(1, 1), cB + hstepB + kstep, voffB);
    PG_WAIT_V(6); PG_BAR;
    for (;;) {
        const bool has_next = S.next(ui + 1, nxt);
        const char* nB = has_next ? S.bbase(nxt) : cB;
#pragma unroll
        for (int i = 0; i < 2; ++i) { vnA0[i] = has_next ? S.aoff(nxt, Rr[i], Cc[i]) : voA0[i]; vnA1[i] = has_next ? S.aoff(nxt, HALF + Rr[i], Cc[i]) : voA1[i]; }
        for (int t = 0; t < nt; t += 2) {
            const bool last = (t == nt - 2);
            const char* a1 = Ab + (size_t)(t + 1) * kstep;
            const char* a2 = last ? Ab : Ab + (size_t)(t + 2) * kstep; const char* b2 = last ? nB : cB + (size_t)(t + 2) * kstep;
            const char* a3 = a2 + kstep; const char* b3 = b2 + kstep;
            unsigned o20[2], o21[2];
#pragma unroll
            for (int i = 0; i < 2; ++i) { o20[i] = last ? vnA0[i] : voA0[i]; o21[i] = last ? vnA1[i] : voA1[i]; }
            PG_LDB(B0, 0, 0); PG_SCHED; PG_LDA(At, 0, 0); PG_STAGE(PG_SA(1, 1), a1, voA1);
            PG_WAIT_L(8); PG_BAR; PG_WAIT_L(0); PG_MMA(0, 0, At, B0); PG_BAR; PG_SCHED;
            PG_LDB(B1, 0, 1); PG_STAGE(PG_SB(0, 0), b2, voffB);
            PG_BAR; PG_WAIT_L(0); PG_MMA(0, 1, At, B1); PG_BAR;
            PG_LDA(At, 0, 1); PG_STAGE(PG_SA(0, 0), a2, o20);
            PG_BAR; PG_WAIT_L(0); PG_MMA(1, 0, At, B0); PG_BAR; PG_SCHED;
            PG_STAGE(PG_SB(0, 1), b2 + hstepB, voffB);
            PG_WAIT_V(6); PG_BAR; PG_MMA(1, 1, At, B1); PG_BAR;
            PG_LDB(B0, 1, 0); PG_SCHED; PG_LDA(At, 1, 0); PG_STAGE(PG_SA(0, 1), a2, o21);
            PG_WAIT_L(8); PG_BAR; PG_WAIT_L(0); PG_MMA(0, 0, At, B0); PG_BAR; PG_SCHED;
            PG_LDB(B1, 1, 1); PG_STAGE(PG_SB(1, 0), b3, voffB);
            PG_BAR; PG_WAIT_L(0); PG_MMA(0, 1, At, B1); PG_BAR;
            PG_LDA(At, 1, 1); PG_STAGE(PG_SA(1, 0), a3, o20);
            PG_BAR; PG_WAIT_L(0); PG_MMA(1, 0, At, B0); PG_BAR; PG_SCHED;
            PG_STAGE(PG_SB(1, 1), b3 + hstepB, voffB);
            PG_WAIT_V(6); PG_BAR; PG_MMA(1, 1, At, B1); PG_BAR;
        }
        { const int row0 = cur.pm * BM + wr * 64 + fr, col0 = cur.pn * BM + wc * 32 + 4 * fq;
#pragma unroll
          for (int ai = 0; ai < 2; ++ai)
#pragma unroll
              for (int m = 0; m < 4; ++m)
#pragma unroll
                  for (int bj = 0; bj < 2; ++bj) E(cur, row0 + ai * HALF + m * 16, col0 + bj * HALF, acc[ai][bj][m][0], acc[ai][bj][m][1]); }
        if (!has_next) break;
#pragma unroll
        for (int a = 0; a < 2; ++a)
#pragma unroll
            for (int b = 0; b < 2; ++b)
#pragma unroll
                for (int m = 0; m < 4; ++m)
#pragma unroll
                    for (int n = 0; n < 2; ++n) acc[a][b][m][n] = (f32x4){0.f, 0.f, 0.f, 0.f};
        cur = nxt; cB = nB; ++ui;
#pragma unroll
        for (int i = 0; i < 2; ++i) { voA0[i] = vnA0[i]; voA1[i] = vnA1[i]; }
    }
    PG_WAIT_V(0);
    if (wr == 0) PG_BAR;
    PG_BAR;
#undef PG_SA
#undef PG_SB
#undef PG_STAGE
#undef PG_LDA
#undef PG_LDB
#undef PG_MMA
#undef PG_WAIT_V
#undef PG_WAIT_L
#undef PG_BAR
#undef PG_SCHED
}
}
struct GF32 { EpiF32 e; __device__ __forceinline__ void operator()(const pg::Unit&, int row, int col, f32x4 a, f32x4 b) const { e(row, col, a, b); } };
struct GResid { EpiResid e; __device__ __forceinline__ void operator()(const pg::Unit&, int row, int col, f32x4 a, f32x4 b) const { e(row, col, a, b); } };
struct GSwiglu { bf16* act; const float* bias;
    __device__ __forceinline__ void operator()(const pg::Unit& u, int row, int col, f32x4 a, f32x4 b) const { EpiSwiglu e{act, bias + (size_t)u.e * 2048}; e(row, col, a, b); } };
struct GBiasBf16 { bf16* Y; const float* bias;
    __device__ __forceinline__ void operator()(const pg::Unit& u, int row, int col, f32x4 a, f32x4 b) const { EpiBiasBf16 e{Y, bias + (size_t)u.e * 1024}; e(row, col, a, b); } };
template <class Epi>
__device__ __forceinline__ void ph_gemm(Fr& F, const bf16* A, int lda, const bf16* Bt, int ldb, int M, int N, int K, const Epi& E) {
    pg::DenseSched S; S.init(A, lda, Bt, ldb, M, N, K, F.nblk, F.blk);
    pg::gemm_phase((LAS unsigned char*)F.lds, S, E);
}
template <int STAGE>
__device__ __forceinline__ void ph_moe_gemm(Fr& F, int layer) {
    const Ptrs& P = F.P;
    moe_prefix(F, layer);
    const int* pre = (const int*)(F.lds + LDS_MISC + 64);
    pg::MoeSched<STAGE> S; S.lda = 1024; S.ldb = 1024; S.K = 1024; S.G = F.nblk; S.c = F.blk; S.NN = STAGE == 1 ? 8 : 4; S.nunits = pre[NE] * S.NN;
    S.pre = pre; S.cnt = (const int*)(P.ws + WS_CTL + CW_CNT) + layer * NE; S.toklist = WSP(int, WS_TOK);
    if (STAGE == 1) { S.A = WSP(bf16, WS_F); S.Bt = WSP(bf16, WS_WGU) + (size_t)layer * NE * 2048 * 1024; pg::gemm_phase((LAS unsigned char*)F.lds, S, GSwiglu{WSP(bf16, WS_ACT), P.in[30] + (size_t)layer * NE * 2048}); }
    else { S.A = WSP(bf16, WS_ACT); S.Bt = WSP(bf16, WS_WDN) + (size_t)layer * NE * 1024 * 1024; pg::gemm_phase((LAS unsigned char*)F.lds, S, GBiasBf16{WSP(bf16, WS_Y), P.in[32] + (size_t)layer * NE * 1024}); }
}

__device__ __forceinline__ void ph_e3(Fr& F) {
    const Ptrs& P = F.P; const int lane = F.lane;
    const float* Z = WSP(float, WS_Z); bf16* QKVN = WSP(bf16, WS_QKVN); bf16* KM = WSP(bf16, WS_KM);
    const float* ropeM = WSP(float, WS_ROPEM);
    for (int r = F.gw; r < NT; r += F.ngw) {
        const float* z = Z + (size_t)r * ZLD;
        const f32x4 qa = *(const f32x4*)(z + 1024 + 4 * lane);
        float ss = wave_sum(qa.x * qa.x + qa.y * qa.y + qa.z * qa.z + qa.w * qa.w);
        float rs = rsqrtf(ss * (1.f / 256.f) + 1e-6f);
        const f32x4 gq = *(const f32x4*)(P.in[16] + 4 * lane);
        u32x2 o; o.x = pk2(qa.x * rs * gq.x, qa.y * rs * gq.y); o.y = pk2(qa.z * rs * gq.z, qa.w * rs * gq.w);
        *(u32x2*)(QKVN + (size_t)r * 384 + 4 * lane) = o;
        const float k0 = z[1280 + 2 * lane], k1 = z[1280 + 2 * lane + 1];
        ss = wave_sum(k0 * k0 + k1 * k1); rs = rsqrtf(ss * (1.f / 128.f) + 1e-6f);
        *(unsigned*)(QKVN + (size_t)r * 384 + 256 + 2 * lane) = pk2(k0 * rs * P.in[18][2 * lane], k1 * rs * P.in[18][2 * lane + 1]);
        float kr = lane < 32 ? z[1408 + lane] : 0.f;
        ss = wave_sum(kr * kr); rs = rsqrtf(ss * (1.f / 32.f) + 1e-6f);
        kr = kr * rs * (lane < 32 ? P.in[21][32 + lane] : 0.f);
        int b, s; row_bs(r, b, s);
        const float other = __shfl_xor(kr, 16);
        float outv = kr;
        if (r < NL && lane < 32) { const int i = lane & 15; const float cs = ropeM[((size_t)s * 16 + i) * 2], sn = ropeM[((size_t)s * 16 + i) * 2 + 1];
            outv = lane < 16 ? kr * cs - other * sn : kr * cs + other * sn; }
        if (lane < 32) { const bf16 ov = (bf16)f2bf(outv);
#pragma unroll
            for (int h = 0; h < 8; ++h) KM[(((size_t)b * 8 + h) * TA + s) * 96 + 64 + lane] = ov; }
    }
}
__device__ __forceinline__ void ph_e5(Fr& F) {
    const Ptrs& P = F.P; const int lane = F.lane;
    const float* R = WSP(float, WS_QKVR); bf16* QM = WSP(bf16, WS_QM); bf16* KM = WSP(bf16, WS_KM); bf16* VT = WSP(bf16, WS_VM);
    const float* ropeM = WSP(float, WS_ROPEM);
    const float gqn = P.in[20][lane], gkn = P.in[20][64 + lane], gqr = lane < 32 ? P.in[21][lane] : 0.f;
    for (int g = F.gw; g < NT / 8; g += F.ngw) {
        const int r0 = g * 8; int b, s0; row_bs(r0, b, s0);
#pragma unroll 1
        for (int h = 0; h < 8; ++h) {
            float v8[8];
#pragma unroll
            for (int rr = 0; rr < 8; ++rr) {
                const int r = r0 + rr, s = s0 + rr; const float* q = R + (size_t)r * 1792;
                const size_t qo = (((size_t)b * 8 + h) * TA + s) * 96;
                const float qn = q[h * 96 + lane];
                float rs = rsqrtf(wave_sum(qn * qn) * (1.f / 64.f) + 1e-6f);
                QM[qo + lane] = (bf16)f2bf(qn * rs * gqn);
                float qr = lane < 32 ? q[h * 96 + 64 + lane] : 0.f;
                rs = rsqrtf(wave_sum(qr * qr) * (1.f / 32.f) + 1e-6f);
                qr = qr * rs * gqr;
                const float other = __shfl_xor(qr, 16); float outv = qr;
                if (r < NL && lane < 32) { const int i = lane & 15; const float cs = ropeM[((size_t)s * 16 + i) * 2], sn = ropeM[((size_t)s * 16 + i) * 2 + 1];
                    outv = lane < 16 ? qr * cs - other * sn : qr * cs + other * sn; }
                if (lane < 32) QM[qo + 64 + lane] = (bf16)f2bf(outv);
                const float kn = q[768 + h * 128 + lane];
                rs = rsqrtf(wave_sum(kn * kn) * (1.f / 64.f) + 1e-6f);
                KM[qo + lane] = (bf16)f2bf(kn * rs * gkn);
                v8[rr] = q[768 + h * 128 + 64 + lane];
            }
            u32x4 w; w.x = pk2(v8[0], v8[1]); w.y = pk2(v8[2], v8[3]); w.z = pk2(v8[4], v8[5]); w.w = pk2(v8[6], v8[7]);
            *(u32x4*)(VT + (((size_t)b * 8 + h) * 64 + lane) * TA + s0) = w;
        }
    }
}
__device__ __forceinline__ void ph_attn_mla_naive(Fr& F) {
    const Ptrs& P = F.P;
    const bf16* QM = WSP(bf16, WS_QM); const bf16* KM = WSP(bf16, WS_KM); const bf16* VM = WSP(bf16, WS_VM);
    const int half = F.tid >> 8, t256 = F.tid & 255;
    for (int u = F.blk * 2 + half; u < NB * 8 * 17; u += F.nblk * 2) {
        const int bh = u / 17, qb = u % 17, b = bh >> 3, h = bh & 7;
        const int s = qb * 256 + t256;
        float qr[96];
        { const u32x4* q = (const u32x4*)(QM + ((size_t)bh * TA + s) * 96); const float sc = 0.10206207261596577f;
#pragma unroll
          for (int i = 0; i < 12; ++i) { const u32x4 w = q[i]; qr[8 * i] = bflo(w.x) * sc; qr[8 * i + 1] = bfhi(w.x) * sc; qr[8 * i + 2] = bflo(w.y) * sc; qr[8 * i + 3] = bfhi(w.y) * sc;
              qr[8 * i + 4] = bflo(w.z) * sc; qr[8 * i + 5] = bfhi(w.z) * sc; qr[8 * i + 6] = bflo(w.w) * sc; qr[8 * i + 7] = bfhi(w.w) * sc; } }
        const int k0 = qb < 16 ? 0 : SEQ;
        float m = -1e30f, l = 0.f, o[64];
#pragma unroll
        for (int i = 0; i < 64; ++i) o[i] = 0.f;
#pragma unroll 1
        for (int j = k0; j < TA; ++j) {
            const u32x4* kr = (const u32x4*)(KM + ((size_t)bh * TA + j) * 96);
            float sc = 0.f;
#pragma unroll
            for (int i = 0; i < 12; ++i) { const u32x4 w = kr[i];
                sc += qr[8 * i] * bflo(w.x) + qr[8 * i + 1] * bfhi(w.x) + qr[8 * i + 2] * bflo(w.y) + qr[8 * i + 3] * bfhi(w.y) + qr[8 * i + 4] * bflo(w.z) + qr[8 * i + 5] * bfhi(w.z) + qr[8 * i + 6] * bflo(w.w) + qr[8 * i + 7] * bfhi(w.w); }
            const float mn = fmaxf(m, sc), al = __expf(m - mn), p = __expf(sc - mn);
            l = l * al + p; m = mn;
            const u32x4* vr = (const u32x4*)(VM + ((size_t)bh * TA + j) * 64);
#pragma unroll
            for (int i = 0; i < 8; ++i) { const u32x4 w = vr[i];
                o[8 * i] = o[8 * i] * al + p * bflo(w.x); o[8 * i + 1] = o[8 * i + 1] * al + p * bfhi(w.x); o[8 * i + 2] = o[8 * i + 2] * al + p * bflo(w.y); o[8 * i + 3] = o[8 * i + 3] * al + p * bfhi(w.y);
                o[8 * i + 4] = o[8 * i + 4] * al + p * bflo(w.z); o[8 * i + 5] = o[8 * i + 5] * al + p * bfhi(w.z); o[8 * i + 6] = o[8 * i + 6] * al + p * bflo(w.w); o[8 * i + 7] = o[8 * i + 7] * al + p * bfhi(w.w); }
        }
        const int row = s < SEQ ? b * SEQ + s : NL + b * CTX + (s - SEQ);
        bf16* y = WSP(bf16, WS_YM) + (size_t)row * D + 512 + h * 64; const float il = 1.f / l;
#pragma unroll
        for (int i = 0; i < 32; ++i) *(unsigned*)(y + 2 * i) = pk2(o[2 * i] * il, o[2 * i + 1] * il);
    }
}


template <int DQ> struct ACfg { static constexpr int KP = DQ * 2 + 16, KCH = DQ / 8, KBYTES = 64 * KP, VP = 136, VBYTES = 64 * VP, BUF = KBYTES + VBYTES; };
template <int DQ, bool WIN>
__device__ __forceinline__ void attn_unit(LAS unsigned char* lds, const bf16* Qrow, const bf16* Kb, const bf16* Vtb, int a0, int a1, int b0, int b1,
                                          float c, int qpos, int ctile, float sink2, bf16* Orow, int tid, int lane) {
    typedef ACfg<DQ> C;
    const int hh = lane >> 5, ql = lane & 31;
    bf16x8 qf[DQ / 16];
#pragma unroll
    for (int ks = 0; ks < DQ / 16; ++ks) qf[ks] = *(const bf16x8*)(Qrow + 16 * ks + 8 * hh);
    f32x16 o0, o1;
#pragma unroll
    for (int r = 0; r < 16; ++r) { o0[r] = 0.f; o1[r] = 0.f; }
    float m = -1e30f, lsum = 0.f;
    const int n0 = a1 - a0, ntl = n0 + (b1 - b0);
    const int kkey0 = tid / C::KCH, kpc0 = tid % C::KCH, kkey1 = (tid + 512) / C::KCH, kpc1 = (tid + 512) % C::KCH;
    const bool two = (C::KCH == 12) && tid < 256;
    u32x4 kst0, kst1 = (u32x4){0u, 0u, 0u, 0u}, vst;
#define AT_ISSUE(ti) do { const int _t = (ti) < n0 ? a0 + (ti) : b0 + (ti) - n0; const int _k0 = _t * 64; \
        kst0 = *(const u32x4*)(Kb + (size_t)(_k0 + kkey0) * DQ + kpc0 * 8); if (two) kst1 = *(const u32x4*)(Kb + (size_t)(_k0 + kkey1) * DQ + kpc1 * 8); \
        vst = *(const u32x4*)(Vtb + (size_t)(tid >> 3) * TA + _k0 + (tid & 7) * 8); } while (0)
#define AT_COMMIT(buf) do { LAS unsigned char* _b = lds + (buf) * C::BUF; \
        *(LAS u32x4*)(_b + kkey0 * C::KP + kpc0 * 16) = kst0; if (two) *(LAS u32x4*)(_b + kkey1 * C::KP + kpc1 * 16) = kst1; \
        LAS unsigned char* _v = _b + C::KBYTES + (tid >> 3) * C::VP + (tid & 7) * 16; *(LAS u32x2*)_v = (u32x2){vst.x, vst.y}; *(LAS u32x2*)(_v + 8) = (u32x2){vst.z, vst.w}; } while (0)
    AT_ISSUE(0); AT_COMMIT(0);
    __syncthreads();
    for (int ti = 0; ti < ntl; ++ti) {
        const int buf = ti & 1;
        if (ti + 1 < ntl) AT_ISSUE(ti + 1);
        const LAS unsigned char* kb_ = lds + buf * C::BUF; const LAS unsigned char* vb_ = kb_ + C::KBYTES;
        f32x16 s0, s1;
#pragma unroll
        for (int r = 0; r < 16; ++r) { s0[r] = 0.f; s1[r] = 0.f; }
#pragma unroll
        for (int ks = 0; ks < DQ / 16; ++ks) {
            const bf16x8 k0 = *(const LAS bf16x8*)(kb_ + ql * C::KP + (16 * ks + 8 * hh) * 2);
            const bf16x8 k1 = *(const LAS bf16x8*)(kb_ + (32 + ql) * C::KP + (16 * ks + 8 * hh) * 2);
            s0 = __builtin_amdgcn_mfma_f32_32x32x16_bf16(k0, qf[ks], s0, 0, 0, 0);
            s1 = __builtin_amdgcn_mfma_f32_32x32x16_bf16(k1, qf[ks], s1, 0, 0, 0);
        }
        const int tile = ti < n0 ? a0 + ti : b0 + ti - n0;
        const bool masked = WIN && ti < n0 && (tile - ctile >= 2 || ctile - tile >= 2);
#pragma unroll
        for (int r = 0; r < 16; ++r) { s0[r] *= c; s1[r] *= c; }
        if (masked) {
#pragma unroll
            for (int r = 0; r < 16; ++r) { const int key = tile * 64 + (r & 3) + 8 * (r >> 2) + 4 * hh; const int d0 = qpos - key, d1 = qpos - key - 32;
                if (d0 > 128 || d0 < -128) s0[r] = -1e30f; if (d1 > 128 || d1 < -128) s1[r] = -1e30f; }
        }
        float mx = s0[0];
#pragma unroll
        for (int r = 1; r < 16; ++r) mx = fmaxf(mx, s0[r]);
#pragma unroll
        for (int r = 0; r < 16; ++r) mx = fmaxf(mx, s1[r]);
        mx = fmaxf(mx, __shfl_xor(mx, 32));
        const float mn = fmaxf(m, mx), alpha = __builtin_amdgcn_exp2f(m - mn); m = mn;
        float ps = 0.f;
#pragma unroll
        for (int r = 0; r < 16; ++r) { s0[r] = __builtin_amdgcn_exp2f(s0[r] - mn); s1[r] = __builtin_amdgcn_exp2f(s1[r] - mn); ps += s0[r] + s1[r]; }
        lsum = lsum * alpha + ps;
#pragma unroll
        for (int r = 0; r < 16; ++r) { o0[r] *= alpha; o1[r] *= alpha; }
        bf16x8 pf[4];
#pragma unroll
        for (int s4 = 0; s4 < 4; ++s4) { u32x4 w;
            if (s4 < 2) { w.x = pk2(s0[8 * s4], s0[8 * s4 + 1]); w.y = pk2(s0[8 * s4 + 2], s0[8 * s4 + 3]); w.z = pk2(s0[8 * s4 + 4], s0[8 * s4 + 5]); w.w = pk2(s0[8 * s4 + 6], s0[8 * s4 + 7]); }
            else { const int q = s4 - 2; w.x = pk2(s1[8 * q], s1[8 * q + 1]); w.y = pk2(s1[8 * q + 2], s1[8 * q + 3]); w.z = pk2(s1[8 * q + 4], s1[8 * q + 5]); w.w = pk2(s1[8 * q + 6], s1[8 * q + 7]); }
            pf[s4] = __builtin_bit_cast(bf16x8, w); }
#pragma unroll
        for (int s4 = 0; s4 < 4; ++s4) {
            const LAS unsigned char* v0 = vb_ + ql * C::VP + (16 * s4 + 4 * hh) * 2; const LAS unsigned char* v1 = v0 + 32 * C::VP;
            const u32x2 a0_ = *(const LAS u32x2*)v0, a1_ = *(const LAS u32x2*)(v0 + 16), c0_ = *(const LAS u32x2*)v1, c1_ = *(const LAS u32x2*)(v1 + 16);
            const bf16x8 va = __builtin_bit_cast(bf16x8, (u32x4){a0_.x, a0_.y, a1_.x, a1_.y}), vc = __builtin_bit_cast(bf16x8, (u32x4){c0_.x, c0_.y, c1_.x, c1_.y});
            o0 = __builtin_amdgcn_mfma_f32_32x32x16_bf16(va, pf[s4], o0, 0, 0, 0);
            o1 = __builtin_amdgcn_mfma_f32_32x32x16_bf16(vc, pf[s4], o1, 0, 0, 0);
        }
        if (ti + 1 < ntl) AT_COMMIT(buf ^ 1);
        __syncthreads();
    }
#undef AT_ISSUE
#undef AT_COMMIT
    float ltot = lsum + __shfl_xor(lsum, 32);
    float fin = 1.f;
    if (WIN) { const float mn = fmaxf(m, sink2); fin = __builtin_amdgcn_exp2f(m - mn); ltot = ltot * fin + __builtin_amdgcn_exp2f(sink2 - mn); }
    const float inv = fin / ltot;
#pragma unroll
    for (int rq = 0; rq < 4; ++rq) {
        u32x2 w; w.x = pk2(o0[4 * rq] * inv, o0[4 * rq + 1] * inv); w.y = pk2(o0[4 * rq + 2] * inv, o0[4 * rq + 3] * inv); *(u32x2*)(Orow + 8 * rq + 4 * hh) = w;
        w.x = pk2(o1[4 * rq] * inv, o1[4 * rq + 1] * inv); w.y = pk2(o1[4 * rq + 2] * inv, o1[4 * rq + 3] * inv); *(u32x2*)(Orow + 32 + 8 * rq + 4 * hh) = w;
    }
}
__device__ __forceinline__ void ph_attn_mla(Fr& F) {
    const Ptrs& P = F.P;
    const bf16* QM = WSP(bf16, WS_QM); const bf16* KM = WSP(bf16, WS_KM); const bf16* VT = WSP(bf16, WS_VM);
    const int x = F.blk & 7, j = F.blk >> 3;
    const float c = 0.10206207261596577f * 1.4426950408889634f;
    for (int rd = 0; ; ++rd) {
        int bh, qb;
        if (F.nblk == 256) { if (rd < 2) { bh = rd * 16 + 2 * x + (j >> 4); qb = j & 15; } else if (rd == 2 && F.blk < 32) { bh = F.blk; qb = 16; } else break; }
        else { const int u = rd * F.nblk + F.blk; if (u >= 544) break; if (u < 512) { bh = u >> 4; qb = u & 15; } else { bh = u - 512; qb = 16; } }
        const int b = bh >> 3, h = bh & 7;
        const int s = qb * 256 + F.wave * 32 + (F.lane & 31);
        const int row = s < SEQ ? b * SEQ + s : NL + b * CTX + (s - SEQ);
        attn_unit<96, false>((LAS unsigned char*)F.lds, QM + ((size_t)bh * TA + s) * 96, KM + (size_t)bh * TA * 96, VT + (size_t)bh * 64 * TA,
                             qb < 16 ? 0 : 64, 68, 0, 0, c, 0, 0, 0.f, WSP(bf16, WS_YM) + (size_t)row * D + 512 + h * 64, F.tid, F.lane);
    }
}

__device__ __forceinline__ void ph_lru_xf(Fr& F) {
    const Ptrs& P = F.P; const float* Z = WSP(float, WS_Z);
    for (size_t gid = F.gtid; gid < (size_t)2 * NT * 512; gid += F.gsz) {
        const int ch = (int)(gid & 511); const int row = (int)((gid >> 9) % NT); const int dir = (int)(gid / ((size_t)NT * 512));
        int t, T, base; if (row < NL) { t = row & 4095; T = SEQ; base = row - t; } else { t = (row - NL) & 255; T = CTX; base = row - t; }
        const float* cw = P.in[9] + (size_t)dir * 4 * 512 + ch;
        float acc = P.in[10][dir * 512 + ch];
#pragma unroll
        for (int j = 0; j < 4; ++j) { const int tt = dir == 0 ? t - 3 + j : t + 3 - j; if (tt >= 0 && tt < T) acc += cw[j * 512] * Z[(size_t)(base + tt) * ZLD + ch]; }
        WSP(float, WS_XF)[gid] = acc;
    }
}
__device__ __forceinline__ void ph_lru_ab(Fr& F) {
    const Ptrs& P = F.P;
    for (size_t gid = F.gtid; gid < (size_t)2 * NT * 512; gid += F.gsz) {
        const int ch = (int)(gid & 511); const int dir = (int)(gid / ((size_t)NT * 512));
        const int blk = ch >> 6, d = ch & 63;
        const float* xf = WSP(float, WS_XF) + (gid - ch) + blk * 64;
        const float* wr = P.in[11] + ((size_t)dir * 8 + blk) * 64 * 64 + d; const float* wi = P.in[13] + ((size_t)dir * 8 + blk) * 64 * 64 + d;
        float ar = P.in[12][dir * 512 + ch], ai = P.in[14][dir * 512 + ch];
#pragma unroll 8
        for (int c = 0; c < 64; ++c) { const float x = xf[c]; ar += x * wr[c * 64]; ai += x * wi[c * 64]; }
        const float r = sigmoidf_(ar), gi = sigmoidf_(ai);
        const float lam = P.in[15][dir * 512 + ch];
        const float sp = log1pf(__expf(-lam));
        const float log_a = -8.f * r * sp; const float a = __expf(log_a);
        const float bb = sqrtf(-expm1f(2.f * log_a)) * (gi * xf[d]);
        WSP(float, WS_LA)[gid] = a; WSP(float, WS_LB)[gid] = bb;
    }
}
__device__ __forceinline__ void ph_lru_scan(Fr& F) {
    const Ptrs& P = F.P;
    if (F.gtid >= NB * 2 * 512) return;
    const int gid = (int)F.gtid; const int ch = gid & 511, dir = (gid >> 9) & 1, b = gid >> 10;
    const float* LA = WSP(float, WS_LA) + (size_t)dir * NT * 512 + ch; const float* LB = WSP(float, WS_LB) + (size_t)dir * NT * 512 + ch;
    float* LH = WSP(float, WS_LH) + (size_t)dir * NT * 512 + ch;
    float h = 0.f;
#pragma unroll 4
    for (int i = 0; i < CTX; ++i) { const int t = dir == 0 ? i : CTX - 1 - i; const size_t row = NL + b * CTX + t; h = LA[row * 512] * h + LB[row * 512]; LH[row * 512] = h; }
#pragma unroll 4
    for (int i = 0; i < SEQ; ++i) { const int t = dir == 0 ? i : SEQ - 1 - i; const size_t row = (size_t)b * SEQ + t; h = LA[row * 512] * h + LB[row * 512]; LH[row * 512] = h; }
}
__device__ __forceinline__ void ph_lru_out(Fr& F) {
    const Ptrs& P = F.P; const float* LH = WSP(float, WS_LH);
    for (size_t gid = F.gtid; gid < (size_t)NT * 512; gid += F.gsz) {
        const int ch = (int)(gid & 511); const size_t row = gid >> 9;
        const float h = LH[gid] + LH[(size_t)NT * 512 + gid];
        WSP(bf16, WS_YM)[row * D + ch] = (bf16)f2bf(h * gelu_tanh(WSP(float, WS_Z)[row * ZLD + 512 + ch]));
    }
}


constexpr int LRU_ST = 16, LRU_NST = 64 / LRU_ST;
constexpr int LRU_AT = LRU_ST * 144, LRU_GT = LRU_ST * 272, LRU_HT = 64 * 128, LRU_WB = LRU_AT + LRU_GT + LRU_HT;
__device__ __forceinline__ float gelu_fast(float x) { const float u = 1.5957691216057308f * (x + 0.044715f * x * x * x); return x / (1.f + __expf(-u)); }
template <int PASS>
__device__ __forceinline__ void ph_lru(Fr& F) {
    const Ptrs& P = F.P; const int lane = F.lane, w = F.wave, ch = w * 64 + lane, fr = lane & 15, fq = lane >> 4;
    LAS unsigned char* At = (LAS unsigned char*)F.lds + w * LRU_WB; LAS unsigned char* Gt = At + LRU_AT; LAS unsigned char* Ht = Gt + LRU_GT;
    const float* Z = WSP(float, WS_Z); const bf16* WRI = WSP(bf16, WS_WRI);
    float* AGG = WSP(float, WS_LA);
    for (int unit = F.blk; unit < NB * 68; unit += F.nblk) {
        const int b = unit / 68, k = unit % 68;
        const bool isctx = k < 4; const int T = isctx ? CTX : SEQ, t0 = isctx ? 64 * k : 64 * (k - 4), segrow0 = isctx ? NL + b * CTX : b * SEQ;
#pragma unroll 1
        for (int dir = 0; dir < 2; ++dir) {
            const int kd = dir == 0 ? k : (isctx ? 3 - k : 71 - k);
            const float cw0 = P.in[9][(dir * 4 + 0) * 512 + ch], cw1 = P.in[9][(dir * 4 + 1) * 512 + ch], cw2 = P.in[9][(dir * 4 + 2) * 512 + ch], cw3 = P.in[9][(dir * 4 + 3) * 512 + ch];
            const float cb = P.in[10][dir * 512 + ch], br = P.in[12][dir * 512 + ch], bi = P.in[14][dir * 512 + ch];
            const float sp8 = -8.f * log1pf(__expf(-P.in[15][dir * 512 + ch]));
            float h = 0.f, pa = 1.f;
            if (PASS == 1) { const float* ag = AGG + ((size_t)(b * 2 + dir) * 68) * 1024 + ch * 2;
#pragma unroll 4
                for (int kk = 0; kk < kd; ++kk) { const f32x2_t ab = *(const f32x2_t*)(ag + (size_t)kk * 1024); h = ab.x * h + ab.y; } }
#pragma unroll 1
            for (int st = 0; st < LRU_NST; ++st) {
                const int sub = dir == 0 ? st : LRU_NST - 1 - st; const int ts = t0 + LRU_ST * sub;
                float xf[LRU_ST], rg[LRU_ST];
                { float uw[LRU_ST + 3];
#pragma unroll
                  for (int q = 0; q < LRU_ST + 3; ++q) { const int t = dir == 0 ? ts - 3 + q : ts + LRU_ST + 2 - q; const bool ok = t >= 0 && t < T;
                      uw[q] = ok ? Z[(size_t)(segrow0 + (ok ? t : 0)) * ZLD + ch] : 0.f; }
#pragma unroll
                  for (int i = 0; i < LRU_ST; ++i) xf[i] = cb + cw0 * uw[i] + cw1 * uw[i + 1] + cw2 * uw[i + 2] + cw3 * uw[i + 3]; }
#pragma unroll
                for (int i = 0; i < LRU_ST; ++i) *(LAS bf16*)(At + i * 144 + lane * 2) = (bf16)f2bf(xf[i]);
#pragma unroll
                for (int gate = 0; gate < 2; ++gate) {
                    f32x4 acc[4];
#pragma unroll
                    for (int n = 0; n < 4; ++n) acc[n] = (f32x4){0.f, 0.f, 0.f, 0.f};
#pragma unroll
                    for (int ks = 0; ks < 2; ++ks) {
                        const bf16x8 af0 = *(const LAS bf16x8*)(At + fr * 144 + (32 * ks + 8 * fq) * 2);
#pragma unroll
                        for (int n = 0; n < 4; ++n) { const bf16x8 bfr = *(const bf16x8*)(WRI + ((size_t)(dir * 8 + w) * 128 + gate * 64 + 16 * n + fr) * 64 + 32 * ks + 8 * fq);
                            acc[n] = __builtin_amdgcn_mfma_f32_16x16x32_bf16(bfr, af0, acc[n], 0, 0, 0); }
                    }
#pragma unroll
                    for (int n = 0; n < 4; ++n) *(LAS f32x4*)(Gt + fr * 272 + (16 * n + 4 * fq) * 4) = acc[n];
#pragma unroll
                    for (int i = 0; i < LRU_ST; ++i) { const float pre = *(const LAS float*)(Gt + i * 272 + lane * 4);
                        if (gate == 0) rg[i] = sigmoidf_(pre + br);
                        else { const float gi = sigmoidf_(pre + bi); const float a = __expf(sp8 * rg[i]); rg[i] = a; xf[i] = sqrtf(fmaxf(1.f - a * a, 0.f)) * (gi * xf[i]); } }
                }
#pragma unroll
                for (int i = 0; i < LRU_ST; ++i) { const int tl = dir == 0 ? LRU_ST * sub + i : LRU_ST * sub + LRU_ST - 1 - i;
                    h = rg[i] * h + xf[i]; if (PASS == 0) pa *= rg[i];
                    if (PASS == 1) {
                        if (dir == 0) *(LAS bf16*)(Ht + tl * 128 + lane * 2) = (bf16)f2bf(h);
                        else { const float hf = bf2f(*(const LAS bf16*)(Ht + tl * 128 + lane * 2)); const size_t row = (size_t)(segrow0 + t0 + tl);
                            WSP(bf16, WS_YM)[row * D + ch] = (bf16)f2bf((hf + h) * gelu_fast(Z[row * ZLD + 512 + ch])); } } }
            }
            if (PASS == 0) { f32x2_t o; o.x = pa; o.y = h; *(f32x2_t*)(AGG + ((size_t)(b * 2 + dir) * 68 + kd) * 1024 + ch * 2) = o; }
        }
    }
}

__device__ __forceinline__ void ph_oprep(Fr& F) {
    const Ptrs& P = F.P; const int lane = F.lane;
    const float* Z = WSP(float, WS_Z); bf16* QG = WSP(bf16, WS_QG); bf16* KG = WSP(bf16, WS_KG); bf16* VGT = WSP(bf16, WS_VG);
    const float* ropeG = WSP(float, WS_ROPEG);
    const float gq = P.in[24][lane], gk = P.in[24][64 + lane];
    for (int g = F.gw; g < NT / 8; g += F.ngw) {
        const int r0 = g * 8; int b, s0; row_bs(r0, b, s0);
        const bool lat = r0 < NL;
        if (lat) {
#pragma unroll 1
            for (int rr = 0; rr < 8; ++rr) {
                const int s = s0 + rr; const float* z = Z + (size_t)(r0 + rr) * ZLD;
                const float cs = ropeG[((size_t)s * 32 + (lane & 31)) * 2], sn = ropeG[((size_t)s * 32 + (lane & 31)) * 2 + 1];
#pragma unroll 4
                for (int h = 0; h < 16; ++h) {
                    float q = z[h * 64 + lane]; const float rs = rsqrtf(wave_sum(q * q) * (1.f / 64.f) + 1e-6f); q = q * rs * gq;
                    const float other = __shfl_xor(q, 32); const float o = lane < 32 ? q * cs - other * sn : q * cs + other * sn;
                    QG[(((size_t)b * 16 + h) * SEQ + s) * 64 + lane] = (bf16)f2bf(o); }
            }
        }
#pragma unroll 1
        for (int h = 0; h < 4; ++h) {
            float v8[8];
#pragma unroll
            for (int rr = 0; rr < 8; ++rr) {
                const int s = s0 + rr; const float* z = Z + (size_t)(r0 + rr) * ZLD;
                float cs = 1.f, sn = 0.f;
                if (lat) { cs = ropeG[((size_t)s * 32 + (lane & 31)) * 2]; sn = ropeG[((size_t)s * 32 + (lane & 31)) * 2 + 1]; }
                float k = z[1024 + h * 64 + lane]; const float rs = rsqrtf(wave_sum(k * k) * (1.f / 64.f) + 1e-6f); k = k * rs * gk;
                const float other = __shfl_xor(k, 32); const float o = lane < 32 ? k * cs - other * sn : k * cs + other * sn;
                KG[(((size_t)b * 4 + h) * TA + s) * 64 + lane] = (bf16)f2bf(o);
                v8[rr] = z[1280 + h * 64 + lane];
            }
            u32x4 w; w.x = pk2(v8[0], v8[1]); w.y = pk2(v8[2], v8[3]); w.z = pk2(v8[4], v8[5]); w.w = pk2(v8[6], v8[7]);
            *(u32x4*)(VGT + (((size_t)b * 4 + h) * 64 + lane) * TA + s0) = w;
        }
    }
}
__device__ __forceinline__ void ph_attn_gqa(Fr& F) {
    const Ptrs& P = F.P;
    const int x = F.blk & 7, j = F.blk >> 3;
    const float c = 0.125f * 1.4426950408889634f;
    for (int rd = 0; ; ++rd) {
        int pair, qblk;
        if (F.nblk == 256) { if (rd >= 4) break; pair = rd * 4 + (x >> 1); qblk = 32 * (x & 1) + j; }
        else { const int u = rd * F.nblk + F.blk; if (u >= 1024) break; pair = u >> 6; qblk = u & 63; }
        const int b = pair >> 2, kh = pair & 3, head = kh * 4 + (F.wave >> 1);
        const int qpos = qblk * 64 + 32 * (F.wave & 1) + (F.lane & 31);
        const int a0 = qblk - 2 < 0 ? 0 : qblk - 2, a1 = qblk + 3 > 64 ? 64 : qblk + 3;
        attn_unit<64, true>((LAS unsigned char*)F.lds, WSP(bf16, WS_QG) + (((size_t)b * 16 + head) * SEQ + qpos) * 64, WSP(bf16, WS_KG) + ((size_t)b * 4 + kh) * TA * 64,
                            WSP(bf16, WS_VG) + ((size_t)b * 4 + kh) * 64 * TA, a0, a1, 64, 68, c, qpos, qblk, P.in[25][head] * 1.4426950408889634f,
                            WSP(bf16, WS_YM) + ((size_t)b * SEQ + qpos) * D + head * 64, F.tid, F.lane);
    }
}
__device__ __forceinline__ void ph_attn_gqa_naive(Fr& F) {
    const Ptrs& P = F.P;
    const int half = F.tid >> 8, t256 = F.tid & 255;
    for (int u = F.blk * 2 + half; u < NB * 16 * 16; u += F.nblk * 2) {
        const int bh = u >> 4, qb = u & 15, b = bh >> 4, h = bh & 15, kh = h >> 2;
        const int t = qb * 256 + t256;
        const bf16* QG = WSP(bf16, WS_QG); const bf16* KG = WSP(bf16, WS_KG) + ((size_t)b * 4 + kh) * TA * 64; const bf16* VG = WSP(bf16, WS_VG) + ((size_t)b * 4 + kh) * TA * 64;
        float qr[64];
        { const u32x4* q = (const u32x4*)(QG + ((size_t)bh * SEQ + t) * 64);
#pragma unroll
          for (int i = 0; i < 8; ++i) { const u32x4 w = q[i]; qr[8 * i] = bflo(w.x) * 0.125f; qr[8 * i + 1] = bfhi(w.x) * 0.125f; qr[8 * i + 2] = bflo(w.y) * 0.125f; qr[8 * i + 3] = bfhi(w.y) * 0.125f;
              qr[8 * i + 4] = bflo(w.z) * 0.125f; qr[8 * i + 5] = bfhi(w.z) * 0.125f; qr[8 * i + 6] = bflo(w.w) * 0.125f; qr[8 * i + 7] = bfhi(w.w) * 0.125f; } }
        float m = -1e30f, l = 0.f, o[64];
#pragma unroll
        for (int i = 0; i < 64; ++i) o[i] = 0.f;
#pragma unroll 1
        for (int jj = 0; jj < 257 + CTX; ++jj) {
            int j; bool valid = true;
            if (jj < 257) { j = t - 128 + jj; valid = (j >= 0 && j < SEQ); if (!valid) j = 0; } else j = SEQ + (jj - 257);
            const u32x4* kr = (const u32x4*)(KG + (size_t)j * 64);
            float sc = 0.f;
#pragma unroll
            for (int i = 0; i < 8; ++i) { const u32x4 w = kr[i];
                sc += qr[8 * i] * bflo(w.x) + qr[8 * i + 1] * bfhi(w.x) + qr[8 * i + 2] * bflo(w.y) + qr[8 * i + 3] * bfhi(w.y) + qr[8 * i + 4] * bflo(w.z) + qr[8 * i + 5] * bfhi(w.z) + qr[8 * i + 6] * bflo(w.w) + qr[8 * i + 7] * bfhi(w.w); }
            if (!valid) sc = -1e30f;
            const float mn = fmaxf(m, sc), al = __expf(m - mn), p = valid ? __expf(sc - mn) : 0.f;
            l = l * al + p; m = mn;
            const u32x4* vr = (const u32x4*)(VG + (size_t)j * 64);
#pragma unroll
            for (int i = 0; i < 8; ++i) { const u32x4 w = vr[i];
                o[8 * i] = o[8 * i] * al + p * bflo(w.x); o[8 * i + 1] = o[8 * i + 1] * al + p * bfhi(w.x); o[8 * i + 2] = o[8 * i + 2] * al + p * bflo(w.y); o[8 * i + 3] = o[8 * i + 3] * al + p * bfhi(w.y);
                o[8 * i + 4] = o[8 * i + 4] * al + p * bflo(w.z); o[8 * i + 5] = o[8 * i + 5] * al + p * bfhi(w.z); o[8 * i + 6] = o[8 * i + 6] * al + p * bflo(w.w); o[8 * i + 7] = o[8 * i + 7] * al + p * bfhi(w.w); }
        }
        { const float sk = P.in[25][h]; const float mn = fmaxf(m, sk), al = __expf(m - mn); l = l * al + __expf(sk - mn);
          const float il = al / l;
          bf16* y = WSP(bf16, WS_YM) + ((size_t)b * SEQ + t) * D + h * 64;
#pragma unroll
          for (int i = 0; i < 32; ++i) *(unsigned*)(y + 2 * i) = pk2(o[2 * i] * il, o[2 * i + 1] * il); }
    }
}

__device__ __forceinline__ void ph_router(Fr& F, int layer, int nrows) {
    const Ptrs& P = F.P; const int lane = F.lane;
    const float* MOD = WSP(float, WS_MOD); const float* X1 = WSP(float, WS_X1);
    const float* wrt = WSP(float, WS_WRT) + (size_t)layer * 32 * 1024;
    int* cnt = (int*)(P.ws + WS_CTL + CW_CNT) + layer * NE;
    for (int r = F.gw; r < nrows; r += F.ngw) {
        RowV v = load_row(X1 + (size_t)r * D, lane);
        const float* m = MOD + (size_t)(layer * 5 + mod_row(r)) * 6144;
        norm_mod(v, P.in[7] + layer * D, m + 4 * 1024, m + 3 * 1024, lane);
        store_row_bf16(WSP(bf16, WS_F) + (size_t)r * D, v, lane);
        float mylg = -3.4e38f;
#pragma unroll 4
        for (int e = 0; e < NE; ++e) { const f32x4* w = (const f32x4*)(wrt + e * 1024) + lane; float s = 0.f;
#pragma unroll
            for (int j = 0; j < 4; ++j) { const f32x4 wv = w[64 * j]; s += v.v[j].x * wv.x + v.v[j].y * wv.y + v.v[j].z * wv.z + v.v[j].w * wv.w; }
            s = wave_sum(s) + P.in[28][layer * NE + e]; mylg = (lane == e) ? s : mylg; }
        int te[4]; float tv[4];
#pragma unroll
        for (int k = 0; k < 4; ++k) { float bv = mylg; int bi = lane;
#pragma unroll
            for (int o = 1; o < 64; o <<= 1) { const float ov = __shfl_xor(bv, o); const int oi = __shfl_xor(bi, o); const bool take = ov > bv || (ov == bv && oi < bi); bv = take ? ov : bv; bi = take ? oi : bi; }
            te[k] = bi; tv[k] = bv; mylg = (lane == bi) ? -3.4e38f : mylg; }
        const float e1 = __expf(tv[1] - tv[0]), e2 = __expf(tv[2] - tv[0]), e3 = __expf(tv[3] - tv[0]); const float inv = 1.f / (1.f + e1 + e2 + e3);
        const float gate[4] = {inv, e1 * inv, e2 * inv, e3 * inv};
        if (lane < 4) { const int e = lane == 0 ? te[0] : lane == 1 ? te[1] : lane == 2 ? te[2] : te[3]; const float g = lane == 0 ? gate[0] : lane == 1 ? gate[1] : lane == 2 ? gate[2] : gate[3];
            const int slot = atomicAdd(&cnt[e], 1);
            WSP(int, WS_TOK)[(size_t)e * NT + slot] = r;
            WSP(int, WS_PE)[r * 4 + lane] = e; WSP(int, WS_PS)[r * 4 + lane] = slot; WSP(float, WS_PG)[r * 4 + lane] = g; }
    }
}
template <int MODE>
__device__ __forceinline__ void ph_combine(Fr& F, int layer, int nrows) {
    const Ptrs& P = F.P; const int lane = F.lane;
    moe_prefix(F, layer);
    const int* pre = (const int*)(F.lds + LDS_MISC + 64);
    const float* MOD = WSP(float, WS_MOD); const float* X1 = WSP(float, WS_X1); const bf16* Y = WSP(bf16, WS_Y);
    for (int r = F.gw; r < nrows; r += F.ngw) {
        RowV v = load_row(X1 + (size_t)r * D, lane);
        const float* g2 = MOD + (size_t)(layer * 5 + mod_row(r)) * 6144 + 5 * 1024;
        RowV acc;
#pragma unroll
        for (int j = 0; j < 4; ++j) acc.v[j] = (f32x4){0.f, 0.f, 0.f, 0.f};
#pragma unroll
        for (int k = 0; k < 4; ++k) { const int e = WSP(int, WS_PE)[r * 4 + k], slot = WSP(int, WS_PS)[r * 4 + k]; const float g = WSP(float, WS_PG)[r * 4 + k];
            const u32x2* y = (const u32x2*)(Y + ((size_t)pre[e] * 256 + slot) * D) + lane;
#pragma unroll
            for (int j = 0; j < 4; ++j) { const u32x2 w = y[64 * j]; acc.v[j] += (f32x4){bflo(w.x), bfhi(w.x), bflo(w.y), bfhi(w.y)} * g; } }
#pragma unroll
        for (int j = 0; j < 4; ++j) v.v[j] += ((const f32x4*)g2)[lane + 64 * j] * acc.v[j];
        if (MODE == 0) {
            f32x4* xo = (f32x4*)(WSP(float, WS_X2) + (size_t)r * D) + lane;
#pragma unroll
            for (int j = 0; j < 4; ++j) xo[64 * j] = v.v[j];
            const float* m = MOD + (size_t)(1 * 5 + mod_row(r)) * 6144;
            norm_mod(v, P.in[6] + D, m + 1024, m, lane);
            store_row_bf16(WSP(bf16, WS_HN) + (size_t)r * D, v, lane);
        } else {
            f32x4* xo = (f32x4*)(P.out + (size_t)r * D) + lane;
#pragma unroll
            for (int j = 0; j < 4; ++j) xo[64 * j] = v.v[j];
        }
    }
}

constexpr int NPHASE = 20;
struct Args { Ptrs P; int ph_lo, ph_hi; };
__global__ void __launch_bounds__(NTHR, 2) mk_fwd(Args args) {
    extern __shared__ __attribute__((aligned(16))) unsigned char lds[];
    Fr F; F.P = args.P; F.lds = lds;
    F.tid = threadIdx.x; F.lane = F.tid & 63; F.wave = __builtin_amdgcn_readfirstlane(F.tid >> 6);
    F.nblk = gridDim.x; F.blk = blockIdx.x; F.gw = F.blk * NWAVES + F.wave; F.ngw = F.nblk * NWAVES;
    F.gtid = (size_t)F.blk * NTHR + F.tid; F.gsz = (size_t)F.nblk * NTHR;
    const Ptrs& P = F.P;
    if (F.tid < 64) ((unsigned*)(lds + LDS_MISC))[F.tid] = 0u;
    __syncthreads();
    const int lo = args.ph_lo, hi = args.ph_hi;
    XcdBarrier bar; bar.bar = (unsigned*)(P.ws + WS_CTL); bar.x = 0; bar.st = nullptr;
    if (hi - lo > 1) bar = xcd_barrier_post((unsigned*)(P.ws + WS_CTL), (volatile LAS unsigned*)(lds + LDS_MISC));
#define IN(k) (lo <= (k) && (k) < hi)
#define SEAM(k) do { if (IN(k) && IN((k) + 1)) xcd_barrier(bar); } while (0)
    const float* MOD = WSP(float, WS_MOD);
    if (IN(0)) { ph_prologue(F); } SEAM(0);
    if (IN(1)) { ph_norm0(F); } SEAM(1);
    if (IN(2)) { ph_gemm(F, WSP(bf16, WS_HN), 1024, WSP(bf16, WS_WIN), 1024, NT, 1536, 1024, GF32{EpiF32{WSP(float, WS_Z), ZLD, EVEN_IN}}); } SEAM(2);
    if (IN(3)) { ph_e3(F); ph_lru<0>(F); } SEAM(3);
    if (IN(4)) { ph_gemm(F, WSP(bf16, WS_QKVN), 384, WSP(bf16, WS_WQKVB), 384, NT, 1792, 384, GF32{EpiF32{WSP(float, WS_QKVR), 1792, 1792}}); } SEAM(4);
    if (IN(5)) { ph_lru<1>(F); ph_e5(F); } SEAM(5);
    if (IN(6)) { ph_attn_mla(F); } SEAM(6);
    if (IN(7)) { ph_gemm(F, WSP(bf16, WS_YM), 1024, WSP(bf16, WS_WOE), 1024, NT, 1024, 1024, GResid{EpiResid{P.in[0], P.in[2], WSP(float, WS_X1), MOD + 2 * 1024}}); } SEAM(7);
    if (IN(8)) { ph_router(F, 0, NT); } SEAM(8);
    if (IN(9)) { ph_moe_gemm<1>(F, 0); } SEAM(9);
    if (IN(10)) { ph_moe_gemm<2>(F, 0); } SEAM(10);
    if (IN(11)) { ph_combine<0>(F, 0, NT); } SEAM(11);
    if (IN(12)) { ph_gemm(F, WSP(bf16, WS_HN), 1024, WSP(bf16, WS_WQO), 1024, NT, 1536, 1024, GF32{EpiF32{WSP(float, WS_Z), ZLD, 1536}}); } SEAM(12);
    if (IN(13)) { ph_oprep(F); } SEAM(13);
    if (IN(14)) { ph_attn_gqa(F); } SEAM(14);
    if (IN(15)) { ph_gemm(F, WSP(bf16, WS_YM), 1024, WSP(bf16, WS_WOO), 1024, NL, 1024, 1024, GResid{EpiResid{WSP(float, WS_X2), WSP(float, WS_X2) + (size_t)NL * D, WSP(float, WS_X1), MOD + 5 * 6144 + 2 * 1024}}); } SEAM(15);
    if (IN(16)) { ph_router(F, 1, NL); } SEAM(16);
    if (IN(17)) { ph_moe_gemm<1>(F, 1); } SEAM(17);
    if (IN(18)) { ph_moe_gemm<2>(F, 1); } SEAM(18);
    if (IN(19)) { ph_combine<1>(F, 1, NL); }
#undef IN
#undef SEAM
}

#ifndef MK_N_LAUNCHES
#define MK_N_LAUNCHES 1
#endif
extern "C" void kernel_launch(void* const* d_in, const int* in_sizes, int n_in, void* d_out, int out_size, void* d_ws, size_t ws_size, hipStream_t stream) {
    static int grid = 0;
    if (grid == 0) {
        if (n_in != 33 || ws_size < WS_END) { fprintf(stderr, "kernel_launch: unexpected n_in %d or ws_size %zu < %zu\n", n_in, ws_size, (size_t)WS_END); grid = -1; return; }
        int dev = 0, cus = 0, per_cu = 0;
        if (hipGetDevice(&dev) != hipSuccess || hipDeviceGetAttribute(&cus, hipDeviceAttributeMultiprocessorCount, dev) != hipSuccess) { grid = -1; return; }
        if (hipFuncSetAttribute((const void*)mk_fwd, hipFuncAttributeMaxDynamicSharedMemorySize, LDS_BYTES) != hipSuccess) { fprintf(stderr, "kernel_launch: hipFuncSetAttribute failed\n"); grid = -1; return; }
        if (hipOccupancyMaxActiveBlocksPerMultiprocessor(&per_cu, (const void*)mk_fwd, NTHR, LDS_BYTES) != hipSuccess || per_cu < 1) { fprintf(stderr, "kernel_launch: occupancy query says %d blocks per CU\n", per_cu); grid = -1; return; }
        (void)hipGetLastError();
        grid = cus;
    }
    if (grid < 0) return;
    Args a{};
    for (int i = 0; i < 33; ++i) a.P.in[i] = (const float*)d_in[i];
    a.P.out = (float*)d_out; a.P.ws = (unsigned char*)d_ws;
    (void)hipMemsetAsync((unsigned char*)d_ws + WS_CTL, 0, CTL_BYTES, stream);
    if (MK_N_LAUNCHES == 1) { a.ph_lo = 0; a.ph_hi = NPHASE; hipLaunchKernelGGL(mk_fwd, dim3(grid), dim3(NTHR), LDS_BYTES, stream, a); }
    else for (int p = 0; p < NPHASE; ++p) { a.ph_lo = p; a.ph_hi = p + 1; hipLaunchKernelGGL(mk_fwd, dim3(grid), dim3(NTHR), LDS_BYTES, stream, a); }
}
```

```cpp
#include <hip/hip_runtime.h>
#include <stdint.h>
#include <stdio.h>

typedef unsigned short bf16;
typedef short bf16x8 __attribute__((ext_vector_type(8)));
typedef float f32x4 __attribute__((ext_vector_type(4)));
typedef float f32x16 __attribute__((ext_vector_type(16)));
typedef unsigned u32x2 __attribute__((ext_vector_type(2)));
typedef unsigned u32x4 __attribute__((ext_vector_type(4)));

constexpr int D = 1024, NB = 4, SEQ = 4096, CTX = 256;
constexpr int NL = NB * SEQ, NC = NB * CTX, NT = NL + NC;
constexpr int TA = SEQ + CTX;
constexpr int NE = 32, TOPK = 4;
constexpr int EVEN_IN = 1440, ZLD = 1536;
constexpr int MAXT256 = 304;
constexpr int ACT_ROWS = MAXT256 * 256;

constexpr size_t al256(size_t x) { return (x + 255) & ~(size_t)255; }
constexpr size_t WS_CTL = 0, CTL_BYTES = 1u << 20;
constexpr size_t CW_CNT = 65536;
constexpr size_t WS_MOD = WS_CTL + CTL_BYTES;
constexpr size_t WS_ROPEM = al256(WS_MOD + 2 * 5 * 6144 * 4);
constexpr size_t WS_ROPEG = al256(WS_ROPEM + 4096 * 16 * 2 * 4);
constexpr size_t WS_WRT = al256(WS_ROPEG + 4096 * 32 * 2 * 4);
constexpr size_t WS_WRI = al256(WS_WRT + 2 * 32 * 1024 * 4);
constexpr size_t WS_WIN = al256(WS_WRI + 2 * 8 * 128 * 64 * 2);
constexpr size_t WS_WQKVB = al256(WS_WIN + 1536 * 1024 * 2);
constexpr size_t WS_WOE = al256(WS_WQKVB + 1792 * 384 * 2);
constexpr size_t WS_WQO = al256(WS_WOE + 1024 * 1024 * 2);
constexpr size_t WS_WOO = al256(WS_WQO + 1536 * 1024 * 2);
constexpr size_t WS_WGU = al256(WS_WOO + 1024 * 1024 * 2);
constexpr size_t WS_WDN = al256(WS_WGU + (size_t)2 * 32 * 2048 * 1024 * 2);
constexpr size_t WS_HN = al256(WS_WDN + (size_t)2 * 32 * 1024 * 1024 * 2);
constexpr size_t WS_Z = al256(WS_HN + (size_t)NT * D * 2);
constexpr size_t WS_QKVN = al256(WS_Z + (size_t)NT * ZLD * 4);
constexpr size_t WS_QKVR = al256(WS_QKVN + (size_t)NT * 384 * 2);
constexpr size_t WS_QM = al256(WS_QKVR + (size_t)NT * 1792 * 4);
constexpr size_t WS_KM = al256(WS_QM + (size_t)NB * 8 * TA * 96 * 2);
constexpr size_t WS_VM = al256(WS_KM + (size_t)NB * 8 * TA * 96 * 2);
constexpr size_t WS_QG = al256(WS_VM + (size_t)NB * 8 * TA * 64 * 2);
constexpr size_t WS_KG = al256(WS_QG + (size_t)NB * 16 * SEQ * 64 * 2);
constexpr size_t WS_VG = al256(WS_KG + (size_t)NB * 4 * TA * 64 * 2);
constexpr size_t WS_YM = al256(WS_VG + (size_t)NB * 4 * TA * 64 * 2);
constexpr size_t WS_X1 = al256(WS_YM + (size_t)NT * D * 2);
constexpr size_t WS_X2 = al256(WS_X1 + (size_t)NT * D * 4);
constexpr size_t WS_F = al256(WS_X2 + (size_t)NT * D * 4);
constexpr size_t WS_LA = al256(WS_F + (size_t)NT * D * 2);
constexpr size_t WS_LB = al256(WS_LA + (size_t)2 * NT * 512 * 4);
constexpr size_t WS_LH = al256(WS_LB + (size_t)2 * NT * 512 * 4);
constexpr size_t WS_XF = al256(WS_LH + (size_t)2 * NT * 512 * 4);
constexpr size_t WS_PE = al256(WS_XF + (size_t)2 * NT * 512 * 4);
constexpr size_t WS_PS = al256(WS_PE + (size_t)NT * 4 * 4);
constexpr size_t WS_PG = al256(WS_PS + (size_t)NT * 4 * 4);
constexpr size_t WS_TOK = al256(WS_PG + (size_t)NT * 4 * 4);
constexpr size_t WS_ACT = al256(WS_TOK + (size_t)NE * NT * 4);
constexpr size_t WS_Y = al256(WS_ACT + (size_t)ACT_ROWS * D * 2);
constexpr size_t WS_END = al256(WS_Y + (size_t)ACT_ROWS * D * 2);

__device__ __forceinline__ unsigned f2bf(float f) { unsigned u = __float_as_uint(f); u += 0x7FFFu + ((u >> 16) & 1u); return u >> 16; }
typedef float f32x2_t __attribute__((ext_vector_type(2)));
typedef __bf16 bf16x2_t __attribute__((ext_vector_type(2)));
__device__ __forceinline__ unsigned pk2(float a, float b) { const f32x2_t v = {a, b}; return __builtin_bit_cast(unsigned, __builtin_convertvector(v, bf16x2_t)); }
__device__ __forceinline__ float bf2f(unsigned b) { return __uint_as_float(b << 16); }
__device__ __forceinline__ float bflo(unsigned u) { return __uint_as_float(u << 16); }
__device__ __forceinline__ float bfhi(unsigned u) { return __uint_as_float(u & 0xffff0000u); }
__device__ __forceinline__ float wave_sum(float v) {
#pragma unroll
    for (int o = 1; o < 64; o <<= 1) v += __shfl_xor(v, o);
    return v;
}

template <int CTRL> __device__ __forceinline__ float dppf(float v) { return __int_as_float(__builtin_amdgcn_update_dpp(0, __float_as_int(v), CTRL, 0xf, 0xf, true)); }
__device__ __forceinline__ float reduce16(float v) { v += dppf<0xB1>(v); v += dppf<0x4E>(v); v += dppf<0x124>(v); v += dppf<0x128>(v); return v; }
__device__ __forceinline__ float dot4(f32x4 a) { return a.x * a.x + a.y * a.y + a.z * a.z + a.w * a.w; }
__device__ __forceinline__ float sigmoidf_(float x) { return 1.f / (1.f + __expf(-x)); }
__device__ __forceinline__ float gelu_tanh(float x) { const float u = 0.7978845608028654f * (x + 0.044715f * x * x * x); return 0.5f * x * (1.f + tanhf(u)); }
__device__ __forceinline__ int mod_row(int r) { return r < NL ? (r >> 12) : 4; }
__device__ __forceinline__ void row_bs(int r, int& b, int& s) { if (r < NL) { b = r >> 12; s = r & 4095; } else { const int rc = r - NL; b = rc >> 8; s = SEQ + (rc & 255); } }


struct Ptrs {
    const float* in[33];
    float* out;
    unsigned char* ws;
};
#define WSP(T, off) ((T*)(P.ws + (off)))
#define LAS __attribute__((address_space(3)))

#define XB_TMO      128
#define XB_XCNT(j)  (256  + 64 * (j))
#define XB_XSUB(j)  (1280 + 64 * (j))
#define XB_XGEN(j)  (2304 + 64 * (j))
#define XB_TOP      3328
#define XB_TOPGEN   3392
#define XCD_BAR_WORDS 3456
#define XB_SPIN_CAP (1u << 18)
__device__ __forceinline__ unsigned xb_ld(unsigned* p)              { return __hip_atomic_load(p, __ATOMIC_RELAXED, __HIP_MEMORY_SCOPE_AGENT); }
__device__ __forceinline__ unsigned xb_add(unsigned* p, unsigned v) { return __hip_atomic_fetch_add(p, v, __ATOMIC_RELAXED, __HIP_MEMORY_SCOPE_AGENT); }
__device__ __forceinline__ unsigned xb_xcc_id() { return (unsigned)__builtin_amdgcn_s_getreg((3 << 11) | 20) & 0xFu; }
#define XB_SPIN(cond, bar) do { unsigned _sp = 0; while (cond) { __builtin_amdgcn_s_sleep(1); \
    if ((++_sp & 255u) == 0u) { if (xb_ld(&(bar)[XB_TMO])) break; if (_sp > XB_SPIN_CAP) { atomicAdd(&(bar)[XB_TMO], 1u); break; } } } } while (0)
struct XcdBarrier { unsigned* bar; unsigned x; volatile LAS unsigned* st; };
__device__ __forceinline__ XcdBarrier xcd_barrier_post(unsigned* bar, volatile LAS unsigned* st) {
    XcdBarrier b; b.bar = bar; b.x = xb_xcc_id(); b.st = st;
    if (threadIdx.x == 0) (void)xb_add(&bar[XB_XCNT(b.x)], 1u);
    return b;
}
__device__ __forceinline__ void xcd_barrier_complete(unsigned* bar, unsigned x, unsigned& nloc, unsigned& nx) {
    const unsigned G = gridDim.x * gridDim.y * gridDim.z;
    unsigned sum, cnt, mine, sp = 0u;
    for (;;) {
        sum = 0u; cnt = 0u; mine = 0u;
#pragma unroll
        for (unsigned j = 0; j < 16; ++j) { const unsigned c = xb_ld(&bar[XB_XCNT(j)]); sum += c; cnt += (c > 0u) ? 1u : 0u; mine = (j == x) ? c : mine; }
        if (sum == G) break;
        __builtin_amdgcn_s_sleep(1);
        if ((++sp & 255u) == 0u) { if (xb_ld(&bar[XB_TMO])) break; if (sp > XB_SPIN_CAP) { atomicAdd(&bar[XB_TMO], 1u); break; } }
    }
    nloc = mine > 0u ? mine : 1u; nx = cnt > 0u ? cnt : 1u;
}
__device__ __forceinline__ void xcd_barrier(const XcdBarrier& b) {
    asm volatile("s_waitcnt vmcnt(0)" ::: "memory");
    __syncthreads();
    if (threadIdx.x == 0) {
        unsigned* bar = b.bar;
        __builtin_amdgcn_s_waitcnt(0);
        unsigned nloc = b.st[0], nx = b.st[1];
        if (nloc == 0u) { xcd_barrier_complete(bar, b.x, nloc, nx); b.st[0] = nloc; b.st[1] = nx; }
        const unsigned old = xb_add(&bar[XB_XSUB(b.x)], 1u);
        const unsigned gen = old / nloc;
        if (old + 1u == (gen + 1u) * nloc) {
            __builtin_amdgcn_fence(__ATOMIC_RELEASE, "agent");
            asm volatile("s_waitcnt vmcnt(0)" ::: "memory");
            const unsigned og = xb_add(&bar[XB_TOP], 1u);
            const unsigned tg = og / nx;
            if (og + 1u == (tg + 1u) * nx) xb_add(&bar[XB_TOPGEN], 1u);
            else XB_SPIN(xb_ld(&bar[XB_TOPGEN]) == tg, bar);
            __builtin_amdgcn_fence(__ATOMIC_ACQUIRE, "agent");
            xb_add(&bar[XB_XGEN(b.x)], 1u);
            asm volatile("s_waitcnt vmcnt(0)" ::: "memory");
        } else {
            XB_SPIN(xb_ld(&bar[XB_XGEN(b.x)]) == gen, bar);
            __builtin_amdgcn_fence(__ATOMIC_ACQUIRE, "agent");
            asm volatile("s_waitcnt vmcnt(0)" ::: "memory");
        }
    }
    __syncthreads();
}

constexpr int NTHR = 512, NWAVES = 8;
constexpr int LRU_ST = 16, LRU_NST = 64 / LRU_ST;
constexpr int LRU_AT = LRU_ST * 144, LRU_GT = LRU_ST * 272, LRU_HT = 64 * 128, LRU_WB = LRU_AT + LRU_GT + LRU_HT;

constexpr int LDS_RING = 131072;
constexpr int LDS_MISC = LDS_RING;
constexpr int LDS_BYTES = LDS_RING + 4096;
struct Fr {
    Ptrs P; unsigned char* lds;
    int tid, lane, wave, gw, ngw, nblk, blk; size_t gtid, gsz;
};

__device__ __forceinline__ void transpose_item(const float* W, int ldw, bf16* WT, int ldt, int k0, int n0, int row_off, int col_off, int map, float* scr, int lane) {
#pragma unroll 8
    for (int i = 0; i < 32; ++i) { const int kk = 2 * i + (lane >> 5); scr[kk * 33 + (lane & 31)] = W[(size_t)(k0 + kk) * ldw + n0 + (lane & 31)]; }
    __builtin_amdgcn_s_waitcnt(0xc07f); asm volatile("" ::: "memory");
    const int c = lane & 7;
#pragma unroll
    for (int j = 0; j < 4; ++j) { const int n = (lane >> 3) + 8 * j; const float* s = scr + (8 * c) * 33 + n;
        u32x4 o; o.x = pk2(s[0 * 33], s[1 * 33]); o.y = pk2(s[2 * 33], s[3 * 33]); o.z = pk2(s[4 * 33], s[5 * 33]); o.w = pk2(s[6 * 33], s[7 * 33]);
        int nn = n0 + n;
        if (map == 1) { const int up = nn >= 1024, jj = nn & 1023; nn = (jj >> 4) * 32 + up * 16 + (jj & 15); }
        *(u32x4*)(WT + (size_t)(row_off + nn) * ldt + col_off + k0 + 8 * c) = o; }
    __builtin_amdgcn_s_waitcnt(0xc07f); asm volatile("" ::: "memory");
}
struct TJob { const float* W; bf16* WT; int K, N, ldw, ldt, row_off, col_off, map; long wstride, tstride; int count; };
constexpr int NJOBS = 8;
__device__ __forceinline__ TJob get_job(const Ptrs& P, int j) {
    TJob t; t.row_off = 0; t.col_off = 0; t.map = 0; t.wstride = 0; t.tstride = 0; t.count = 1;
    switch (j) {
    case 0: t.W = P.in[29]; t.WT = WSP(bf16, WS_WGU); t.K = 1024; t.N = 2048; t.ldw = 2048; t.ldt = 1024; t.map = 1; t.wstride = (long)1024 * 2048; t.tstride = (long)2048 * 1024; t.count = 64; break;
    case 1: t.W = P.in[31]; t.WT = WSP(bf16, WS_WDN); t.K = 1024; t.N = 1024; t.ldw = 1024; t.ldt = 1024; t.wstride = (long)1024 * 1024; t.tstride = (long)1024 * 1024; t.count = 64; break;
    case 2: t.W = P.in[8]; t.WT = WSP(bf16, WS_WIN); t.K = 1024; t.N = 1440; t.ldw = 1440; t.ldt = 1024; break;
    case 3: t.W = P.in[17]; t.WT = WSP(bf16, WS_WQKVB); t.K = 256; t.N = 768; t.ldw = 768; t.ldt = 384; break;
    case 4: t.W = P.in[19]; t.WT = WSP(bf16, WS_WQKVB); t.K = 128; t.N = 1024; t.ldw = 1024; t.ldt = 384; t.row_off = 768; t.col_off = 256; break;
    case 5: t.W = P.in[22]; t.WT = WSP(bf16, WS_WOE); t.K = 1024; t.N = 1024; t.ldw = 1024; t.ldt = 1024; break;
    case 6: t.W = P.in[23]; t.WT = WSP(bf16, WS_WQO); t.K = 1024; t.N = 1536; t.ldw = 1536; t.ldt = 1024; break;
    default: t.W = P.in[26]; t.WT = WSP(bf16, WS_WOO); t.K = 1024; t.N = 1024; t.ldw = 1024; t.ldt = 1024; break;
    }
    return t;
}
__device__ __forceinline__ void ph_prologue(Fr& F) {
    const Ptrs& P = F.P;
    if (F.blk < 24) {
        float* sl = (float*)(F.lds + 8 * 64 * 33 * 4);
        const float* c = P.in[1]; const float* cc = P.in[3];
        for (int i = F.tid; i < 5 * 1024; i += NTHR) { const int r = i >> 10, k = i & 1023; const float v = r < 4 ? c[r * 1024 + k] : cc[k]; sl[i] = v / (1.f + __expf(-v)); }
        __syncthreads();
        const int gid = F.blk * NTHR + F.tid, l = gid / 6144, j = gid % 6144;
        const float* w = P.in[4] + (size_t)l * 1024 * 6144 + j;
        float acc[5] = {0.f, 0.f, 0.f, 0.f, 0.f};
#pragma unroll 8
        for (int k = 0; k < 1024; ++k) { const float wv = w[(size_t)k * 6144];
#pragma unroll
            for (int r = 0; r < 5; ++r) acc[r] += sl[r * 1024 + k] * wv; }
        float* MOD = WSP(float, WS_MOD);
        const float bm = P.in[5][l * 6144 + j];
#pragma unroll
        for (int r = 0; r < 5; ++r) MOD[(l * 5 + r) * 6144 + j] = acc[r] + bm;
    }
    for (size_t gid = F.gtid; gid < 4096 * 48; gid += F.gsz) {
        const int s = (int)(gid / 48), i = (int)(gid % 48); const int row = s >> 6, col = s & 63;
        if (i < 16) { const int fi = i & 7; const float fr = powf(10000.f, -(float)fi / 8.f); const float ang = (float)(i < 8 ? row : col) * fr;
            float* T = WSP(float, WS_ROPEM) + ((size_t)s * 16 + i) * 2; T[0] = cosf(ang); T[1] = sinf(ang); }
        else { const int ii = i - 16, fi = ii & 15; const float fr = powf(10000.f, -(float)fi / 16.f); const float ang = (float)(ii < 16 ? row : col) * fr;
            float* T = WSP(float, WS_ROPEG) + ((size_t)s * 32 + ii) * 2; T[0] = cosf(ang); T[1] = sinf(ang); }
    }
    for (size_t gid = F.gtid; gid < 2 * 32 * 1024; gid += F.gsz) { const int l = (int)(gid >> 15), e = (int)(gid >> 10) & 31, k = (int)gid & 1023;
        WSP(float, WS_WRT)[gid] = P.in[27][((size_t)l * 1024 + k) * 32 + e]; }
    for (size_t gid = F.gtid; gid < 2 * 8 * 128 * 64; gid += F.gsz) { const int c = (int)gid & 63, o = (int)(gid >> 6) & 127, blk = (int)(gid >> 13) & 7, dir = (int)(gid >> 16);
        const float* src = o < 64 ? P.in[11] : P.in[13];
        WSP(bf16, WS_WRI)[gid] = (bf16)f2bf(src[(((size_t)dir * 8 + blk) * 64 + c) * 64 + (o & 63)]); }
    { u32x4* z = (u32x4*)(WSP(bf16, WS_WIN) + (size_t)1440 * 1024); for (size_t i = F.gtid; i < (size_t)96 * 1024 * 2 / 16; i += F.gsz) z[i] = (u32x4){0u, 0u, 0u, 0u};
      bf16* q = WSP(bf16, WS_WQKVB);
      for (size_t i = F.gtid; i < (size_t)768 * 16; i += F.gsz) { const int r = (int)(i >> 4), c = (int)(i & 15); *(u32x4*)(q + (size_t)r * 384 + 256 + c * 8) = (u32x4){0u, 0u, 0u, 0u}; }
      for (size_t i = F.gtid; i < (size_t)1024 * 32; i += F.gsz) { const int r = (int)(i >> 5), c = (int)(i & 31); *(u32x4*)(q + (size_t)(768 + r) * 384 + c * 8) = (u32x4){0u, 0u, 0u, 0u}; } }
    float* scr = (float*)(F.lds + F.wave * 64 * 33 * 4);
    long base = 0;
#pragma unroll 1
    for (int j = 0; j < NJOBS; ++j) {
        const TJob t = get_job(P, j);
        const int nnb = t.N / 32; const long per = (long)(t.K / 64) * nnb, total = per * t.count;
        long first = ((long)F.gw - base % F.ngw + F.ngw) % F.ngw;
        for (long it = first; it < total; it += F.ngw) {
            const int m = (int)(it / per); const int r = (int)(it % per); const int kb = r / nnb, nb = r % nnb;
            transpose_item(t.W + (size_t)m * t.wstride, t.ldw, t.WT + (size_t)m * t.tstride, t.ldt, kb * 64, nb * 32, t.row_off, t.col_off, t.map, scr, F.lane);
        }
        base += total;
    }
}

struct RowV { f32x4 v[4]; };
__device__ __forceinline__ RowV load_row(const float* p, int lane) { RowV r; const f32x4* q = (const f32x4*)p + lane;
#pragma unroll
    for (int j = 0; j < 4; ++j) r.v[j] = q[64 * j]; return r; }
__device__ __forceinline__ void norm_mod(RowV& r, const float* g, const float* sc, const float* sh, int lane) {
    float s = 0.f;
#pragma unroll
    for (int j = 0; j < 4; ++j) s += r.v[j].x * r.v[j].x + r.v[j].y * r.v[j].y + r.v[j].z * r.v[j].z + r.v[j].w * r.v[j].w;
    const float rs = rsqrtf(wave_sum(s) * (1.f / D) + 1e-6f);
#pragma unroll
    for (int j = 0; j < 4; ++j) { const f32x4 gv = ((const f32x4*)g)[lane + 64 * j], scv = ((const f32x4*)sc)[lane + 64 * j], shv = ((const f32x4*)sh)[lane + 64 * j];
        r.v[j] = (r.v[j] * rs * gv) * (scv + 1.f) + shv; }
}
__device__ __forceinline__ void store_row_bf16(bf16* p, const RowV& r, int lane) { u32x2* q = (u32x2*)p + lane;
#pragma unroll
    for (int j = 0; j < 4; ++j) { u32x2 o; o.x = pk2(r.v[j].x, r.v[j].y); o.y = pk2(r.v[j].z, r.v[j].w); q[64 * j] = o; } }
__device__ __forceinline__ const float* xrow0(const Ptrs& P, int r) { return r < NL ? P.in[0] + (size_t)r * D : P.in[2] + (size_t)(r - NL) * D; }

__device__ __forceinline__ void ph_norm0(Fr& F) {
    const Ptrs& P = F.P; const float* MOD = WSP(float, WS_MOD);
    for (int r = F.gw; r < NT; r += F.ngw) {
        RowV v = load_row(xrow0(P, r), F.lane);
        const float* m = MOD + (size_t)mod_row(r) * 6144;
        norm_mod(v, P.in[6], m + 1024, m, F.lane);
        store_row_bf16(WSP(bf16, WS_HN) + (size_t)r * D, v, F.lane);
    }
}

__device__ __forceinline__ void wtile(const bf16* a0, const bf16* a1, const bf16* b0, const bf16* b1, int K, f32x4 (&acc)[2][2]) {
#pragma unroll
    for (int m = 0; m < 2; ++m)
#pragma unroll
        for (int n = 0; n < 2; ++n) acc[m][n] = (f32x4){0.f, 0.f, 0.f, 0.f};
#pragma unroll 2
    for (int k = 0; k < K; k += 32) {
        const bf16x8 A0 = *(const bf16x8*)(a0 + k), A1 = *(const bf16x8*)(a1 + k), B0 = *(const bf16x8*)(b0 + k), B1 = *(const bf16x8*)(b1 + k);
        acc[0][0] = __builtin_amdgcn_mfma_f32_16x16x32_bf16(B0, A0, acc[0][0], 0, 0, 0);
        acc[0][1] = __builtin_amdgcn_mfma_f32_16x16x32_bf16(B1, A0, acc[0][1], 0, 0, 0);
        acc[1][0] = __builtin_amdgcn_mfma_f32_16x16x32_bf16(B0, A1, acc[1][0], 0, 0, 0);
        acc[1][1] = __builtin_amdgcn_mfma_f32_16x16x32_bf16(B1, A1, acc[1][1], 0, 0, 0);
    }
}
struct EpiF32 { float* C; int ldc, nvalid;
    __device__ __forceinline__ void operator()(int row, int col, f32x4 a, f32x4 b) const {
        if (col < nvalid) *(f32x4*)(C + (size_t)row * ldc + col) = a;
        if (col + 16 < nvalid) *(f32x4*)(C + (size_t)row * ldc + col + 16) = b; } };
struct EpiResid { const float* xin0; const float* xin1; float* xout; const float* g;
    __device__ __forceinline__ void operator()(int row, int col, f32x4 a, f32x4 b) const {
        const float* xi = row < NL ? xin0 + (size_t)row * D : xin1 + (size_t)(row - NL) * D; const float* gg = g + (size_t)mod_row(row) * 6144;
        float* xo = xout + (size_t)row * D;
        *(f32x4*)(xo + col) = *(const f32x4*)(xi + col) + *(const f32x4*)(gg + col) * a;
        *(f32x4*)(xo + col + 16) = *(const f32x4*)(xi + col + 16) + *(const f32x4*)(gg + col + 16) * b; } };
struct EpiSwiglu { bf16* act; const float* bias;
    __device__ __forceinline__ void operator()(int row, int col, f32x4 a, f32x4 b) const {
        const int j = (col >> 5) * 16 + (col & 15);
        const f32x4 bg = *(const f32x4*)(bias + j), bu = *(const f32x4*)(bias + 1024 + j);
        float o[4];
#pragma unroll
        for (int i = 0; i < 4; ++i) { float hg = a[i] + bg[i], hu = b[i] + bu[i]; hg = fminf(hg, 7.f); hu = fminf(fmaxf(hu, -7.f), 7.f);
            o[i] = hg * sigmoidf_(1.702f * hg) * (hu + 1.f); }
        u32x2 w; w.x = pk2(o[0], o[1]); w.y = pk2(o[2], o[3]);
        *(u32x2*)(act + (size_t)row * D + j) = w; } };
struct EpiBiasBf16 { bf16* Y; const float* bias;
    __device__ __forceinline__ void operator()(int row, int col, f32x4 a, f32x4 b) const {
        const f32x4 b0 = *(const f32x4*)(bias + col), b1 = *(const f32x4*)(bias + col + 16);
        u32x2 w; w.x = pk2(a[0] + b0[0], a[1] + b0[1]); w.y = pk2(a[2] + b0[2], a[3] + b0[3]); *(u32x2*)(Y + (size_t)row * D + col) = w;
        w.x = pk2(b[0] + b1[0], b[1] + b1[1]); w.y = pk2(b[2] + b1[2], b[3] + b1[3]); *(u32x2*)(Y + (size_t)row * D + col + 16) = w; } };

template <class Epi>
__device__ __forceinline__ void ph_sgemm(Fr& F, const bf16* A, int lda, const bf16* Bt, int ldb, int M, int N, int K, const Epi& E) {
    const int fr = F.lane & 15, fq = F.lane >> 4; const int ng = N / 32, nt = (M / 32) * ng;
    for (int t = F.gw; t < nt; t += F.ngw) {
        const int row0 = (t / ng) * 32, col0 = (t % ng) * 32;
        f32x4 acc[2][2];
        wtile(A + (size_t)(row0 + fr) * lda + 8 * fq, A + (size_t)(row0 + 16 + fr) * lda + 8 * fq,
              Bt + (size_t)(col0 + fr) * ldb + 8 * fq, Bt + (size_t)(col0 + 16 + fr) * ldb + 8 * fq, K, acc);
#pragma unroll
        for (int m = 0; m < 2; ++m) E(row0 + m * 16 + fr, col0 + 4 * fq, acc[m][0], acc[m][1]);
    }
}
__device__ __forceinline__ void moe_prefix(Fr& F, int layer) {
    int* pre = (int*)(F.lds + LDS_MISC + 64);
    const int* cnt = (const int*)(F.P.ws + WS_CTL + CW_CNT) + layer * NE;
    __syncthreads();
    if (F.tid == 0) { int s = 0; for (int e = 0; e < NE; ++e) { pre[e] = s; s += (cnt[e] + 255) >> 8; } pre[NE] = s; }
    __syncthreads();
}
__device__ __forceinline__ int moe_find(const int* pre, int t256) { int e = 0;
#pragma unroll 1
    for (int i = 0; i < NE; ++i) e = (pre[i + 1] <= t256) ? i + 1 : e;
    return e; }
template <int STAGE>
__device__ __forceinline__ void ph_moe_sgemm(Fr& F, int layer) {
    const Ptrs& P = F.P;
    moe_prefix(F, layer);
    const int* pre = (const int*)(F.lds + LDS_MISC + 64);
    const int* cnt = (const int*)(P.ws + WS_CTL + CW_CNT) + layer * NE;
    const int fr = F.lane & 15, fq = F.lane >> 4;
    constexpr int N = STAGE == 1 ? 2048 : 1024, ng = N / 32;
    const int nt = pre[NE] * 8 * ng;
    const int* toklist = WSP(int, WS_TOK);
    for (int t = F.gw; t < nt; t += F.ngw) {
        const int t256 = t / (8 * ng), rem = t % (8 * ng), sub = rem / ng, g = rem % ng;
        const int e = moe_find(pre, t256), mt = t256 - pre[e];
        const int row0 = t256 * 256 + sub * 32, col0 = g * 32;
        f32x4 acc[2][2];
        if (STAGE == 1) {
            const int s0 = mt * 256 + sub * 32 + fr, s1 = s0 + 16; const int c = cnt[e];
            const int tk0 = s0 < c ? toklist[(size_t)e * NT + s0] : 0, tk1 = s1 < c ? toklist[(size_t)e * NT + s1] : 0;
            const bf16* Fb = WSP(bf16, WS_F); const bf16* Bt = WSP(bf16, WS_WGU) + ((size_t)layer * NE + e) * 2048 * 1024;
            wtile(Fb + (size_t)tk0 * D + 8 * fq, Fb + (size_t)tk1 * D + 8 * fq, Bt + (size_t)(col0 + fr) * D + 8 * fq, Bt + (size_t)(col0 + 16 + fr) * D + 8 * fq, D, acc);
            EpiSwiglu E{WSP(bf16, WS_ACT), P.in[30] + ((size_t)layer * NE + e) * 2048};
#pragma unroll
            for (int m = 0; m < 2; ++m) E(row0 + m * 16 + fr, col0 + 4 * fq, acc[m][0], acc[m][1]);
        } else {
            const bf16* A = WSP(bf16, WS_ACT); const bf16* Bt = WSP(bf16, WS_WDN) + ((size_t)layer * NE + e) * 1024 * 1024;
            wtile(A + (size_t)(row0 + fr) * D + 8 * fq, A + (size_t)(row0 + 16 + fr) * D + 8 * fq, Bt + (size_t)(col0 + fr) * D + 8 * fq, Bt + (size_t)(col0 + 16 + fr) * D + 8 * fq, D, acc);
            EpiBiasBf16 E{WSP(bf16, WS_Y), P.in[32] + ((size_t)layer * NE + e) * 1024};
#pragma unroll
            for (int m = 0; m < 2; ++m) E(row0 + m * 16 + fr, col0 + 4 * fq, acc[m][0], acc[m][1]);
        }
    }
}


namespace pg {
constexpr int BM = 256, BK = 64, HALF = 128, HTB = HALF * BK * 2, STAGE_BYTES = 8 * HTB, NXCD = 8, WGM = 8;
__device__ __forceinline__ int lds_byte(int r, int c) { const int st = (r >> 4) * 2 + (c >> 5), rr = r & 15, cc = c & 31, ob = rr * 64 + cc * 2; return st * 1024 + (ob ^ (((ob >> 9) & 1) << 5)); }
__device__ __forceinline__ void stage_rc(int b, int& R, int& C) { const int st = b / 1024, sb = b % 1024, swz = sb ^ (((sb >> 9) & 1) << 5); R = (st >> 1) * 16 + swz / 64; C = (st & 1) * 32 + (swz % 64) / 2; }
struct Unit { int pm, pn, e, mt; };
struct DenseSched {
    const bf16* A; const bf16* Bt; int lda, ldb, K; int nM, nN, nwg, G, c;
    __device__ __forceinline__ void init(const bf16* A_, int lda_, const bf16* Bt_, int ldb_, int M, int N, int K_, int G_, int c_) { A = A_; Bt = Bt_; lda = lda_; ldb = ldb_; K = K_; nM = M / BM; nN = N / BM; nwg = nM * nN; G = G_; c = c_; }
    __device__ __forceinline__ bool next(int i, Unit& u) const {
        const long L = (long)i * G + c; if (L >= nwg) return false;
        int wgid = (int)L; { const int q = nwg / NXCD, r = nwg % NXCD, xcd = wgid % NXCD, off = wgid / NXCD; wgid = (xcd < r ? xcd * (q + 1) : r * (q + 1) + (xcd - r) * q) + off; }
        const int nig = WGM * nN, gid = wgid / nig, fm = gid * WGM, gsz = (nM - fm) < WGM ? (nM - fm) : WGM;
        u.pm = fm + ((wgid % nig) % gsz); u.pn = (wgid % nig) / gsz; u.e = 0; u.mt = 0; return true;
    }
    __device__ __forceinline__ unsigned aoff(const Unit& u, int r, int C) const { return (unsigned)((u.pm * BM + r) * lda + C) * 2u; }
    __device__ __forceinline__ const char* bbase(const Unit& u) const { return (const char*)(Bt + (size_t)u.pn * BM * ldb); }
};
template <int STAGE> struct MoeSched {
    const bf16* A; const bf16* Bt; int lda, ldb, K; int G, c, NN, nunits; const int* pre; const int* cnt; const int* toklist;
    __device__ __forceinline__ bool next(int i, Unit& u) const {
        const long L = (long)i * G + c; if (L >= nunits) return false;
        const int t256 = (int)(L / NN); u.pn = (int)(L % NN); u.pm = t256; u.e = moe_find(pre, t256); u.mt = t256 - pre[u.e]; return true;
    }
    __device__ __forceinline__ unsigned aoff(const Unit& u, int r, int C) const {
        if (STAGE == 1) { const int slot = u.mt * BM + r; const int tok = slot < cnt[u.e] ? toklist[(size_t)u.e * NT + slot] : 0; return (unsigned)(tok * lda + C) * 2u; }
        return (unsigned)((u.pm * BM + r) * lda + C) * 2u;
    }
    __device__ __forceinline__ const char* bbase(const Unit& u) const { return (const char*)(Bt + ((size_t)u.e * NN * BM + (size_t)u.pn * BM) * ldb); }
};

template <class Sched, class Epi>
__device__ __forceinline__ void gemm_phase(LAS unsigned char* lds, const Sched& S, const Epi& E) {
    const int tid = threadIdx.x, wid = __builtin_amdgcn_readfirstlane(tid >> 6), lane = tid & 63, wr = wid >> 2, wc = wid & 3, fr = lane & 15, fq = lane >> 4;
    const int K = S.K, nt = K / BK;
    int Rr[2], Cc[2]; unsigned voffB[2];
#pragma unroll
    for (int i = 0; i < 2; ++i) { stage_rc(tid * 16 + i * 8192, Rr[i], Cc[i]); voffB[i] = (unsigned)(Rr[i] * S.ldb + Cc[i]) * 2u; }
    const size_t kstep = (size_t)(BK * 2);
    const size_t hstepB = (size_t)HALF * S.ldb * 2;
    const unsigned ldsw = (unsigned)wid * 1024u;
    const int aoff = lds_byte(wr * 64 + fr, fq * 8), boff = lds_byte(wc * 32 + fr, fq * 8);
#define PG_SA(b, h) (((b) * 2 + (h)) * HTB)
#define PG_SB(b, h) ((4 + (b) * 2 + (h)) * HTB)
#define PG_STAGE(bufoff, gbase, voff) do { _Pragma("unroll") for (int _i = 0; _i < 2; ++_i) \
        __builtin_amdgcn_global_load_lds((const unsigned*)((const char*)(gbase) + (voff)[_i]), (LAS unsigned*)(lds + (bufoff) + ldsw + _i * 8192), 16, 0, 0); } while (0)
#define PG_LDA(dst, b, h) do { _Pragma("unroll") for (int m = 0; m < 4; ++m) _Pragma("unroll") for (int k = 0; k < 2; ++k) dst[m][k] = *(const LAS bf16x8*)(lds + PG_SA(b, h) + aoff + m * 2048 + k * 1024); } while (0)
#define PG_LDB(dst, b, h) do { _Pragma("unroll") for (int n = 0; n < 2; ++n) _Pragma("unroll") for (int k = 0; k < 2; ++k) dst[n][k] = *(const LAS bf16x8*)(lds + PG_SB(b, h) + boff + n * 2048 + k * 1024); } while (0)
#define PG_MMA(ai, bj, At, Bt) do { __builtin_amdgcn_s_setprio(1); _Pragma("unroll") for (int m = 0; m < 4; ++m) _Pragma("unroll") for (int n = 0; n < 2; ++n) _Pragma("unroll") for (int k = 0; k < 2; ++k) \
        acc[ai][bj][m][n] = __builtin_amdgcn_mfma_f32_16x16x32_bf16(Bt[n][k], At[m][k], acc[ai][bj][m][n], 0, 0, 0); __builtin_amdgcn_s_setprio(0); } while (0)
#define PG_WAIT_V(n) asm volatile("s_waitcnt vmcnt(" #n ")" ::: "memory")
#define PG_WAIT_L(n) asm volatile("s_waitcnt lgkmcnt(" #n ")" ::: "memory")
#define PG_BAR __builtin_amdgcn_s_barrier()
#define PG_SCHED __builtin_amdgcn_sched_barrier(0)
    Unit cur, nxt; int ui = 0;
    if (!S.next(0, cur)) return;
    f32x4 acc[2][2][4][2];
#pragma unroll
    for (int a = 0; a < 2; ++a)
#pragma unroll
        for (int b = 0; b < 2; ++b)
#pragma unroll
            for (int m = 0; m < 4; ++m)
#pragma unroll
                for (int n = 0; n < 2; ++n) acc[a][b][m][n] = (f32x4){0.f, 0.f, 0.f, 0.f};
    bf16x8 At[4][2], B0[2][2], B1[2][2];
    unsigned voA0[2], voA1[2], vnA0[2], vnA1[2];
#pragma unroll
    for (int i = 0; i < 2; ++i) { voA0[i] = S.aoff(cur, Rr[i], Cc[i]); voA1[i] = S.aoff(cur, HALF + Rr[i], Cc[i]); }
    const char* Ab = (const char*)S.A; const char* cB = S.bbase(cur);
    PG_STAGE(PG_SB(0, 0), cB, voffB); PG_STAGE(PG_SA(0, 0), Ab, voA0); PG_STAGE(PG_SB(0, 1), cB + hstepB, voffB); PG_STAGE(PG_SA(0, 1), Ab, voA1);
    if (wr == 1) PG_BAR;
    PG_WAIT_V(4); PG_BAR;
    PG_STAGE(PG_SB(1, 0), cB + kstep, voffB); PG_STAGE(PG_SA(1, 0), Ab + kstep, voA0); PG_STAGE(PG_SB(1, 1), cB + hstepB + kstep, voffB);
    PG_WAIT_V(6); PG_BAR;
    for (;;) {
        const bool has_next = S.next(ui + 1, nxt);
        const char* nB = has_next ? S.bbase(nxt) : cB;
#pragma unroll
        for (int i = 0; i < 2; ++i) { vnA0[i] = has_next ? S.aoff(nxt, Rr[i], Cc[i]) : voA0[i]; vnA1[i] = has_next ? S.aoff(nxt, HALF + Rr[i], Cc[i]) : voA1[i]; }
        for (int t = 0; t < nt; t += 2) {
            const bool last = (t == nt - 2);
            const char* a1 = Ab + (size_t)(t + 1) * kstep;
            const char* a2 = last ? Ab : Ab + (size_t)(t + 2) * kstep; const char* b2 = last ? nB : cB + (size_t)(t + 2) * kstep;
            const char* a3 = a2 + kstep; const char* b3 = b2 + kstep;
            unsigned o20[2], o21[2];
#pragma unroll
            for (int i = 0; i < 2; ++i) { o20[i] = last ? vnA0[i] : voA0[i]; o21[i] = last ? vnA1[i] : voA1[i]; }
            PG_LDB(B0, 0, 0); PG_SCHED; PG_LDA(At, 0, 0); PG_STAGE(PG_SA(1, 1), a1, voA1);
            PG_WAIT_L(8); PG_BAR; PG_WAIT_L(0); PG_MMA(0, 0, At, B0); PG_BAR; PG_SCHED;
            PG_LDB(B1, 0, 1); PG_STAGE(PG_SB(0, 0), b2, voffB);
            PG_BAR; PG_WAIT_L(0); PG_MMA(0, 1, At, B1); PG_BAR;
            PG_LDA(At, 0, 1); PG_STAGE(PG_SA(0, 0), a2, o20);
            PG_BAR; PG_WAIT_L(0); PG_MMA(1, 0, At, B0); PG_BAR; PG_SCHED;
            PG_STAGE(PG_SB(0, 1), b2 + hstepB, voffB);
            PG_WAIT_V(6); PG_BAR; PG_MMA(1, 1, At, B1); PG_BAR;
            PG_LDB(B0, 1, 0); PG_SCHED; PG_LDA(At, 1, 0); PG_STAGE(PG_SA(0, 1), a2, o21);
            PG_WAIT_L(8); PG_BAR; PG_WAIT_L(0); PG_MMA(0, 0, At, B0); PG_BAR; PG_SCHED;
            PG_LDB(B1, 1, 1); PG_STAGE(PG_SB(1, 0), b3, voffB);
            PG_BAR; PG_WAIT_L(0); PG_MMA(0, 1, At, B1); PG_BAR;
            PG_LDA(At, 1, 1); PG_STAGE(PG_SA(1, 0), a3, o20);
            PG_BAR; PG_WAIT_L(0); PG_MMA(1, 0, At, B0); PG_BAR; PG_SCHED;
            PG_STAGE(PG_SB(1, 1), b3 + hstepB, voffB);
            PG_WAIT_V(6); PG_BAR; PG_MMA(1, 1, At, B1); PG_BAR;
        }
        { const int row0 = cur.pm * BM + wr * 64 + fr, col0 = cur.pn * BM + wc * 32 + 4 * fq;
#pragma unroll
          for (int ai = 0; ai < 2; ++ai)
#pragma unroll
              for (int m = 0; m < 4; ++m)
#pragma unroll
                  for (int bj = 0; bj < 2; ++bj) E(cur, row0 + ai * HALF + m * 16, col0 + bj * HALF, acc[ai][bj][m][0], acc[ai][bj][m][1]); }
        if (!has_next) break;
#pragma unroll
        for (int a = 0; a < 2; ++a)
#pragma unroll
            for (int b = 0; b < 2; ++b)
#pragma unroll
                for (int m = 0; m < 4; ++m)
#pragma unroll
                    for (int n = 0; n < 2; ++n) acc[a][b][m][n] = (f32x4){0.f, 0.f, 0.f, 0.f};
        cur = nxt; cB = nB; ++ui;
#pragma unroll
        for (int i = 0; i < 2; ++i) { voA0[i] = vnA0[i]; voA1[i] = vnA1[i]; }
    }
    PG_WAIT_V(0);
    if (wr == 0) PG_BAR;
    PG_BAR;
#undef PG_SA
#undef PG_SB
#undef PG_STAGE
#undef PG_LDA
#undef PG_LDB
#undef PG_MMA
#undef PG_WAIT_V
#undef PG_WAIT_L
#undef PG_BAR
#undef PG_SCHED
}
}
struct GF32 { EpiF32 e; __device__ __forceinline__ void operator()(const pg::Unit&, int row, int col, f32x4 a, f32x4 b) const { e(row, col, a, b); } };
struct GResid { EpiResid e; __device__ __forceinline__ void operator()(const pg::Unit&, int row, int col, f32x4 a, f32x4 b) const { e(row, col, a, b); } };
struct GSwiglu { bf16* act; const float* bias;
    __device__ __forceinline__ void operator()(const pg::Unit& u, int row, int col, f32x4 a, f32x4 b) const { EpiSwiglu e{act, bias + (size_t)u.e * 2048}; e(row, col, a, b); } };
struct GBiasBf16 { bf16* Y; const float* bias;
    __device__ __forceinline__ void operator()(const pg::Unit& u, int row, int col, f32x4 a, f32x4 b) const { EpiBiasBf16 e{Y, bias + (size_t)u.e * 1024}; e(row, col, a, b); } };
template <class Epi>
__device__ __forceinline__ void ph_gemm(Fr& F, const bf16* A, int lda, const bf16* Bt, int ldb, int M, int N, int K, const Epi& E) {
    pg::DenseSched S; S.init(A, lda, Bt, ldb, M, N, K, F.nblk, F.blk);
    pg::gemm_phase((LAS unsigned char*)F.lds, S, E);
}
template <int STAGE>
__device__ __forceinline__ void ph_moe_gemm(Fr& F, int layer) {
    const Ptrs& P = F.P;
    moe_prefix(F, layer);
    const int* pre = (const int*)(F.lds + LDS_MISC + 64);
    pg::MoeSched<STAGE> S; S.lda = 1024; S.ldb = 1024; S.K = 1024; S.G = F.nblk; S.c = F.blk; S.NN = STAGE == 1 ? 8 : 4; S.nunits = pre[NE] * S.NN;
    S.pre = pre; S.cnt = (const int*)(P.ws + WS_CTL + CW_CNT) + layer * NE; S.toklist = WSP(int, WS_TOK);
    if (STAGE == 1) { S.A = WSP(bf16, WS_F); S.Bt = WSP(bf16, WS_WGU) + (size_t)layer * NE * 2048 * 1024; pg::gemm_phase((LAS unsigned char*)F.lds, S, GSwiglu{WSP(bf16, WS_ACT), P.in[30] + (size_t)layer * NE * 2048}); }
    else { S.A = WSP(bf16, WS_ACT); S.Bt = WSP(bf16, WS_WDN) + (size_t)layer * NE * 1024 * 1024; pg::gemm_phase((LAS unsigned char*)F.lds, S, GBiasBf16{WSP(bf16, WS_Y), P.in[32] + (size_t)layer * NE * 1024}); }
}

__device__ __forceinline__ void ph_e3(Fr& F) {
    const Ptrs& P = F.P; const int lane = F.lane;
    const float* Z = WSP(float, WS_Z); bf16* QKVN = WSP(bf16, WS_QKVN); bf16* KM = WSP(bf16, WS_KM);
    const float* ropeM = WSP(float, WS_ROPEM);
    for (int r = F.gw; r < NT; r += F.ngw) {
        const float* z = Z + (size_t)r * ZLD;
        const f32x4 qa = *(const f32x4*)(z + 1024 + 4 * lane);
        float ss = wave_sum(qa.x * qa.x + qa.y * qa.y + qa.z * qa.z + qa.w * qa.w);
        float rs = rsqrtf(ss * (1.f / 256.f) + 1e-6f);
        const f32x4 gq = *(const f32x4*)(P.in[16] + 4 * lane);
        u32x2 o; o.x = pk2(qa.x * rs * gq.x, qa.y * rs * gq.y); o.y = pk2(qa.z * rs * gq.z, qa.w * rs * gq.w);
        *(u32x2*)(QKVN + (size_t)r * 384 + 4 * lane) = o;
        const float k0 = z[1280 + 2 * lane], k1 = z[1280 + 2 * lane + 1];
        ss = wave_sum(k0 * k0 + k1 * k1); rs = rsqrtf(ss * (1.f / 128.f) + 1e-6f);
        *(unsigned*)(QKVN + (size_t)r * 384 + 256 + 2 * lane) = pk2(k0 * rs * P.in[18][2 * lane], k1 * rs * P.in[18][2 * lane + 1]);
        float kr = lane < 32 ? z[1408 + lane] : 0.f;
        ss = wave_sum(kr * kr); rs = rsqrtf(ss * (1.f / 32.f) + 1e-6f);
        kr = kr * rs * (lane < 32 ? P.in[21][32 + lane] : 0.f);
        int b, s; row_bs(r, b, s);
        const float other = __shfl_xor(kr, 16);
        float outv = kr;
        if (r < NL && lane < 32) { const int i = lane & 15; const float cs = ropeM[((size_t)s * 16 + i) * 2], sn = ropeM[((size_t)s * 16 + i) * 2 + 1];
            outv = lane < 16 ? kr * cs - other * sn : kr * cs + other * sn; }
        if (lane < 32) { const bf16 ov = (bf16)f2bf(outv);
#pragma unroll
            for (int h = 0; h < 8; ++h) KM[(((size_t)b * 8 + h) * TA + s) * 96 + 64 + lane] = ov; }
    }
}
__device__ __forceinline__ void ph_e5(Fr& F) {
    const Ptrs& P = F.P; const int lane = F.lane, sub = lane >> 4, d4 = lane & 15;
    const float* R = WSP(float, WS_QKVR); bf16* QM = WSP(bf16, WS_QM); bf16* KM = WSP(bf16, WS_KM); bf16* VT = WSP(bf16, WS_VM);
    const float* ropeM = WSP(float, WS_ROPEM);
    LAS unsigned char* scr = (LAS unsigned char*)F.lds + F.wave * LRU_WB;
    const f32x4 gqn = *(const f32x4*)(P.in[20] + 4 * d4), gkn = *(const f32x4*)(P.in[20] + 64 + 4 * d4);
    const f32x4 gqr = d4 < 8 ? *(const f32x4*)(P.in[21] + 4 * d4) : (f32x4){0.f, 0.f, 0.f, 0.f};
    for (int g = F.gw; g < NT / 8; g += F.ngw) {
        const int r0 = g * 8; int b, s0; row_bs(r0, b, s0);
#pragma unroll 2
        for (int h = 0; h < 8; ++h) {
#pragma unroll
            for (int pass = 0; pass < 2; ++pass) {
                const int rr = sub + 4 * pass, r = r0 + rr, s = s0 + rr; const float* q = R + (size_t)r * 1792;
                const size_t qo = (((size_t)b * 8 + h) * TA + s) * 96;
                f32x4 x = *(const f32x4*)(q + h * 96 + 4 * d4);
                float rs = rsqrtf(reduce16(dot4(x)) * (1.f / 64.f) + 1e-6f);
                x = x * rs * gqn;
                { u32x2 w; w.x = pk2(x.x, x.y); w.y = pk2(x.z, x.w); *(u32x2*)(QM + qo + 4 * d4) = w; }
                f32x4 y = d4 < 8 ? *(const f32x4*)(q + h * 96 + 64 + 4 * d4) : (f32x4){0.f, 0.f, 0.f, 0.f};
                rs = rsqrtf(reduce16(dot4(y)) * (1.f / 32.f) + 1e-6f);
                y = y * rs * gqr;
                f32x4 yo; yo.x = __shfl_xor(y.x, 4); yo.y = __shfl_xor(y.y, 4); yo.z = __shfl_xor(y.z, 4); yo.w = __shfl_xor(y.w, 4);
                if (r < NL && d4 < 8) { const float* rp = ropeM + ((size_t)s * 16 + 4 * (d4 & 3)) * 2; const f32x4 c0 = *(const f32x4*)rp, c1 = *(const f32x4*)(rp + 4);
                    const f32x4 cs = {c0.x, c0.z, c1.x, c1.z}, sn = {c0.y, c0.w, c1.y, c1.w};
                    y = d4 < 4 ? y * cs - yo * sn : y * cs + yo * sn; }
                if (d4 < 8) { u32x2 w; w.x = pk2(y.x, y.y); w.y = pk2(y.z, y.w); *(u32x2*)(QM + qo + 64 + 4 * d4) = w; }
                f32x4 kx = *(const f32x4*)(q + 768 + h * 128 + 4 * d4);
                rs = rsqrtf(reduce16(dot4(kx)) * (1.f / 64.f) + 1e-6f);
                kx = kx * rs * gkn;
                { u32x2 w; w.x = pk2(kx.x, kx.y); w.y = pk2(kx.z, kx.w); *(u32x2*)(KM + qo + 4 * d4) = w; }
                const f32x4 vx = *(const f32x4*)(q + 768 + h * 128 + 64 + 4 * d4);
                { u32x2 w; w.x = pk2(vx.x, vx.y); w.y = pk2(vx.z, vx.w); *(LAS u32x2*)(scr + rr * 128 + 8 * d4) = w; }
            }
            unsigned short t8[8];
#pragma unroll
            for (int rr = 0; rr < 8; ++rr) t8[rr] = *(const LAS unsigned short*)(scr + rr * 128 + 2 * lane);
            u32x4 w; w.x = t8[0] | ((unsigned)t8[1] << 16); w.y = t8[2] | ((unsigned)t8[3] << 16); w.z = t8[4] | ((unsigned)t8[5] << 16); w.w = t8[6] | ((unsigned)t8[7] << 16);
            *(u32x4*)(VT + (((size_t)b * 8 + h) * 64 + lane) * TA + s0) = w;
        }
    }
}
__device__ __forceinline__ void ph_attn_mla_naive(Fr& F) {
    const Ptrs& P = F.P;
    const bf16* QM = WSP(bf16, WS_QM); const bf16* KM = WSP(bf16, WS_KM); const bf16* VM = WSP(bf16, WS_VM);
    const int half = F.tid >> 8, t256 = F.tid & 255;
    for (int u = F.blk * 2 + half; u < NB * 8 * 17; u += F.nblk * 2) {
        const int bh = u / 17, qb = u % 17, b = bh >> 3, h = bh & 7;
        const int s = qb * 256 + t256;
        float qr[96];
        { const u32x4* q = (const u32x4*)(QM + ((size_t)bh * TA + s) * 96); const float sc = 0.10206207261596577f;
#pragma unroll
          for (int i = 0; i < 12; ++i) { const u32x4 w = q[i]; qr[8 * i] = bflo(w.x) * sc; qr[8 * i + 1] = bfhi(w.x) * sc; qr[8 * i + 2] = bflo(w.y) * sc; qr[8 * i + 3] = bfhi(w.y) * sc;
              qr[8 * i + 4] = bflo(w.z) * sc; qr[8 * i + 5] = bfhi(w.z) * sc; qr[8 * i + 6] = bflo(w.w) * sc; qr[8 * i + 7] = bfhi(w.w) * sc; } }
        const int k0 = qb < 16 ? 0 : SEQ;
        float m = -1e30f, l = 0.f, o[64];
#pragma unroll
        for (int i = 0; i < 64; ++i) o[i] = 0.f;
#pragma unroll 1
        for (int j = k0; j < TA; ++j) {
            const u32x4* kr = (const u32x4*)(KM + ((size_t)bh * TA + j) * 96);
            float sc = 0.f;
#pragma unroll
            for (int i = 0; i < 12; ++i) { const u32x4 w = kr[i];
                sc += qr[8 * i] * bflo(w.x) + qr[8 * i + 1] * bfhi(w.x) + qr[8 * i + 2] * bflo(w.y) + qr[8 * i + 3] * bfhi(w.y) + qr[8 * i + 4] * bflo(w.z) + qr[8 * i + 5] * bfhi(w.z) + qr[8 * i + 6] * bflo(w.w) + qr[8 * i + 7] * bfhi(w.w); }
            const float mn = fmaxf(m, sc), al = __expf(m - mn), p = __expf(sc - mn);
            l = l * al + p; m = mn;
            const u32x4* vr = (const u32x4*)(VM + ((size_t)bh * TA + j) * 64);
#pragma unroll
            for (int i = 0; i < 8; ++i) { const u32x4 w = vr[i];
                o[8 * i] = o[8 * i] * al + p * bflo(w.x); o[8 * i + 1] = o[8 * i + 1] * al + p * bfhi(w.x); o[8 * i + 2] = o[8 * i + 2] * al + p * bflo(w.y); o[8 * i + 3] = o[8 * i + 3] * al + p * bfhi(w.y);
                o[8 * i + 4] = o[8 * i + 4] * al + p * bflo(w.z); o[8 * i + 5] = o[8 * i + 5] * al + p * bfhi(w.z); o[8 * i + 6] = o[8 * i + 6] * al + p * bflo(w.w); o[8 * i + 7] = o[8 * i + 7] * al + p * bfhi(w.w); }
        }
        const int row = s < SEQ ? b * SEQ + s : NL + b * CTX + (s - SEQ);
        bf16* y = WSP(bf16, WS_YM) + (size_t)row * D + 512 + h * 64; const float il = 1.f / l;
#pragma unroll
        for (int i = 0; i < 32; ++i) *(unsigned*)(y + 2 * i) = pk2(o[2 * i] * il, o[2 * i + 1] * il);
    }
}


template <int DQ> struct ACfg { static constexpr int KP = DQ * 2 + 16, KCH = DQ / 8, KBYTES = 64 * KP, VP = 136, VBYTES = 64 * VP, BUF = KBYTES + VBYTES; };
template <int DQ, bool WIN>
__device__ __forceinline__ void attn_unit(LAS unsigned char* lds, const bf16* Qrow, const bf16* Kb, const bf16* Vtb, int a0, int a1, int b0, int b1,
                                          float c, int qpos, int ctile, float sink2, bf16* Orow, int tid, int lane) {
    typedef ACfg<DQ> C;
    const int hh = lane >> 5, ql = lane & 31;
    bf16x8 qf[DQ / 16];
#pragma unroll
    for (int ks = 0; ks < DQ / 16; ++ks) qf[ks] = *(const bf16x8*)(Qrow + 16 * ks + 8 * hh);
    f32x16 o0, o1;
#pragma unroll
    for (int r = 0; r < 16; ++r) { o0[r] = 0.f; o1[r] = 0.f; }
    float m = -1e30f, lsum = 0.f;
    const int n0 = a1 - a0, ntl = n0 + (b1 - b0);
    const int kkey0 = tid / C::KCH, kpc0 = tid % C::KCH, kkey1 = (tid + 512) / C::KCH, kpc1 = (tid + 512) % C::KCH;
    const bool two = (C::KCH == 12) && tid < 256;
    u32x4 kst0, kst1 = (u32x4){0u, 0u, 0u, 0u}, vst;
#define AT_ISSUE(ti) do { const int _t = (ti) < n0 ? a0 + (ti) : b0 + (ti) - n0; const int _k0 = _t * 64; \
        kst0 = *(const u32x4*)(Kb + (size_t)(_k0 + kkey0) * DQ + kpc0 * 8); if (two) kst1 = *(const u32x4*)(Kb + (size_t)(_k0 + kkey1) * DQ + kpc1 * 8); \
        vst = *(const u32x4*)(Vtb + (size_t)(tid >> 3) * TA + _k0 + (tid & 7) * 8); } while (0)
#define AT_COMMIT(buf) do { LAS unsigned char* _b = lds + (buf) * C::BUF; \
        *(LAS u32x4*)(_b + kkey0 * C::KP + kpc0 * 16) = kst0; if (two) *(LAS u32x4*)(_b + kkey1 * C::KP + kpc1 * 16) = kst1; \
        LAS unsigned char* _v = _b + C::KBYTES + (tid >> 3) * C::VP + (tid & 7) * 16; *(LAS u32x2*)_v = (u32x2){vst.x, vst.y}; *(LAS u32x2*)(_v + 8) = (u32x2){vst.z, vst.w}; } while (0)
    AT_ISSUE(0); AT_COMMIT(0);
    __syncthreads();
    for (int ti = 0; ti < ntl; ++ti) {
        const int buf = ti & 1;
        if (ti + 1 < ntl) AT_ISSUE(ti + 1);
        const LAS unsigned char* kb_ = lds + buf * C::BUF; const LAS unsigned char* vb_ = kb_ + C::KBYTES;
        f32x16 s0, s1;
#pragma unroll
        for (int r = 0; r < 16; ++r) { s0[r] = 0.f; s1[r] = 0.f; }
#pragma unroll
        for (int ks = 0; ks < DQ / 16; ++ks) {
            const bf16x8 k0 = *(const LAS bf16x8*)(kb_ + ql * C::KP + (16 * ks + 8 * hh) * 2);
            const bf16x8 k1 = *(const LAS bf16x8*)(kb_ + (32 + ql) * C::KP + (16 * ks + 8 * hh) * 2);
            s0 = __builtin_amdgcn_mfma_f32_32x32x16_bf16(k0, qf[ks], s0, 0, 0, 0);
            s1 = __builtin_amdgcn_mfma_f32_32x32x16_bf16(k1, qf[ks], s1, 0, 0, 0);
        }
        const int tile = ti < n0 ? a0 + ti : b0 + ti - n0;
        const bool masked = WIN && ti < n0 && (tile - ctile >= 2 || ctile - tile >= 2);
#pragma unroll
        for (int r = 0; r < 16; ++r) { s0[r] *= c; s1[r] *= c; }
        if (masked) {
#pragma unroll
            for (int r = 0; r < 16; ++r) { const int key = tile * 64 + (r & 3) + 8 * (r >> 2) + 4 * hh; const int d0 = qpos - key, d1 = qpos - key - 32;
                if (d0 > 128 || d0 < -128) s0[r] = -1e30f; if (d1 > 128 || d1 < -128) s1[r] = -1e30f; }
        }
        float mx = s0[0];
#pragma unroll
        for (int r = 1; r < 16; ++r) mx = fmaxf(mx, s0[r]);
#pragma unroll
        for (int r = 0; r < 16; ++r) mx = fmaxf(mx, s1[r]);
        mx = fmaxf(mx, __shfl_xor(mx, 32));
        const float mn = fmaxf(m, mx), alpha = __builtin_amdgcn_exp2f(m - mn); m = mn;
        float ps = 0.f;
#pragma unroll
        for (int r = 0; r < 16; ++r) { s0[r] = __builtin_amdgcn_exp2f(s0[r] - mn); s1[r] = __builtin_amdgcn_exp2f(s1[r] - mn); ps += s0[r] + s1[r]; }
        lsum = lsum * alpha + ps;
#pragma unroll
        for (int r = 0; r < 16; ++r) { o0[r] *= alpha; o1[r] *= alpha; }
        bf16x8 pf[4];
#pragma unroll
        for (int s4 = 0; s4 < 4; ++s4) { u32x4 w;
            if (s4 < 2) { w.x = pk2(s0[8 * s4], s0[8 * s4 + 1]); w.y = pk2(s0[8 * s4 + 2], s0[8 * s4 + 3]); w.z = pk2(s0[8 * s4 + 4], s0[8 * s4 + 5]); w.w = pk2(s0[8 * s4 + 6], s0[8 * s4 + 7]); }
            else { const int q = s4 - 2; w.x = pk2(s1[8 * q], s1[8 * q + 1]); w.y = pk2(s1[8 * q + 2], s1[8 * q + 3]); w.z = pk2(s1[8 * q + 4], s1[8 * q + 5]); w.w = pk2(s1[8 * q + 6], s1[8 * q + 7]); }
            pf[s4] = __builtin_bit_cast(bf16x8, w); }
#pragma unroll
        for (int s4 = 0; s4 < 4; ++s4) {
            const LAS unsigned char* v0 = vb_ + ql * C::VP + (16 * s4 + 4 * hh) * 2; const LAS unsigned char* v1 = v0 + 32 * C::VP;
            const u32x2 a0_ = *(const LAS u32x2*)v0, a1_ = *(const LAS u32x2*)(v0 + 16), c0_ = *(const LAS u32x2*)v1, c1_ = *(const LAS u32x2*)(v1 + 16);
            const bf16x8 va = __builtin_bit_cast(bf16x8, (u32x4){a0_.x, a0_.y, a1_.x, a1_.y}), vc = __builtin_bit_cast(bf16x8, (u32x4){c0_.x, c0_.y, c1_.x, c1_.y});
            o0 = __builtin_amdgcn_mfma_f32_32x32x16_bf16(va, pf[s4], o0, 0, 0, 0);
            o1 = __builtin_amdgcn_mfma_f32_32x32x16_bf16(vc, pf[s4], o1, 0, 0, 0);
        }
        if (ti + 1 < ntl) AT_COMMIT(buf ^ 1);
        __syncthreads();
    }
#undef AT_ISSUE
#undef AT_COMMIT
    float ltot = lsum + __shfl_xor(lsum, 32);
    float fin = 1.f;
    if (WIN) { const float mn = fmaxf(m, sink2); fin = __builtin_amdgcn_exp2f(m - mn); ltot = ltot * fin + __builtin_amdgcn_exp2f(sink2 - mn); }
    const float inv = fin / ltot;
#pragma unroll
    for (int rq = 0; rq < 4; ++rq) {
        u32x2 w; w.x = pk2(o0[4 * rq] * inv, o0[4 * rq + 1] * inv); w.y = pk2(o0[4 * rq + 2] * inv, o0[4 * rq + 3] * inv); *(u32x2*)(Orow + 8 * rq + 4 * hh) = w;
        w.x = pk2(o1[4 * rq] * inv, o1[4 * rq + 1] * inv); w.y = pk2(o1[4 * rq + 2] * inv, o1[4 * rq + 3] * inv); *(u32x2*)(Orow + 32 + 8 * rq + 4 * hh) = w;
    }
}
__device__ __forceinline__ void ph_attn_mla(Fr& F) {
    const Ptrs& P = F.P;
    const bf16* QM = WSP(bf16, WS_QM); const bf16* KM = WSP(bf16, WS_KM); const bf16* VT = WSP(bf16, WS_VM);
    const int x = F.blk & 7, j = F.blk >> 3;
    const float c = 0.10206207261596577f * 1.4426950408889634f;
    for (int rd = 0; ; ++rd) {
        int bh, qb;
        if (F.nblk == 256) { if (rd < 2) { bh = rd * 16 + 2 * x + (j >> 4); qb = j & 15; } else if (rd == 2 && F.blk < 32) { bh = F.blk; qb = 16; } else break; }
        else { const int u = rd * F.nblk + F.blk; if (u >= 544) break; if (u < 512) { bh = u >> 4; qb = u & 15; } else { bh = u - 512; qb = 16; } }
        const int b = bh >> 3, h = bh & 7;
        const int s = qb * 256 + F.wave * 32 + (F.lane & 31);
        const int row = s < SEQ ? b * SEQ + s : NL + b * CTX + (s - SEQ);
        attn_unit<96, false>((LAS unsigned char*)F.lds, QM + ((size_t)bh * TA + s) * 96, KM + (size_t)bh * TA * 96, VT + (size_t)bh * 64 * TA,
                             qb < 16 ? 0 : 64, 68, 0, 0, c, 0, 0, 0.f, WSP(bf16, WS_YM) + (size_t)row * D + 512 + h * 64, F.tid, F.lane);
    }
}

__device__ __forceinline__ void ph_lru_xf(Fr& F) {
    const Ptrs& P = F.P; const float* Z = WSP(float, WS_Z);
    for (size_t gid = F.gtid; gid < (size_t)2 * NT * 512; gid += F.gsz) {
        const int ch = (int)(gid & 511); const int row = (int)((gid >> 9) % NT); const int dir = (int)(gid / ((size_t)NT * 512));
        int t, T, base; if (row < NL) { t = row & 4095; T = SEQ; base = row - t; } else { t = (row - NL) & 255; T = CTX; base = row - t; }
        const float* cw = P.in[9] + (size_t)dir * 4 * 512 + ch;
        float acc = P.in[10][dir * 512 + ch];
#pragma unroll
        for (int j = 0; j < 4; ++j) { const int tt = dir == 0 ? t - 3 + j : t + 3 - j; if (tt >= 0 && tt < T) acc += cw[j * 512] * Z[(size_t)(base + tt) * ZLD + ch]; }
        WSP(float, WS_XF)[gid] = acc;
    }
}
__device__ __forceinline__ void ph_lru_ab(Fr& F) {
    const Ptrs& P = F.P;
    for (size_t gid = F.gtid; gid < (size_t)2 * NT * 512; gid += F.gsz) {
        const int ch = (int)(gid & 511); const int dir = (int)(gid / ((size_t)NT * 512));
        const int blk = ch >> 6, d = ch & 63;
        const float* xf = WSP(float, WS_XF) + (gid - ch) + blk * 64;
        const float* wr = P.in[11] + ((size_t)dir * 8 + blk) * 64 * 64 + d; const float* wi = P.in[13] + ((size_t)dir * 8 + blk) * 64 * 64 + d;
        float ar = P.in[12][dir * 512 + ch], ai = P.in[14][dir * 512 + ch];
#pragma unroll 8
        for (int c = 0; c < 64; ++c) { const float x = xf[c]; ar += x * wr[c * 64]; ai += x * wi[c * 64]; }
        const float r = sigmoidf_(ar), gi = sigmoidf_(ai);
        const float lam = P.in[15][dir * 512 + ch];
        const float sp = log1pf(__expf(-lam));
        const float log_a = -8.f * r * sp; const float a = __expf(log_a);
        const float bb = sqrtf(-expm1f(2.f * log_a)) * (gi * xf[d]);
        WSP(float, WS_LA)[gid] = a; WSP(float, WS_LB)[gid] = bb;
    }
}
__device__ __forceinline__ void ph_lru_scan(Fr& F) {
    const Ptrs& P = F.P;
    if (F.gtid >= NB * 2 * 512) return;
    const int gid = (int)F.gtid; const int ch = gid & 511, dir = (gid >> 9) & 1, b = gid >> 10;
    const float* LA = WSP(float, WS_LA) + (size_t)dir * NT * 512 + ch; const float* LB = WSP(float, WS_LB) + (size_t)dir * NT * 512 + ch;
    float* LH = WSP(float, WS_LH) + (size_t)dir * NT * 512 + ch;
    float h = 0.f;
#pragma unroll 4
    for (int i = 0; i < CTX; ++i) { const int t = dir == 0 ? i : CTX - 1 - i; const size_t row = NL + b * CTX + t; h = LA[row * 512] * h + LB[row * 512]; LH[row * 512] = h; }
#pragma unroll 4
    for (int i = 0; i < SEQ; ++i) { const int t = dir == 0 ? i : SEQ - 1 - i; const size_t row = (size_t)b * SEQ + t; h = LA[row * 512] * h + LB[row * 512]; LH[row * 512] = h; }
}
__device__ __forceinline__ void ph_lru_out(Fr& F) {
    const Ptrs& P = F.P; const float* LH = WSP(float, WS_LH);
    for (size_t gid = F.gtid; gid < (size_t)NT * 512; gid += F.gsz) {
        const int ch = (int)(gid & 511); const size_t row = gid >> 9;
        const float h = LH[gid] + LH[(size_t)NT * 512 + gid];
        WSP(bf16, WS_YM)[row * D + ch] = (bf16)f2bf(h * gelu_tanh(WSP(float, WS_Z)[row * ZLD + 512 + ch]));
    }
}


__device__ __forceinline__ float gelu_fast(float x) { const float u = 1.5957691216057308f * (x + 0.044715f * x * x * x); return x / (1.f + __expf(-u)); }
template <int PASS>
__device__ __forceinline__ void ph_lru(Fr& F) {
    const Ptrs& P = F.P; const int lane = F.lane, w = F.wave, ch = w * 64 + lane, fr = lane & 15, fq = lane >> 4;
    LAS unsigned char* At = (LAS unsigned char*)F.lds + w * LRU_WB; LAS unsigned char* Gt = At + LRU_AT; LAS unsigned char* Ht = Gt + LRU_GT;
    const float* Z = WSP(float, WS_Z); const bf16* WRI = WSP(bf16, WS_WRI);
    float* AGG = WSP(float, WS_LA);
    for (int unit = F.blk; unit < NB * 68; unit += F.nblk) {
        const int b = unit / 68, k = unit % 68;
        const bool isctx = k < 4; const int T = isctx ? CTX : SEQ, t0 = isctx ? 64 * k : 64 * (k - 4), segrow0 = isctx ? NL + b * CTX : b * SEQ;
#pragma unroll 1
        for (int dir = 0; dir < 2; ++dir) {
            const int kd = dir == 0 ? k : (isctx ? 3 - k : 71 - k);
            const float cw0 = P.in[9][(dir * 4 + 0) * 512 + ch], cw1 = P.in[9][(dir * 4 + 1) * 512 + ch], cw2 = P.in[9][(dir * 4 + 2) * 512 + ch], cw3 = P.in[9][(dir * 4 + 3) * 512 + ch];
            const float cb = P.in[10][dir * 512 + ch], br = P.in[12][dir * 512 + ch], bi = P.in[14][dir * 512 + ch];
            const float sp8 = -8.f * log1pf(__expf(-P.in[15][dir * 512 + ch]));
            bf16x8 wf[2][2][4];
#pragma unroll
            for (int gate = 0; gate < 2; ++gate)
#pragma unroll
                for (int ks = 0; ks < 2; ++ks)
#pragma unroll
                    for (int n = 0; n < 4; ++n) wf[gate][ks][n] = *(const bf16x8*)(WRI + ((size_t)(dir * 8 + w) * 128 + gate * 64 + 16 * n + fr) * 64 + 32 * ks + 8 * fq);
            float uw[LRU_ST + 3], un[LRU_ST + 3], gv[LRU_ST], gn[LRU_ST];
#define LRU_LOAD(dstu, dstg, st_) do { const int _sub = dir == 0 ? (st_) : LRU_NST - 1 - (st_); const int _ts = t0 + LRU_ST * _sub; \
                _Pragma("unroll") for (int q = 0; q < LRU_ST + 3; ++q) { const int t = dir == 0 ? _ts - 3 + q : _ts + LRU_ST + 2 - q; const bool ok = t >= 0 && t < T; \
                    dstu[q] = ok ? Z[(size_t)(segrow0 + (ok ? t : 0)) * ZLD + ch] : 0.f; } \
                if (PASS == 1 && dir == 1) { _Pragma("unroll") for (int i = 0; i < LRU_ST; ++i) dstg[i] = Z[(size_t)(segrow0 + _ts + LRU_ST - 1 - i) * ZLD + 512 + ch]; } } while (0)
            LRU_LOAD(uw, gv, 0);
            float h = 0.f, pa = 1.f;
            if (PASS == 1) { const float* ag = AGG + ((size_t)(b * 2 + dir) * 68) * 1024 + ch * 2;
#pragma unroll 16
                for (int kk = 0; kk < kd; ++kk) { const f32x2_t ab = *(const f32x2_t*)(ag + (size_t)kk * 1024); h = ab.x * h + ab.y; } }
#pragma unroll 1
            for (int st = 0; st < LRU_NST; ++st) {
                const int sub = dir == 0 ? st : LRU_NST - 1 - st;
                if (st + 1 < LRU_NST) LRU_LOAD(un, gn, st + 1);
                float xf[LRU_ST], rg[LRU_ST];
#pragma unroll
                for (int i = 0; i < LRU_ST; ++i) xf[i] = cb + cw0 * uw[i] + cw1 * uw[i + 1] + cw2 * uw[i + 2] + cw3 * uw[i + 3];
#pragma unroll
                for (int i = 0; i < LRU_ST; ++i) *(LAS bf16*)(At + i * 144 + lane * 2) = (bf16)f2bf(xf[i]);
#pragma unroll
                for (int gate = 0; gate < 2; ++gate) {
                    f32x4 acc[4];
#pragma unroll
                    for (int n = 0; n < 4; ++n) acc[n] = (f32x4){0.f, 0.f, 0.f, 0.f};
#pragma unroll
                    for (int ks = 0; ks < 2; ++ks) {
                        const bf16x8 af0 = *(const LAS bf16x8*)(At + fr * 144 + (32 * ks + 8 * fq) * 2);
#pragma unroll
                        for (int n = 0; n < 4; ++n) acc[n] = __builtin_amdgcn_mfma_f32_16x16x32_bf16(wf[gate][ks][n], af0, acc[n], 0, 0, 0);
                    }
#pragma unroll
                    for (int n = 0; n < 4; ++n) *(LAS f32x4*)(Gt + fr * 272 + (16 * n + 4 * fq) * 4) = acc[n];
#pragma unroll
                    for (int i = 0; i < LRU_ST; ++i) { const float pre = *(const LAS float*)(Gt + i * 272 + lane * 4);
                        if (gate == 0) rg[i] = sigmoidf_(pre + br);
                        else { const float gi = sigmoidf_(pre + bi); const float a = __expf(sp8 * rg[i]); rg[i] = a; xf[i] = sqrtf(fmaxf(1.f - a * a, 0.f)) * (gi * xf[i]); } }
                }
#pragma unroll
                for (int i = 0; i < LRU_ST; ++i) { const int tl = dir == 0 ? LRU_ST * sub + i : LRU_ST * sub + LRU_ST - 1 - i;
                    h = rg[i] * h + xf[i]; if (PASS == 0) pa *= rg[i];
                    if (PASS == 1) {
                        if (dir == 0) *(LAS bf16*)(Ht + tl * 128 + lane * 2) = (bf16)f2bf(h);
                        else { const float hf = bf2f(*(const LAS bf16*)(Ht + tl * 128 + lane * 2)); const size_t row = (size_t)(segrow0 + t0 + tl);
                            WSP(bf16, WS_YM)[row * D + ch] = (bf16)f2bf((hf + h) * gelu_fast(gv[i])); } } }
#pragma unroll
                for (int q = 0; q < LRU_ST + 3; ++q) uw[q] = un[q];
                if (PASS == 1) {
#pragma unroll
                    for (int i = 0; i < LRU_ST; ++i) gv[i] = gn[i]; }
            }
#undef LRU_LOAD
            if (PASS == 0) { f32x2_t o; o.x = pa; o.y = h; *(f32x2_t*)(AGG + ((size_t)(b * 2 + dir) * 68 + kd) * 1024 + ch * 2) = o; }
        }
    }
}

__device__ __forceinline__ void ph_oprep(Fr& F) {
    const Ptrs& P = F.P; const int lane = F.lane, sub = lane >> 4, d4 = lane & 15;
    const float* Z = WSP(float, WS_Z); bf16* QG = WSP(bf16, WS_QG); bf16* KG = WSP(bf16, WS_KG); bf16* VGT = WSP(bf16, WS_VG);
    const float* ropeG = WSP(float, WS_ROPEG);
    LAS unsigned char* scr = (LAS unsigned char*)F.lds + F.wave * 4096;
    const f32x4 gq = *(const f32x4*)(P.in[24] + 4 * d4), gk = *(const f32x4*)(P.in[24] + 64 + 4 * d4);
    for (int g = F.gw; g < NT / 8; g += F.ngw) {
        const int r0 = g * 8; int b, s0; row_bs(r0, b, s0);
        const bool lat = r0 < NL;
#pragma unroll 2
        for (int rr = 0; rr < 8; ++rr) {
            const int s = s0 + rr; const float* z = Z + (size_t)(r0 + rr) * ZLD;
            f32x4 cs = {1.f, 1.f, 1.f, 1.f}, sn = {0.f, 0.f, 0.f, 0.f};
            if (lat) { const float* rp = ropeG + ((size_t)s * 32 + 4 * (d4 & 7)) * 2; const f32x4 c0 = *(const f32x4*)rp, c1 = *(const f32x4*)(rp + 4);
                cs = (f32x4){c0.x, c0.z, c1.x, c1.z}; sn = (f32x4){c0.y, c0.w, c1.y, c1.w}; }
            if (d4 >= 8) sn = -sn;
            if (lat) {
#pragma unroll
                for (int pass = 0; pass < 4; ++pass) { const int hd = 4 * pass + sub;
                    f32x4 x = *(const f32x4*)(z + hd * 64 + 4 * d4);
                    const float rs = rsqrtf(reduce16(dot4(x)) * (1.f / 64.f) + 1e-6f);
                    x = x * rs * gq;
                    f32x4 xo; xo.x = dppf<0x128>(x.x); xo.y = dppf<0x128>(x.y); xo.z = dppf<0x128>(x.z); xo.w = dppf<0x128>(x.w);
                    x = x * cs - xo * sn;
                    u32x2 w; w.x = pk2(x.x, x.y); w.y = pk2(x.z, x.w); *(u32x2*)(QG + (((size_t)b * 16 + hd) * SEQ + s) * 64 + 4 * d4) = w; } }
            { f32x4 x = *(const f32x4*)(z + 1024 + sub * 64 + 4 * d4);
              const float rs = rsqrtf(reduce16(dot4(x)) * (1.f / 64.f) + 1e-6f);
              x = x * rs * gk;
              f32x4 xo; xo.x = dppf<0x128>(x.x); xo.y = dppf<0x128>(x.y); xo.z = dppf<0x128>(x.z); xo.w = dppf<0x128>(x.w);
              x = x * cs - xo * sn;
              u32x2 w; w.x = pk2(x.x, x.y); w.y = pk2(x.z, x.w); *(u32x2*)(KG + (((size_t)b * 4 + sub) * TA + s) * 64 + 4 * d4) = w;
              const f32x4 vx = *(const f32x4*)(z + 1280 + sub * 64 + 4 * d4);
              w.x = pk2(vx.x, vx.y); w.y = pk2(vx.z, vx.w); *(LAS u32x2*)(scr + (sub * 8 + rr) * 128 + 8 * d4) = w; }
        }
#pragma unroll
        for (int hh = 0; hh < 4; ++hh) {
            unsigned short t8[8];
#pragma unroll
            for (int rr = 0; rr < 8; ++rr) t8[rr] = *(const LAS unsigned short*)(scr + (hh * 8 + rr) * 128 + 2 * lane);
            u32x4 w; w.x = t8[0] | ((unsigned)t8[1] << 16); w.y = t8[2] | ((unsigned)t8[3] << 16); w.z = t8[4] | ((unsigned)t8[5] << 16); w.w = t8[6] | ((unsigned)t8[7] << 16);
            *(u32x4*)(VGT + (((size_t)b * 4 + hh) * 64 + lane) * TA + s0) = w;
        }
    }
}
__device__ __forceinline__ void ph_attn_gqa(Fr& F) {
    const Ptrs& P = F.P;
    const int x = F.blk & 7, j = F.blk >> 3;
    const float c = 0.125f * 1.4426950408889634f;
    for (int rd = 0; ; ++rd) {
        int pair, qblk;
        if (F.nblk == 256) { if (rd >= 4) break; pair = rd * 4 + (x >> 1); qblk = 32 * (x & 1) + j; }
        else { const int u = rd * F.nblk + F.blk; if (u >= 1024) break; pair = u >> 6; qblk = u & 63; }
        const int b = pair >> 2, kh = pair & 3, head = kh * 4 + (F.wave >> 1);
        const int qpos = qblk * 64 + 32 * (F.wave & 1) + (F.lane & 31);
        const int a0 = qblk - 2 < 0 ? 0 : qblk - 2, a1 = qblk + 3 > 64 ? 64 : qblk + 3;
        attn_unit<64, true>((LAS unsigned char*)F.lds, WSP(bf16, WS_QG) + (((size_t)b * 16 + head) * SEQ + qpos) * 64, WSP(bf16, WS_KG) + ((size_t)b * 4 + kh) * TA * 64,
                            WSP(bf16, WS_VG) + ((size_t)b * 4 + kh) * 64 * TA, a0, a1, 64, 68, c, qpos, qblk, P.in[25][head] * 1.4426950408889634f,
                            WSP(bf16, WS_YM) + ((size_t)b * SEQ + qpos) * D + head * 64, F.tid, F.lane);
    }
}
__device__ __forceinline__ void ph_attn_gqa_naive(Fr& F) {
    const Ptrs& P = F.P;
    const int half = F.tid >> 8, t256 = F.tid & 255;
    for (int u = F.blk * 2 + half; u < NB * 16 * 16; u += F.nblk * 2) {
        const int bh = u >> 4, qb = u & 15, b = bh >> 4, h = bh & 15, kh = h >> 2;
        const int t = qb * 256 + t256;
        const bf16* QG = WSP(bf16, WS_QG); const bf16* KG = WSP(bf16, WS_KG) + ((size_t)b * 4 + kh) * TA * 64; const bf16* VG = WSP(bf16, WS_VG) + ((size_t)b * 4 + kh) * TA * 64;
        float qr[64];
        { const u32x4* q = (const u32x4*)(QG + ((size_t)bh * SEQ + t) * 64);
#pragma unroll
          for (int i = 0; i < 8; ++i) { const u32x4 w = q[i]; qr[8 * i] = bflo(w.x) * 0.125f; qr[8 * i + 1] = bfhi(w.x) * 0.125f; qr[8 * i + 2] = bflo(w.y) * 0.125f; qr[8 * i + 3] = bfhi(w.y) * 0.125f;
              qr[8 * i + 4] = bflo(w.z) * 0.125f; qr[8 * i + 5] = bfhi(w.z) * 0.125f; qr[8 * i + 6] = bflo(w.w) * 0.125f; qr[8 * i + 7] = bfhi(w.w) * 0.125f; } }
        float m = -1e30f, l = 0.f, o[64];
#pragma unroll
        for (int i = 0; i < 64; ++i) o[i] = 0.f;
#pragma unroll 1
        for (int jj = 0; jj < 257 + CTX; ++jj) {
            int j; bool valid = true;
            if (jj < 257) { j = t - 128 + jj; valid = (j >= 0 && j < SEQ); if (!valid) j = 0; } else j = SEQ + (jj - 257);
            const u32x4* kr = (const u32x4*)(KG + (size_t)j * 64);
            float sc = 0.f;
#pragma unroll
            for (int i = 0; i < 8; ++i) { const u32x4 w = kr[i];
                sc += qr[8 * i] * bflo(w.x) + qr[8 * i + 1] * bfhi(w.x) + qr[8 * i + 2] * bflo(w.y) + qr[8 * i + 3] * bfhi(w.y) + qr[8 * i + 4] * bflo(w.z) + qr[8 * i + 5] * bfhi(w.z) + qr[8 * i + 6] * bflo(w.w) + qr[8 * i + 7] * bfhi(w.w); }
            if (!valid) sc = -1e30f;
            const float mn = fmaxf(m, sc), al = __expf(m - mn), p = valid ? __expf(sc - mn) : 0.f;
            l = l * al + p; m = mn;
            const u32x4* vr = (const u32x4*)(VG + (size_t)j * 64);
#pragma unroll
            for (int i = 0; i < 8; ++i) { const u32x4 w = vr[i];
                o[8 * i] = o[8 * i] * al + p * bflo(w.x); o[8 * i + 1] = o[8 * i + 1] * al + p * bfhi(w.x); o[8 * i + 2] = o[8 * i + 2] * al + p * bflo(w.y); o[8 * i + 3] = o[8 * i + 3] * al + p * bfhi(w.y);
                o[8 * i + 4] = o[8 * i + 4] * al + p * bflo(w.z); o[8 * i + 5] = o[8 * i + 5] * al + p * bfhi(w.z); o[8 * i + 6] = o[8 * i + 6] * al + p * bflo(w.w); o[8 * i + 7] = o[8 * i + 7] * al + p * bfhi(w.w); }
        }
        { const float sk = P.in[25][h]; const float mn = fmaxf(m, sk), al = __expf(m - mn); l = l * al + __expf(sk - mn);
          const float il = al / l;
          bf16* y = WSP(bf16, WS_YM) + ((size_t)b * SEQ + t) * D + h * 64;
#pragma unroll
          for (int i = 0; i < 32; ++i) *(unsigned*)(y + 2 * i) = pk2(o[2 * i] * il, o[2 * i + 1] * il); }
    }
}

__device__ __forceinline__ void ph_router(Fr& F, int layer, int nrows) {
    const Ptrs& P = F.P; const int lane = F.lane;
    const float* MOD = WSP(float, WS_MOD); const float* X1 = WSP(float, WS_X1);
    { const f32x4* src = (const f32x4*)(WSP(float, WS_WRT) + (size_t)layer * 32 * 1024); LAS f32x4* dst = (LAS f32x4*)F.lds;
#pragma unroll 4
      for (int i = 0; i < 16; ++i) dst[F.tid + NTHR * i] = src[F.tid + NTHR * i];
      __syncthreads(); }
    const LAS float* wl = (const LAS float*)F.lds;
    int* cnt = (int*)(P.ws + WS_CTL + CW_CNT) + layer * NE;
    const int e8 = ((lane >> 5) & 1) * 4 + ((lane >> 4) & 1) * 2 + ((lane >> 3) & 1);
    for (int r0 = F.gw * 2; r0 < nrows; r0 += F.ngw * 2) {
        RowV v[2];
#pragma unroll
        for (int rr = 0; rr < 2; ++rr) { v[rr] = load_row(X1 + (size_t)(r0 + rr) * D, lane);
            const float* m = MOD + (size_t)(layer * 5 + mod_row(r0 + rr)) * 6144;
            norm_mod(v[rr], P.in[7] + layer * D, m + 4 * 1024, m + 3 * 1024, lane);
            store_row_bf16(WSP(bf16, WS_F) + (size_t)(r0 + rr) * D, v[rr], lane); }
        float lg[2][4];
        int zoff = 0; asm volatile("" : "+v"(zoff));
#pragma unroll
        for (int grp = 0; grp < 4; ++grp) {
            float acc[2][8];
#pragma unroll
            for (int e = 0; e < 8; ++e) { const LAS f32x4* w = (const LAS f32x4*)(wl + (grp * 8 + e) * 1024) + lane + zoff;
                const f32x4 w0 = w[0], w1 = w[64], w2 = w[128], w3 = w[192];
#pragma unroll
                for (int rr = 0; rr < 2; ++rr) { const f32x4 p = v[rr].v[0] * w0 + v[rr].v[1] * w1 + v[rr].v[2] * w2 + v[rr].v[3] * w3; acc[rr][e] = (p.x + p.y) + (p.z + p.w); }
                if (e & 1) asm volatile("" : "+v"(zoff) : "v"(acc[1][e])); }
            const float bias = P.in[28][layer * NE + grp * 8 + e8];
#pragma unroll
            for (int rr = 0; rr < 2; ++rr) {
                float (&a)[8] = acc[rr];
#pragma unroll
                for (int i = 0; i < 4; ++i) { const bool hi = lane & 32; const float send = hi ? a[i] : a[i + 4], keep = hi ? a[i + 4] : a[i]; a[i] = keep + __shfl_xor(send, 32); }
#pragma unroll
                for (int i = 0; i < 2; ++i) { const bool hi = lane & 16; const float send = hi ? a[i] : a[i + 2], keep = hi ? a[i + 2] : a[i]; a[i] = keep + __shfl_xor(send, 16); }
                { const bool hi = lane & 8; const float send = hi ? a[0] : a[1], keep = hi ? a[1] : a[0]; a[0] = keep + dppf<0x128>(send); }
                float t = a[0]; t += dppf<0xB1>(t); t += dppf<0x4E>(t); t += dppf<0x141>(t);
                lg[rr][grp] = t + bias;
            }
        }
#pragma unroll
        for (int rr = 0; rr < 2; ++rr) {
            float c[4] = {lg[rr][0], lg[rr][1], lg[rr][2], lg[rr][3]};
            int te[4]; float tv[4];
#pragma unroll
            for (int k = 0; k < 4; ++k) {
                float bv = c[0]; int bi = e8;
#pragma unroll
                for (int g = 1; g < 4; ++g) { const bool take = c[g] > bv; bv = take ? c[g] : bv; bi = take ? 8 * g + e8 : bi; }
#pragma unroll
                for (int o = 8; o < 64; o <<= 1) { const float ov = __shfl_xor(bv, o); const int oi = __shfl_xor(bi, o); const bool take = ov > bv || (ov == bv && oi < bi); bv = take ? ov : bv; bi = take ? oi : bi; }
                te[k] = bi; tv[k] = bv;
#pragma unroll
                for (int g = 0; g < 4; ++g) c[g] = (bi == 8 * g + e8) ? -3.4e38f : c[g]; }
            const float e1 = __expf(tv[1] - tv[0]), e2 = __expf(tv[2] - tv[0]), e3 = __expf(tv[3] - tv[0]); const float inv = 1.f / (1.f + e1 + e2 + e3);
            const int r = r0 + rr;
            if (lane < 4) { const int e = lane == 0 ? te[0] : lane == 1 ? te[1] : lane == 2 ? te[2] : te[3]; const float g = (lane == 0 ? 1.f : lane == 1 ? e1 : lane == 2 ? e2 : e3) * inv;
                const int slot = atomicAdd(&cnt[e], 1);
                WSP(int, WS_TOK)[(size_t)e * NT + slot] = r;
                WSP(int, WS_PE)[r * 4 + lane] = e; WSP(int, WS_PS)[r * 4 + lane] = slot; WSP(float, WS_PG)[r * 4 + lane] = g; }
        }
    }
}
template <int MODE>
__device__ __forceinline__ void ph_combine(Fr& F, int layer, int nrows) {
    const Ptrs& P = F.P; const int lane = F.lane;
    moe_prefix(F, layer);
    const int* pre = (const int*)(F.lds + LDS_MISC + 64);
    const float* MOD = WSP(float, WS_MOD); const float* X1 = WSP(float, WS_X1); const bf16* Y = WSP(bf16, WS_Y);
    for (int r = F.gw; r < nrows; r += F.ngw) {
        RowV v = load_row(X1 + (size_t)r * D, lane);
        const float* g2 = MOD + (size_t)(layer * 5 + mod_row(r)) * 6144 + 5 * 1024;
        RowV acc;
#pragma unroll
        for (int j = 0; j < 4; ++j) acc.v[j] = (f32x4){0.f, 0.f, 0.f, 0.f};
#pragma unroll
        for (int k = 0; k < 4; ++k) { const int e = WSP(int, WS_PE)[r * 4 + k], slot = WSP(int, WS_PS)[r * 4 + k]; const float g = WSP(float, WS_PG)[r * 4 + k];
            const u32x2* y = (const u32x2*)(Y + ((size_t)pre[e] * 256 + slot) * D) + lane;
#pragma unroll
            for (int j = 0; j < 4; ++j) { const u32x2 w = y[64 * j]; acc.v[j] += (f32x4){bflo(w.x), bfhi(w.x), bflo(w.y), bfhi(w.y)} * g; } }
#pragma unroll
        for (int j = 0; j < 4; ++j) v.v[j] += ((const f32x4*)g2)[lane + 64 * j] * acc.v[j];
        if (MODE == 0) {
            f32x4* xo = (f32x4*)(WSP(float, WS_X2) + (size_t)r * D) + lane;
#pragma unroll
            for (int j = 0; j < 4; ++j) xo[64 * j] = v.v[j];
            const float* m = MOD + (size_t)(1 * 5 + mod_row(r)) * 6144;
            norm_mod(v, P.in[6] + D, m + 1024, m, lane);
            store_row_bf16(WSP(bf16, WS_HN) + (size_t)r * D, v, lane);
        } else {
            f32x4* xo = (f32x4*)(P.out + (size_t)r * D) + lane;
#pragma unroll
            for (int j = 0; j < 4; ++j) xo[64 * j] = v.v[j];
        }
    }
}

constexpr int NPHASE = 20;
struct Args { Ptrs P; int ph_lo, ph_hi; };
__global__ void __launch_bounds__(NTHR, 2) mk_fwd(Args args) {
    extern __shared__ __attribute__((aligned(16))) unsigned char lds[];
    Fr F; F.P = args.P; F.lds = lds;
    F.tid = threadIdx.x; F.lane = F.tid & 63; F.wave = __builtin_amdgcn_readfirstlane(F.tid >> 6);
    F.nblk = gridDim.x; F.blk = blockIdx.x; F.gw = F.blk * NWAVES + F.wave; F.ngw = F.nblk * NWAVES;
    F.gtid = (size_t)F.blk * NTHR + F.tid; F.gsz = (size_t)F.nblk * NTHR;
    const Ptrs& P = F.P;
    if (F.tid < 64) ((unsigned*)(lds + LDS_MISC))[F.tid] = 0u;
    __syncthreads();
    const int lo = args.ph_lo, hi = args.ph_hi;
    XcdBarrier bar; bar.bar = (unsigned*)(P.ws + WS_CTL); bar.x = 0; bar.st = nullptr;
    if (hi - lo > 1) bar = xcd_barrier_post((unsigned*)(P.ws + WS_CTL), (volatile LAS unsigned*)(lds + LDS_MISC));
#ifndef PROBE_MASK
#define PROBE_MASK 0u
#endif
#define IN(k) (lo <= (k) && (k) < hi)
#define REP(k) for (int _rep = 0; _rep < (((PROBE_MASK >> (k)) & 1u) ? 2 : 1); ++_rep)
#define SEAM(k) do { if (IN(k) && IN((k) + 1)) xcd_barrier(bar); } while (0)
    const float* MOD = WSP(float, WS_MOD);
    if (IN(0)) REP(0) { ph_prologue(F); } SEAM(0);
    if (IN(1)) REP(1) { ph_norm0(F); } SEAM(1);
    if (IN(2)) REP(2) { ph_gemm(F, WSP(bf16, WS_HN), 1024, WSP(bf16, WS_WIN), 1024, NT, 1536, 1024, GF32{EpiF32{WSP(float, WS_Z), ZLD, EVEN_IN}}); } SEAM(2);
    if (IN(3)) { REP(20) { ph_e3(F); } REP(21) { ph_lru<0>(F); } } SEAM(3);
    if (IN(4)) REP(4) { ph_gemm(F, WSP(bf16, WS_QKVN), 384, WSP(bf16, WS_WQKVB), 384, NT, 1792, 384, GF32{EpiF32{WSP(float, WS_QKVR), 1792, 1792}}); } SEAM(4);
    if (IN(5)) { REP(22) { ph_lru<1>(F); } REP(23) { ph_e5(F); } } SEAM(5);
    if (IN(6)) REP(6) { ph_attn_mla(F); } SEAM(6);
    if (IN(7)) REP(7) { ph_gemm(F, WSP(bf16, WS_YM), 1024, WSP(bf16, WS_WOE), 1024, NT, 1024, 1024, GResid{EpiResid{P.in[0], P.in[2], WSP(float, WS_X1), MOD + 2 * 1024}}); } SEAM(7);
    if (IN(8)) REP(8) { ph_router(F, 0, NT); } SEAM(8);
    if (IN(9)) REP(9) { ph_moe_gemm<1>(F, 0); } SEAM(9);
    if (IN(10)) REP(10) { ph_moe_gemm<2>(F, 0); } SEAM(10);
    if (IN(11)) REP(11) { ph_combine<0>(F, 0, NT); } SEAM(11);
    if (IN(12)) REP(12) { ph_gemm(F, WSP(bf16, WS_HN), 1024, WSP(bf16, WS_WQO), 1024, NT, 1536, 1024, GF32{EpiF32{WSP(float, WS_Z), ZLD, 1536}}); } SEAM(12);
    if (IN(13)) REP(13) { ph_oprep(F); } SEAM(13);
    if (IN(14)) REP(14) { ph_attn_gqa(F); } SEAM(14);
    if (IN(15)) REP(15) { ph_gemm(F, WSP(bf16, WS_YM), 1024, WSP(bf16, WS_WOO), 1024, NL, 1024, 1024, GResid{EpiResid{WSP(float, WS_X2), WSP(float, WS_X2) + (size_t)NL * D, WSP(float, WS_X1), MOD + 5 * 6144 + 2 * 1024}}); } SEAM(15);
    if (IN(16)) REP(16) { ph_router(F, 1, NL); } SEAM(16);
    if (IN(17)) REP(17) { ph_moe_gemm<1>(F, 1); } SEAM(17);
    if (IN(18)) REP(18) { ph_moe_gemm<2>(F, 1); } SEAM(18);
    if (IN(19)) REP(19) { ph_combine<1>(F, 1, NL); }
#undef IN
#undef SEAM
}

#ifndef MK_N_LAUNCHES
#define MK_N_LAUNCHES 1
#endif
extern "C" void kernel_launch(void* const* d_in, const int* in_sizes, int n_in, void* d_out, int out_size, void* d_ws, size_t ws_size, hipStream_t stream) {
    static int grid = 0;
    if (grid == 0) {
        if (n_in != 33 || ws_size < WS_END) { fprintf(stderr, "kernel_launch: unexpected n_in %d or ws_size %zu < %zu\n", n_in, ws_size, (size_t)WS_END); grid = -1; return; }
        int dev = 0, cus = 0, per_cu = 0;
        if (hipGetDevice(&dev) != hipSuccess || hipDeviceGetAttribute(&cus, hipDeviceAttributeMultiprocessorCount, dev) != hipSuccess) { grid = -1; return; }
        if (hipFuncSetAttribute((const void*)mk_fwd, hipFuncAttributeMaxDynamicSharedMemorySize, LDS_BYTES) != hipSuccess) { fprintf(stderr, "kernel_launch: hipFuncSetAttribute failed\n"); grid = -1; return; }
        if (hipOccupancyMaxActiveBlocksPerMultiprocessor(&per_cu, (const void*)mk_fwd, NTHR, LDS_BYTES) != hipSuccess || per_cu < 1) { fprintf(stderr, "kernel_launch: occupancy query says %d blocks per CU\n", per_cu); grid = -1; return; }
        (void)hipGetLastError();
        grid = cus;
    }
    if (grid < 0) return;
    Args a{};
    for (int i = 0; i < 33; ++i) a.P.in[i] = (const float*)d_in[i];
    a.P.out = (float*)d_out; a.P.ws = (unsigned char*)d_ws;
    (void)hipMemsetAsync((unsigned char*)d_ws + WS_CTL, 0, CTL_BYTES, stream);
    if (MK_N_LAUNCHES == 1) { a.ph_lo = 0; a.ph_hi = NPHASE; hipLaunchKernelGGL(mk_fwd, dim3(grid), dim3(NTHR), LDS_BYTES, stream, a); }
    else for (int p = 0; p < NPHASE; ++p) { a.ph_lo = p; a.ph_hi = p + 1; hipLaunchKernelGGL(mk_fwd, dim3(grid), dim3(NTHR), LDS_BYTES, stream, a); }
}
```

```cpp
#include <hip/hip_runtime.h>
#include <stdint.h>
#include <stdio.h>

typedef unsigned short bf16;
typedef short bf16x8 __attribute__((ext_vector_type(8)));
typedef float f32x4 __attribute__((ext_vector_type(4)));
typedef float f32x16 __attribute__((ext_vector_type(16)));
typedef unsigned u32x2 __attribute__((ext_vector_type(2)));
typedef unsigned u32x4 __attribute__((ext_vector_type(4)));
typedef int i32x8 __attribute__((ext_vector_type(8)));
typedef int i32x4 __attribute__((ext_vector_type(4)));

constexpr int D = 1024, NB = 4, SEQ = 4096, CTX = 256;
constexpr int NL = NB * SEQ, NC = NB * CTX, NT = NL + NC;
constexpr int TA = SEQ + CTX;
constexpr int NE = 32, TOPK = 4;
constexpr int EVEN_IN = 1440, ZLD = 1536;
constexpr int MAXT256 = 304;
constexpr int ACT_ROWS = MAXT256 * 256;

constexpr size_t al256(size_t x) { return (x + 255) & ~(size_t)255; }
constexpr size_t WS_CTL = 0, CTL_BYTES = 128u << 10;
constexpr size_t CW_CNT = 65536;
constexpr size_t WS_MOD = WS_CTL + CTL_BYTES;
constexpr size_t WS_ROPEM = al256(WS_MOD + 2 * 5 * 6144 * 4);
constexpr size_t WS_ROPEG = al256(WS_ROPEM + 4096 * 16 * 2 * 4);
constexpr size_t WS_WRT = al256(WS_ROPEG + 4096 * 32 * 2 * 4);
constexpr size_t WS_WRI = al256(WS_WRT + 2 * 32 * 1024 * 4);
constexpr size_t WS_WIN = al256(WS_WRI + 2 * 8 * 128 * 64 * 2);
constexpr size_t WS_WQKVB = al256(WS_WIN + 1536 * 1024 * 2);
constexpr size_t WS_WOE = al256(WS_WQKVB + 1792 * 384 * 2);
constexpr size_t WS_WQO = al256(WS_WOE + 1024 * 1024 * 2);
constexpr size_t WS_WOO = al256(WS_WQO + 1536 * 1024 * 2);
constexpr size_t WS_WGU = al256(WS_WOO + 1024 * 1024 * 2);
constexpr size_t WS_WDN = al256(WS_WGU + (size_t)2 * 32 * 2048 * 1024 * 2);
constexpr size_t WS_HN = al256(WS_WDN + (size_t)2 * 32 * 1024 * 1024 * 2);
constexpr size_t WS_Z = al256(WS_HN + (size_t)NT * D * 2);
constexpr size_t WS_QKVN = al256(WS_Z + (size_t)NT * ZLD * 4);
constexpr size_t WS_QKVR = al256(WS_QKVN + (size_t)NT * 384 * 2);
constexpr size_t WS_QM = al256(WS_QKVR + (size_t)NT * 1792 * 4);
constexpr size_t WS_KM = al256(WS_QM + (size_t)NB * 8 * TA * 96 * 2);
constexpr size_t WS_VM = al256(WS_KM + (size_t)NB * 8 * TA * 96 * 2);
constexpr size_t WS_QG = al256(WS_VM + (size_t)NB * 8 * TA * 64 * 2);
constexpr size_t WS_KG = al256(WS_QG + (size_t)NB * 16 * SEQ * 64 * 2);
constexpr size_t WS_VG = al256(WS_KG + (size_t)NB * 4 * TA * 64 * 2);
constexpr size_t WS_YM = al256(WS_VG + (size_t)NB * 4 * TA * 64 * 2);
constexpr size_t WS_X1 = al256(WS_YM + (size_t)NT * D * 2);
constexpr size_t WS_X2 = al256(WS_X1 + (size_t)NT * D * 4);
constexpr size_t WS_F = al256(WS_X2 + (size_t)NT * D * 4);
constexpr size_t WS_LA = al256(WS_F + (size_t)NT * D * 2);
constexpr size_t WS_LB = al256(WS_LA + (size_t)2 * NT * 512 * 4);
constexpr size_t WS_LH = al256(WS_LB + (size_t)2 * NT * 512 * 4);
constexpr size_t WS_XF = al256(WS_LH + (size_t)2 * NT * 512 * 4);
constexpr size_t WS_PE = al256(WS_XF + (size_t)2 * NT * 512 * 4);
constexpr size_t WS_PS = al256(WS_PE + (size_t)NT * 4 * 4);
constexpr size_t WS_PG = al256(WS_PS + (size_t)NT * 4 * 4);
constexpr size_t WS_TOK = al256(WS_PG + (size_t)NT * 4 * 4);
constexpr size_t WS_ACT = al256(WS_TOK + (size_t)NE * NT * 4);
constexpr size_t WS_Y = al256(WS_ACT + (size_t)ACT_ROWS * D * 2);
constexpr size_t WS_END = al256(WS_Y + (size_t)ACT_ROWS * D * 2);

__device__ __forceinline__ unsigned f2bf(float f) { unsigned u = __float_as_uint(f); u += 0x7FFFu + ((u >> 16) & 1u); return u >> 16; }
typedef float f32x2_t __attribute__((ext_vector_type(2)));
typedef __bf16 bf16x2_t __attribute__((ext_vector_type(2)));
__device__ __forceinline__ unsigned pk2(float a, float b) { const f32x2_t v = {a, b}; return __builtin_bit_cast(unsigned, __builtin_convertvector(v, bf16x2_t)); }

__device__ __forceinline__ unsigned pk4_fp8(float a, float b, float c, float d) { unsigned w = 0; w = __builtin_amdgcn_cvt_pk_fp8_f32(a, b, w, false); w = __builtin_amdgcn_cvt_pk_fp8_f32(c, d, w, true); return w; }
__device__ __forceinline__ float bf2f(unsigned b) { return __uint_as_float(b << 16); }
__device__ __forceinline__ float bflo(unsigned u) { return __uint_as_float(u << 16); }
__device__ __forceinline__ float bfhi(unsigned u) { return __uint_as_float(u & 0xffff0000u); }
__device__ __forceinline__ float wave_sum(float v) {
#pragma unroll
    for (int o = 1; o < 64; o <<= 1) v += __shfl_xor(v, o);
    return v;
}

template <int CTRL> __device__ __forceinline__ float dppf(float v) { return __int_as_float(__builtin_amdgcn_update_dpp(0, __float_as_int(v), CTRL, 0xf, 0xf, true)); }
__device__ __forceinline__ float reduce16(float v) { v += dppf<0xB1>(v); v += dppf<0x4E>(v); v += dppf<0x124>(v); v += dppf<0x128>(v); return v; }
__device__ __forceinline__ float dot4(f32x4 a) { return a.x * a.x + a.y * a.y + a.z * a.z + a.w * a.w; }
__device__ __forceinline__ float sigmoidf_(float x) { return 1.f / (1.f + __expf(-x)); }
__device__ __forceinline__ float gelu_tanh(float x) { const float u = 0.7978845608028654f * (x + 0.044715f * x * x * x); return 0.5f * x * (1.f + tanhf(u)); }
__device__ __forceinline__ int mod_row(int r) { return r < NL ? (r >> 12) : 4; }
__device__ __forceinline__ void row_bs(int r, int& b, int& s) { if (r < NL) { b = r >> 12; s = r & 4095; } else { const int rc = r - NL; b = rc >> 8; s = SEQ + (rc & 255); } }


struct Ptrs {
    const float* in[33];
    float* out;
    unsigned char* ws;
};
#define WSP(T, off) ((T*)(P.ws + (off)))
#define LAS __attribute__((address_space(3)))

#define XB_TMO      128
#define XB_XCNT(j)  (256  + 64 * (j))
#define XB_XSUB(j)  (1280 + 64 * (j))
#define XB_XGEN(j)  (2304 + 64 * (j))
#define XB_TOP      3328
#define XB_TOPGEN   3392
#define XCD_BAR_WORDS 3456
#define XB_SPIN_CAP (1u << 18)
__device__ __forceinline__ unsigned xb_ld(unsigned* p)              { return __hip_atomic_load(p, __ATOMIC_RELAXED, __HIP_MEMORY_SCOPE_AGENT); }
__device__ __forceinline__ unsigned xb_add(unsigned* p, unsigned v) { return __hip_atomic_fetch_add(p, v, __ATOMIC_RELAXED, __HIP_MEMORY_SCOPE_AGENT); }
__device__ __forceinline__ unsigned xb_xcc_id() { return (unsigned)__builtin_amdgcn_s_getreg((3 << 11) | 20) & 0xFu; }
#define XB_SPIN(cond, bar) do { unsigned _sp = 0; while (cond) { __builtin_amdgcn_s_sleep(1); \
    if ((++_sp & 255u) == 0u) { if (xb_ld(&(bar)[XB_TMO])) break; if (_sp > XB_SPIN_CAP) { atomicAdd(&(bar)[XB_TMO], 1u); break; } } } } while (0)
struct XcdBarrier { unsigned* bar; unsigned x; volatile LAS unsigned* st; };
__device__ __forceinline__ XcdBarrier xcd_barrier_post(unsigned* bar, volatile LAS unsigned* st) {
    XcdBarrier b; b.bar = bar; b.x = xb_xcc_id(); b.st = st;
    if (threadIdx.x == 0) (void)xb_add(&bar[XB_XCNT(b.x)], 1u);
    return b;
}
__device__ __forceinline__ void xcd_barrier_complete(unsigned* bar, unsigned x, unsigned& nloc, unsigned& nx) {
    const unsigned G = gridDim.x * gridDim.y * gridDim.z;
    unsigned sum, cnt, mine, sp = 0u;
    for (;;) {
        sum = 0u; cnt = 0u; mine = 0u;
#pragma unroll
        for (unsigned j = 0; j < 16; ++j) { const unsigned c = xb_ld(&bar[XB_XCNT(j)]); sum += c; cnt += (c > 0u) ? 1u : 0u; mine = (j == x) ? c : mine; }
        if (sum == G) break;
        __builtin_amdgcn_s_sleep(1);
        if ((++sp & 255u) == 0u) { if (xb_ld(&bar[XB_TMO])) break; if (sp > XB_SPIN_CAP) { atomicAdd(&bar[XB_TMO], 1u); break; } }
    }
    nloc = mine > 0u ? mine : 1u; nx = cnt > 0u ? cnt : 1u;
}
__device__ __forceinline__ void xcd_barrier(const XcdBarrier& b) {
    asm volatile("s_waitcnt vmcnt(0)" ::: "memory");
    __syncthreads();
    if (threadIdx.x == 0) {
        unsigned* bar = b.bar;
        __builtin_amdgcn_s_waitcnt(0);
        unsigned nloc = b.st[0], nx = b.st[1];
        if (nloc == 0u) { xcd_barrier_complete(bar, b.x, nloc, nx); b.st[0] = nloc; b.st[1] = nx; }
        const unsigned old = xb_add(&bar[XB_XSUB(b.x)], 1u);
        const unsigned gen = old / nloc;
        if (old + 1u == (gen + 1u) * nloc) {
            __builtin_amdgcn_fence(__ATOMIC_RELEASE, "agent");
            asm volatile("s_waitcnt vmcnt(0)" ::: "memory");
            const unsigned og = xb_add(&bar[XB_TOP], 1u);
            const unsigned tg = og / nx;
            if (og + 1u == (tg + 1u) * nx) xb_add(&bar[XB_TOPGEN], 1u);
            else XB_SPIN(xb_ld(&bar[XB_TOPGEN]) == tg, bar);
            __builtin_amdgcn_fence(__ATOMIC_ACQUIRE, "agent");
            xb_add(&bar[XB_XGEN(b.x)], 1u);
            asm volatile("s_waitcnt vmcnt(0)" ::: "memory");
        } else {
            XB_SPIN(xb_ld(&bar[XB_XGEN(b.x)]) == gen, bar);
            __builtin_amdgcn_fence(__ATOMIC_ACQUIRE, "agent");
            asm volatile("s_waitcnt vmcnt(0)" ::: "memory");
        }
    }
    __syncthreads();
}

constexpr int NTHR = 512, NWAVES = 8;
constexpr int LRU_ST = 16, LRU_NST = 64 / LRU_ST;
constexpr int LRU_AT = LRU_ST * 144, LRU_GT = LRU_ST * 272, LRU_HT = 64 * 128, LRU_WB = LRU_AT + LRU_GT + LRU_HT;

constexpr int LDS_RING = 131072;
constexpr int LDS_MISC = LDS_RING;
constexpr int LDS_BYTES = LDS_RING + 8192;
struct Fr {
    Ptrs P; unsigned char* lds;
    int tid, lane, wave, gw, ngw, nblk, blk; size_t gtid, gsz;
};

__device__ __forceinline__ void transpose_item(const float* W, int ldw, bf16* WT, int ldt, int k0, int n0, int row_off, int col_off, int map, float* scr, int lane) {
#pragma unroll 8
    for (int i = 0; i < 32; ++i) { const int kk = 2 * i + (lane >> 5); scr[kk * 33 + (lane & 31)] = W[(size_t)(k0 + kk) * ldw + n0 + (lane & 31)]; }
    __builtin_amdgcn_s_waitcnt(0xc07f); asm volatile("" ::: "memory");
    const int c = lane & 7;
#pragma unroll
    for (int j = 0; j < 4; ++j) { const int n = (lane >> 3) + 8 * j; const float* s = scr + (8 * c) * 33 + n;
        u32x4 o; o.x = pk2(s[0 * 33], s[1 * 33]); o.y = pk2(s[2 * 33], s[3 * 33]); o.z = pk2(s[4 * 33], s[5 * 33]); o.w = pk2(s[6 * 33], s[7 * 33]);
        int nn = n0 + n;
        if (map & 1) { const int up = nn >= 1024, jj = nn & 1023; nn = (jj >> 4) * 32 + up * 16 + (jj & 15); }
        if (map & 2) { u32x2 o8; o8.x = pk4_fp8(s[0 * 33] * 64.f, s[1 * 33] * 64.f, s[2 * 33] * 64.f, s[3 * 33] * 64.f); o8.y = pk4_fp8(s[4 * 33] * 64.f, s[5 * 33] * 64.f, s[6 * 33] * 64.f, s[7 * 33] * 64.f);
            *(u32x2*)((unsigned char*)WT + (size_t)(row_off + nn) * ldt + col_off + k0 + 8 * c) = o8; }
        else *(u32x4*)(WT + (size_t)(row_off + nn) * ldt + col_off + k0 + 8 * c) = o; }
    __builtin_amdgcn_s_waitcnt(0xc07f); asm volatile("" ::: "memory");
}
struct TJob { const float* W; bf16* WT; int K, N, ldw, ldt, row_off, col_off, map; long wstride, tstride; int count; };
constexpr int NJOBS = 8;
__device__ __forceinline__ TJob get_job(const Ptrs& P, int j) {
    TJob t; t.row_off = 0; t.col_off = 0; t.map = 0; t.wstride = 0; t.tstride = 0; t.count = 1;
    switch (j) {
    case 0: t.W = P.in[29]; t.WT = WSP(bf16, WS_WGU); t.K = 1024; t.N = 2048; t.ldw = 2048; t.ldt = 1024; t.map = 3; t.wstride = (long)1024 * 2048; t.tstride = (long)2048 * 1024 / 2; t.count = 64; break;
    case 1: t.W = P.in[31]; t.WT = WSP(bf16, WS_WDN); t.K = 1024; t.N = 1024; t.ldw = 1024; t.ldt = 1024; t.map = 2; t.wstride = (long)1024 * 1024; t.tstride = (long)1024 * 1024 / 2; t.count = 64; break;
    case 2: t.W = P.in[8]; t.WT = WSP(bf16, WS_WIN); t.K = 1024; t.N = 1440; t.ldw = 1440; t.ldt = 1024; break;
    case 3: t.W = P.in[17]; t.WT = WSP(bf16, WS_WQKVB); t.K = 256; t.N = 768; t.ldw = 768; t.ldt = 384; break;
    case 4: t.W = P.in[19]; t.WT = WSP(bf16, WS_WQKVB); t.K = 128; t.N = 1024; t.ldw = 1024; t.ldt = 384; t.row_off = 768; t.col_off = 256; break;
    case 5: t.W = P.in[22]; t.WT = WSP(bf16, WS_WOE); t.K = 1024; t.N = 1024; t.ldw = 1024; t.ldt = 1024; break;
    case 6: t.W = P.in[23]; t.WT = WSP(bf16, WS_WQO); t.K = 1024; t.N = 1536; t.ldw = 1536; t.ldt = 1024; break;
    default: t.W = P.in[26]; t.WT = WSP(bf16, WS_WOO); t.K = 1024; t.N = 1024; t.ldw = 1024; t.ldt = 1024; break;
    }
    return t;
}

constexpr int Q_ITEMS_L = 32 * 64 * 16 + 32 * 32 * 16, Q_ITEMS = 2 * Q_ITEMS_L;
struct CItem { const float* W; unsigned char* WT; int ldw, k0, n0, map; };
__device__ __forceinline__ CItem conv_decode(const Ptrs& P, int id) {
    CItem c; const int layer = id / Q_ITEMS_L, r = id % Q_ITEMS_L;
    if (r < 32768) { const int m = layer * 32 + (r >> 10), q = r & 1023; c.W = P.in[29] + (size_t)m * 1024 * 2048; c.WT = P.ws + WS_WGU + (size_t)m * 2048 * 1024; c.ldw = 2048; c.n0 = (q >> 4) * 32; c.k0 = (q & 15) * 64; c.map = 1; }
    else { const int r2 = r - 32768; const int m = layer * 32 + (r2 >> 9), q = r2 & 511; c.W = P.in[31] + (size_t)m * 1024 * 1024; c.WT = P.ws + WS_WDN + (size_t)m * 1024 * 1024; c.ldw = 1024; c.n0 = (q >> 4) * 32; c.k0 = (q & 15) * 64; c.map = 0; }
    return c;
}
__device__ __forceinline__ void conv_load(const CItem& c, float (&v)[32], int lane) {
#pragma unroll
    for (int i = 0; i < 32; ++i) v[i] = c.W[(size_t)(c.k0 + 2 * i + (lane >> 5)) * c.ldw + c.n0 + (lane & 31)];
}
__device__ __forceinline__ void conv_finish(const CItem& c, const float (&v)[32], float* scr, int lane) {
#pragma unroll
    for (int i = 0; i < 32; ++i) scr[(2 * i + (lane >> 5)) * 33 + (lane & 31)] = v[i];
    __builtin_amdgcn_s_waitcnt(0xc07f); asm volatile("" ::: "memory");
    const int cc = lane & 7;
#pragma unroll
    for (int j = 0; j < 4; ++j) { const int n = (lane >> 3) + 8 * j; const float* s = scr + (8 * cc) * 33 + n;
        int nn = c.n0 + n;
        if (c.map & 1) { const int up = nn >= 1024, jj = nn & 1023, jl = jj & 127, q = jl >> 3;
            nn = (jj >> 7) * 256 + ((jl >> 2) & 1) * 128 + (q >> 2) * 32 + up * 16 + (q & 3) * 4 + (jl & 3); }
        else { const int cl = nn & 255;
            nn = (nn & ~255) + (cl & 0xE0) + ((cl >> 2) & 1) * 16 + ((cl >> 3) & 3) * 4 + (cl & 3); }
        u32x2 o8; o8.x = pk4_fp8(s[0 * 33] * 64.f, s[1 * 33] * 64.f, s[2 * 33] * 64.f, s[3 * 33] * 64.f); o8.y = pk4_fp8(s[4 * 33] * 64.f, s[5 * 33] * 64.f, s[6 * 33] * 64.f, s[7 * 33] * 64.f);
        *(u32x2*)(c.WT + (size_t)nn * 1024 + c.k0 + 8 * cc) = o8; }
    __builtin_amdgcn_s_waitcnt(0xc07f); asm volatile("" ::: "memory");
}
__device__ __forceinline__ void conv_seq(Fr& F, int start, int n) {
    if (start + n > Q_ITEMS) n = Q_ITEMS - start;
    if (n <= 0) return;
    float* scr = (float*)(F.lds + F.wave * 64 * 33 * 4);
    float va[32], vb[32];
    CItem ca = conv_decode(F.P, start), cb = ca;
    conv_load(ca, va, F.lane);
#pragma unroll 1
    for (int i = 0; i < n; i += 2) {
        if (i + 1 < n) { cb = conv_decode(F.P, start + i + 1); conv_load(cb, vb, F.lane); }
        conv_finish(ca, va, scr, F.lane);
        if (i + 2 < n) { ca = conv_decode(F.P, start + i + 2); conv_load(ca, va, F.lane); }
        if (i + 1 < n) conv_finish(cb, vb, scr, F.lane);
    }
}
struct Slot { int phase, b0, nb, n; };
constexpr Slot SLOTS[] = {{0, 0, 256, 1}, {2, 152, 104, 6}, {3, 16, 240, 6}, {5, 16, 240, 10}, {7, 16, 240, 6}, {10, 144, 112, 4}, {11, 0, 256, 20}, {12, 152, 104, 6}};
constexpr int NSLOTS = sizeof(SLOTS) / sizeof(Slot);
constexpr int slot_base(int k) { int b = 0; for (int i = 0; i < k; ++i) b += SLOTS[i].nb * 8 * SLOTS[i].n; return b; }
static_assert(slot_base(5) >= Q_ITEMS_L && slot_base(NSLOTS) >= Q_ITEMS, "conversion schedule must cover layer 0 before phase 9 and everything before phase 17");
template <int PH>
__device__ __forceinline__ void conv_fill(Fr& F) {
#pragma unroll
    for (int k = 0; k < NSLOTS; ++k) if (SLOTS[k].phase == PH) {
        __syncthreads();
        if (F.blk >= SLOTS[k].b0 && F.blk < SLOTS[k].b0 + SLOTS[k].nb) conv_seq(F, slot_base(k) + ((F.blk - SLOTS[k].b0) * 8 + F.wave) * SLOTS[k].n, SLOTS[k].n);
    }
}
__device__ __forceinline__ void ph_prologue(Fr& F) {
    const Ptrs& P = F.P;
    if (F.blk < 192) {
        float* sl = (float*)(F.lds + 8 * 64 * 33 * 4);
        float* red = sl + 5 * 1024;
        const float* c = P.in[1]; const float* cc = P.in[3];
        for (int i = F.tid; i < 5 * 1024; i += NTHR) { const int r = i >> 10, k = i & 1023; const float v = r < 4 ? c[r * 1024 + k] : cc[k]; sl[i] = v / (1.f + __expf(-v)); }
        __syncthreads();
        const int l = F.blk / 96, j = (F.blk % 96) * 64 + (F.tid & 63), ks = F.tid >> 6;
        const float* w = P.in[4] + ((size_t)l * 1024 + ks * 128) * 6144 + j;
        float acc[5] = {0.f, 0.f, 0.f, 0.f, 0.f};
#pragma unroll 16
        for (int k = 0; k < 128; ++k) { const float wv = w[(size_t)k * 6144];
#pragma unroll
            for (int r = 0; r < 5; ++r) acc[r] += sl[r * 1024 + ks * 128 + k] * wv; }
#pragma unroll
        for (int r = 0; r < 5; ++r) red[(ks * 5 + r) * 64 + (F.tid & 63)] = acc[r];
        __syncthreads();
        if (F.tid < 320) { const int r = F.tid >> 6, cidx = F.tid & 63; float sum = 0.f;
#pragma unroll
            for (int q = 0; q < 8; ++q) sum += red[(q * 5 + r) * 64 + cidx];
            const int jj = (F.blk % 96) * 64 + cidx;
            WSP(float, WS_MOD)[(l * 5 + r) * 6144 + jj] = sum + P.in[5][l * 6144 + jj]; }
        __syncthreads();
    }
    for (size_t gid = F.gtid; gid < 4096 * 48; gid += F.gsz) {
        const int s = (int)(gid / 48), i = (int)(gid % 48); const int row = s >> 6, col = s & 63;
        if (i < 16) { const int fi = i & 7; const float fr = powf(10000.f, -(float)fi / 8.f); const float ang = (float)(i < 8 ? row : col) * fr;
            float* T = WSP(float, WS_ROPEM) + ((size_t)s * 16 + i) * 2; T[0] = cosf(ang); T[1] = sinf(ang); }
        else { const int ii = i - 16, fi = ii & 15; const float fr = powf(10000.f, -(float)fi / 16.f); const float ang = (float)(ii < 16 ? row : col) * fr;
            float* T = WSP(float, WS_ROPEG) + ((size_t)s * 32 + ii) * 2; T[0] = cosf(ang); T[1] = sinf(ang); }
    }
    for (size_t gid = F.gtid; gid < 2 * 32 * 1024; gid += F.gsz) { const int l = (int)(gid >> 15), e = (int)(gid >> 10) & 31, k = (int)gid & 1023;
        WSP(float, WS_WRT)[gid] = P.in[27][((size_t)l * 1024 + k) * 32 + e]; }
    for (size_t gid = F.gtid; gid < 2 * 8 * 128 * 64; gid += F.gsz) { const int c = (int)gid & 63, o = (int)(gid >> 6) & 127, blk = (int)(gid >> 13) & 7, dir = (int)(gid >> 16);
        const float* src = o < 64 ? P.in[11] : P.in[13];
        WSP(bf16, WS_WRI)[gid] = (bf16)f2bf(src[(((size_t)dir * 8 + blk) * 64 + c) * 64 + (o & 63)]); }
    { u32x4* z = (u32x4*)(WSP(bf16, WS_WIN) + (size_t)1440 * 1024); for (size_t i = F.gtid; i < (size_t)96 * 1024 * 2 / 16; i += F.gsz) z[i] = (u32x4){0u, 0u, 0u, 0u};
      bf16* q = WSP(bf16, WS_WQKVB);
      for (size_t i = F.gtid; i < (size_t)768 * 16; i += F.gsz) { const int r = (int)(i >> 4), c = (int)(i & 15); *(u32x4*)(q + (size_t)r * 384 + 256 + c * 8) = (u32x4){0u, 0u, 0u, 0u}; }
      for (size_t i = F.gtid; i < (size_t)1024 * 32; i += F.gsz) { const int r = (int)(i >> 5), c = (int)(i & 31); *(u32x4*)(q + (size_t)(768 + r) * 384 + c * 8) = (u32x4){0u, 0u, 0u, 0u}; } }
    float* scr = (float*)(F.lds + F.wave * 64 * 33 * 4);
    long base = 0;
#pragma unroll 1
    for (int j = 2; j < NJOBS; ++j) {
        const TJob t = get_job(P, j);
        const int nnb = t.N / 32; const long per = (long)(t.K / 64) * nnb, total = per * t.count;
        long first = ((long)F.gw - base % F.ngw + F.ngw) % F.ngw;
        for (long it = first; it < total; it += F.ngw) {
            const int m = (int)(it / per); const int r = (int)(it % per); const int kb = r / nnb, nb = r % nnb;
            transpose_item(t.W + (size_t)m * t.wstride, t.ldw, t.WT + (size_t)m * t.tstride, t.ldt, kb * 64, nb * 32, t.row_off, t.col_off, t.map, scr, F.lane);
        }
        base += total;
    }
}

struct RowV { f32x4 v[4]; };
__device__ __forceinline__ RowV load_row(const float* p, int lane) { RowV r; const f32x4* q = (const f32x4*)p + lane;
#pragma unroll
    for (int j = 0; j < 4; ++j) r.v[j] = q[64 * j]; return r; }
__device__ __forceinline__ void norm_mod(RowV& r, const float* g, const float* sc, const float* sh, int lane) {
    float s = 0.f;
#pragma unroll
    for (int j = 0; j < 4; ++j) s += r.v[j].x * r.v[j].x + r.v[j].y * r.v[j].y + r.v[j].z * r.v[j].z + r.v[j].w * r.v[j].w;
    const float rs = rsqrtf(wave_sum(s) * (1.f / D) + 1e-6f);
#pragma unroll
    for (int j = 0; j < 4; ++j) { const f32x4 gv = ((const f32x4*)g)[lane + 64 * j], scv = ((const f32x4*)sc)[lane + 64 * j], shv = ((const f32x4*)sh)[lane + 64 * j];
        r.v[j] = (r.v[j] * rs * gv) * (scv + 1.f) + shv; }
}
__device__ __forceinline__ void store_row_bf16(bf16* p, const RowV& r, int lane) { u32x2* q = (u32x2*)p + lane;
#pragma unroll
    for (int j = 0; j < 4; ++j) { u32x2 o; o.x = pk2(r.v[j].x, r.v[j].y); o.y = pk2(r.v[j].z, r.v[j].w); q[64 * j] = o; } }
__device__ __forceinline__ const float* xrow0(const Ptrs& P, int r) { return r < NL ? P.in[0] + (size_t)r * D : P.in[2] + (size_t)(r - NL) * D; }

__device__ __forceinline__ void ph_norm0(Fr& F) {
    const Ptrs& P = F.P; const float* MOD = WSP(float, WS_MOD);
    for (int r = F.gw; r < NT; r += F.ngw) {
        RowV v = load_row(xrow0(P, r), F.lane);
        const float* m = MOD + (size_t)mod_row(r) * 6144;
        norm_mod(v, P.in[6], m + 1024, m, F.lane);
        store_row_bf16(WSP(bf16, WS_HN) + (size_t)r * D, v, F.lane);
    }
}

__device__ __forceinline__ void wtile(const bf16* a0, const bf16* a1, const bf16* b0, const bf16* b1, int K, f32x4 (&acc)[2][2]) {
#pragma unroll
    for (int m = 0; m < 2; ++m)
#pragma unroll
        for (int n = 0; n < 2; ++n) acc[m][n] = (f32x4){0.f, 0.f, 0.f, 0.f};
#pragma unroll 2
    for (int k = 0; k < K; k += 32) {
        const bf16x8 A0 = *(const bf16x8*)(a0 + k), A1 = *(const bf16x8*)(a1 + k), B0 = *(const bf16x8*)(b0 + k), B1 = *(const bf16x8*)(b1 + k);
        acc[0][0] = __builtin_amdgcn_mfma_f32_16x16x32_bf16(B0, A0, acc[0][0], 0, 0, 0);
        acc[0][1] = __builtin_amdgcn_mfma_f32_16x16x32_bf16(B1, A0, acc[0][1], 0, 0, 0);
        acc[1][0] = __builtin_amdgcn_mfma_f32_16x16x32_bf16(B0, A1, acc[1][0], 0, 0, 0);
        acc[1][1] = __builtin_amdgcn_mfma_f32_16x16x32_bf16(B1, A1, acc[1][1], 0, 0, 0);
    }
}
struct EpiF32 { float* C; int ldc, nvalid;
    __device__ __forceinline__ void operator()(int row, int col, f32x4 a, f32x4 b) const {
        if (col < nvalid) *(f32x4*)(C + (size_t)row * ldc + col) = a;
        if (col + 16 < nvalid) *(f32x4*)(C + (size_t)row * ldc + col + 16) = b; } };
struct EpiResid { const float* xin0; const float* xin1; float* xout; const float* g;
    __device__ __forceinline__ void operator()(int row, int col, f32x4 a, f32x4 b) const {
        const float* xi = row < NL ? xin0 + (size_t)row * D : xin1 + (size_t)(row - NL) * D; const float* gg = g + (size_t)mod_row(row) * 6144;
        float* xo = xout + (size_t)row * D;
        *(f32x4*)(xo + col) = *(const f32x4*)(xi + col) + *(const f32x4*)(gg + col) * a;
        *(f32x4*)(xo + col + 16) = *(const f32x4*)(xi + col + 16) + *(const f32x4*)(gg + col + 16) * b; } };
struct EpiSwiglu { bf16* act; const float* bias;
    __device__ __forceinline__ void operator()(int row, int col, f32x4 a, f32x4 b) const {
        const int j = (col >> 5) * 16 + (col & 15);
        const f32x4 bg = *(const f32x4*)(bias + j), bu = *(const f32x4*)(bias + 1024 + j);
        float o[4];
#pragma unroll
        for (int i = 0; i < 4; ++i) { float hg = a[i] + bg[i], hu = b[i] + bu[i]; hg = fminf(hg, 7.f); hu = fminf(fmaxf(hu, -7.f), 7.f);
            o[i] = hg * sigmoidf_(1.702f * hg) * (hu + 1.f); }
        *(unsigned*)((unsigned char*)act + (size_t)row * D + j) = pk4_fp8(o[0], o[1], o[2], o[3]); } };
struct EpiBiasBf16 { bf16* Y; const float* bias;
    __device__ __forceinline__ void operator()(int row, int col, f32x4 a, f32x4 b) const {
        const f32x4 b0 = *(const f32x4*)(bias + col), b1 = *(const f32x4*)(bias + col + 16);
        u32x2 w; w.x = pk2(a[0] + b0[0], a[1] + b0[1]); w.y = pk2(a[2] + b0[2], a[3] + b0[3]); *(u32x2*)(Y + (size_t)row * D + col) = w;
        w.x = pk2(b[0] + b1[0], b[1] + b1[1]); w.y = pk2(b[2] + b1[2], b[3] + b1[3]); *(u32x2*)(Y + (size_t)row * D + col + 16) = w; } };

__device__ __forceinline__ void moe_prefix(Fr& F, int layer) {
    int* pre = (int*)(F.lds + LDS_MISC + 64);
    const int* cnt = (const int*)(F.P.ws + WS_CTL + CW_CNT) + layer * NE;
    __syncthreads();
    if (F.tid == 0) { int s = 0; for (int e = 0; e < NE; ++e) { pre[e] = s; s += (cnt[e] + 255) >> 8; } pre[NE] = s; }
    __syncthreads();
}
__device__ __forceinline__ int moe_find(const int* pre, int t256) {
    const int lane = threadIdx.x & 63; const int v = lane < NE ? pre[lane + 1] : 0x7fffffff; return __popcll(__ballot(v <= t256)); }

namespace pg {
constexpr int BM = 256, BK = 64, HALF = 128, HTB = HALF * BK * 2, STAGE_BYTES = 8 * HTB, NXCD = 8, WGM = 8;
__device__ __forceinline__ int lds_byte(int r, int c) { const int st = (r >> 4) * 2 + (c >> 5), rr = r & 15, cc = c & 31, ob = rr * 64 + cc * 2; return st * 1024 + (ob ^ (((ob >> 9) & 1) << 5)); }
__device__ __forceinline__ void stage_rc(int b, int& R, int& C) { const int st = b / 1024, sb = b % 1024, swz = sb ^ (((sb >> 9) & 1) << 5); R = (st >> 1) * 16 + swz / 64; C = (st & 1) * 32 + (swz % 64) / 2; }
struct Unit { int pm, pn, e, mt; };
struct DenseSched {
    const bf16* A; const bf16* Bt; int ldab, ldbb, nkt; int nM, nN, nwg, G, c;
    __device__ __forceinline__ void init(const bf16* A_, int lda_, const bf16* Bt_, int ldb_, int M, int N, int K_, int G_, int c_) { A = A_; Bt = Bt_; ldab = lda_ * 2; ldbb = ldb_ * 2; nkt = K_ / BK; nM = M / BM; nN = N / BM; nwg = nM * nN; G = G_; c = c_; }
    __device__ __forceinline__ bool next(int i, Unit& u) const {
        const long L = (long)i * G + c; if (L >= nwg) return false;
        int wgid = (int)L; { const int q = nwg / NXCD, r = nwg % NXCD, xcd = wgid % NXCD, off = wgid / NXCD; wgid = (xcd < r ? xcd * (q + 1) : r * (q + 1) + (xcd - r) * q) + off; }
        const int nig = WGM * nN, gid = wgid / nig, fm = gid * WGM, gsz = (nM - fm) < WGM ? (nM - fm) : WGM;
        u.pm = fm + ((wgid % nig) % gsz); u.pn = (wgid % nig) / gsz; u.e = 0; u.mt = 0; return true;
    }
    __device__ __forceinline__ void fill(const Unit&, int, int, LAS unsigned char*, int) const {}
    __device__ __forceinline__ unsigned aoff(const Unit& u, int, LAS unsigned char*, int r, int C) const { return (unsigned)((u.pm * BM + r) * ldab + C * 2); }
    __device__ __forceinline__ const char* bbase(const Unit& u) const { return (const char*)Bt + (size_t)u.pn * BM * ldbb; }
};
template <int STAGE> struct MoeSched {
    const bf16* A; const bf16* Bt; int ldab, ldbb, nkt; int G, c, NN, nunits; const int* pre; const int* cnt; const int* toklist; const float* bias;
    __device__ __forceinline__ bool next(int i, Unit& u) const {
        int t256;
        if (G == 256) { const int x = c & 7, j = c >> 3;
            const int tpr = 256 / NN, nfull = (nunits / NN) / tpr;
            if (i < nfull) { if (STAGE == 1) { t256 = i * 32 + x * 4 + (j >> 3); u.pn = j & 7; } else { t256 = i * 64 + x * 8 + (j >> 2); u.pn = j & 3; } }
            else { if (i > nfull) return false;
                const int R = nunits / NN - nfull * tpr, per = (R + 7) >> 3, lt = STAGE == 1 ? (j >> 3) : (j >> 2);
                if (lt >= per || x * per + lt >= R) return false;
                t256 = nfull * tpr + x * per + lt; u.pn = STAGE == 1 ? (j & 7) : (j & 3); } }
        else { const long L = (long)i * G + c; if (L >= nunits) return false; t256 = (int)(L / NN); u.pn = (int)(L % NN); }
        u.pm = t256; u.e = moe_find(pre, t256); u.mt = t256 - pre[u.e]; return true;
    }
    __device__ __forceinline__ void fill(const Unit& u, int par, int slot3, LAS unsigned char* lds, int tid) const {
        if (STAGE == 1 && tid < 256) { const int c = cnt[u.e]; int slot = u.mt * BM + tid; slot = slot < c ? slot : c - 1;
            __builtin_amdgcn_global_load_lds((const unsigned*)(toklist + (size_t)u.e * NT + slot), (LAS unsigned*)(lds + LDS_MISC + 512 + par * 1024 + (tid >> 6) * 256), 4, 0, 0); }
        if (tid >= 256) { const int w = (tid >> 6) - 4, l = tid & 63;
            const float* src = STAGE == 1 ? bias + (size_t)u.e * 2048 + (w >> 1) * 1024 + u.pn * 128 + (w & 1) * 64 + l : bias + (size_t)u.e * 1024 + u.pn * 256 + w * 64 + l;
            __builtin_amdgcn_global_load_lds((const unsigned*)src, (LAS unsigned*)(lds + LDS_MISC + 2560 + slot3 * 1024 + w * 256), 4, 0, 0); }
    }
    __device__ __forceinline__ unsigned aoff(const Unit& u, int par, LAS unsigned char* lds, int r, int C) const {
        if (STAGE == 1) { const int tok = *(const LAS int*)(lds + LDS_MISC + 512 + par * 1024 + r * 4); return (unsigned)(tok * ldab + C * 2); }
        return (unsigned)((u.pm * BM + r) * ldab + C * 2);
    }
    __device__ __forceinline__ const char* bbase(const Unit& u) const { return (const char*)Bt + ((size_t)u.e * NN * BM + (size_t)u.pn * BM) * ldbb; }
};

template <bool FP8, class Sched, class Epi>
__device__ __forceinline__ void gemm_phase(LAS unsigned char* lds, const Sched& S, const Epi& E) {
    const int tid = threadIdx.x, wid = __builtin_amdgcn_readfirstlane(tid >> 6), lane = tid & 63, wr = wid >> 2, wc = wid & 3, fr = lane & 15, fq = lane >> 4;
    const int nt = S.nkt;
    int Rr[2], Cc[2]; unsigned voffB[2];
#pragma unroll
    for (int i = 0; i < 2; ++i) { stage_rc(tid * 16 + i * 8192, Rr[i], Cc[i]); voffB[i] = (unsigned)(Rr[i] * S.ldbb + Cc[i] * 2); }
    const size_t kstep = (size_t)(BK * 2);
    const size_t hstepB = (size_t)HALF * S.ldbb;
    const unsigned ldsw = (unsigned)wid * 1024u;
    const int aoff = lds_byte(wr * 64 + fr, fq * 8), boff = lds_byte(wc * 32 + fr, fq * 8);
#define PG_SA(b, h) (((b) * 2 + (h)) * HTB)
#define PG_SB(b, h) ((4 + (b) * 2 + (h)) * HTB)
#define PG_STAGE(bufoff, gbase, voff) do { _Pragma("unroll") for (int _i = 0; _i < 2; ++_i) \
        __builtin_amdgcn_global_load_lds((const unsigned*)((const char*)(gbase) + (voff)[_i]), (LAS unsigned*)(lds + (bufoff) + ldsw + _i * 8192), 16, 0, 0); } while (0)
#define PG_LDA(dst, b, h) do { if constexpr (FP8) { _Pragma("unroll") for (int m = 0; m < 4; ++m) { const i32x4 _l = *(const LAS i32x4*)(lds + PG_SA(b, h) + aoff + m * 2048), _h = *(const LAS i32x4*)(lds + PG_SA(b, h) + aoff + m * 2048 + 1024); \
        dst##8[m] = __builtin_shufflevector(_l, _h, 0, 1, 2, 3, 4, 5, 6, 7); } } \
    else { _Pragma("unroll") for (int m = 0; m < 4; ++m) _Pragma("unroll") for (int k = 0; k < 2; ++k) dst[m][k] = *(const LAS bf16x8*)(lds + PG_SA(b, h) + aoff + m * 2048 + k * 1024); } } while (0)
#define PG_LDB(dst, b, h) do { if constexpr (FP8) { _Pragma("unroll") for (int n = 0; n < 2; ++n) { const i32x4 _l = *(const LAS i32x4*)(lds + PG_SB(b, h) + boff + n * 2048), _h = *(const LAS i32x4*)(lds + PG_SB(b, h) + boff + n * 2048 + 1024); \
        dst##8[n] = __builtin_shufflevector(_l, _h, 0, 1, 2, 3, 4, 5, 6, 7); } } \
    else { _Pragma("unroll") for (int n = 0; n < 2; ++n) _Pragma("unroll") for (int k = 0; k < 2; ++k) dst[n][k] = *(const LAS bf16x8*)(lds + PG_SB(b, h) + boff + n * 2048 + k * 1024); } } while (0)
#define PG_MMA(ai, bj, At, Bt) do { __builtin_amdgcn_s_setprio(1); if constexpr (FP8) { _Pragma("unroll") for (int m = 0; m < 4; ++m) _Pragma("unroll") for (int n = 0; n < 2; ++n) \
        asm volatile("v_mfma_scale_f32_16x16x128_f8f6f4 %0, %1, %2, %0, %3, %4 op_sel_hi:[0,0,0]" : "+v"(acc[ai][bj][m][n]) : "v"(Bt##8[n]), "v"(At##8[m]), "v"(sc_w), "v"(sc_a)); } \
    else { _Pragma("unroll") for (int m = 0; m < 4; ++m) _Pragma("unroll") for (int n = 0; n < 2; ++n) _Pragma("unroll") for (int k = 0; k < 2; ++k) \
        acc[ai][bj][m][n] = __builtin_amdgcn_mfma_f32_16x16x32_bf16(Bt[n][k], At[m][k], acc[ai][bj][m][n], 0, 0, 0); } __builtin_amdgcn_s_setprio(0); } while (0)
#define PG_MMA2(ai, At, B0, B1) do { PG_MMA(ai, 0, At, B0); PG_MMA(ai, 1, At, B1); } while (0)
#define PG_WAIT_V(n) asm volatile("s_waitcnt vmcnt(" #n ")" ::: "memory")
#define PG_WAIT_VL(n) asm volatile("s_waitcnt vmcnt(" #n ") lgkmcnt(0)" ::: "memory")
#define PG_WAIT_L(n) asm volatile("s_waitcnt lgkmcnt(" #n ")" ::: "memory")
#define PG_BAR __builtin_amdgcn_s_barrier()
#define PG_SCHED __builtin_amdgcn_sched_barrier(0)
    Unit cur, nxt; int ui = 0;
    if (!S.next(0, cur)) return;
    f32x4 acc[2][2][4][2];
#pragma unroll
    for (int a = 0; a < 2; ++a)
#pragma unroll
        for (int b = 0; b < 2; ++b)
#pragma unroll
            for (int m = 0; m < 4; ++m)
#pragma unroll
                for (int n = 0; n < 2; ++n) acc[a][b][m][n] = (f32x4){0.f, 0.f, 0.f, 0.f};
    bf16x8 At[4][2], B0[2][2], B1[2][2]; i32x8 At8[4], B08[2], B18[2];
    int sc_w = 0x79797979, sc_a = 0x7F7F7F7F;
    asm volatile("" : "+v"(sc_w), "+v"(sc_a));
    unsigned voA0[2], voA1[2], vnA0[2], vnA1[2];
    S.fill(cur, 0, 0, lds, tid);
    asm volatile("s_waitcnt vmcnt(0)" ::: "memory"); __syncthreads();
#pragma unroll
    for (int i = 0; i < 2; ++i) { voA0[i] = S.aoff(cur, 0, lds, Rr[i], Cc[i]); voA1[i] = S.aoff(cur, 0, lds, HALF + Rr[i], Cc[i]); }
    const char* Ab = (const char*)S.A; const char* cB = S.bbase(cur);
    PG_STAGE(PG_SB(0, 0), cB, voffB); PG_STAGE(PG_SB(0, 1), cB + hstepB, voffB); PG_STAGE(PG_SA(0, 0), Ab, voA0); PG_STAGE(PG_SA(0, 1), Ab, voA1);
    if (wr == 1) PG_BAR;
    PG_WAIT_V(2); PG_BAR;
    PG_STAGE(PG_SB(1, 0), cB + kstep, voffB); PG_STAGE(PG_SA(1, 0), Ab + kstep, voA0); PG_STAGE(PG_SB(1, 1), cB + hstepB + kstep, voffB);
    PG_WAIT_V(6); PG_BAR;
    for (;;) {
        const bool has_next = S.next(ui + 1, nxt);
        const char* nB = has_next ? S.bbase(nxt) : cB;
        if (has_next) S.fill(nxt, (ui + 1) & 1, (ui + 1) % 3, lds, tid);
        for (int t = 0; t < nt; t += 2) {
            const bool last = (t == nt - 2);
            if (last) {
#pragma unroll
                for (int i = 0; i < 2; ++i) { vnA0[i] = has_next ? S.aoff(nxt, (ui + 1) & 1, lds, Rr[i], Cc[i]) : voA0[i]; vnA1[i] = has_next ? S.aoff(nxt, (ui + 1) & 1, lds, HALF + Rr[i], Cc[i]) : voA1[i]; } }
            const char* a1 = Ab + (size_t)(t + 1) * kstep;
            const char* a2 = last ? Ab : Ab + (size_t)(t + 2) * kstep; const char* b2 = last ? nB : cB + (size_t)(t + 2) * kstep;
            const char* a3 = a2 + kstep; const char* b3 = b2 + kstep;
            unsigned o20[2], o21[2];
#pragma unroll
            for (int i = 0; i < 2; ++i) { o20[i] = last ? vnA0[i] : voA0[i]; o21[i] = last ? vnA1[i] : voA1[i]; }
            PG_LDB(B0, 0, 0); PG_LDB(B1, 0, 1); PG_LDA(At, 0, 0); PG_STAGE(PG_SA(1, 1), a1, voA1);
            PG_WAIT_VL(8); PG_BAR; PG_SCHED; PG_MMA2(0, At, B0, B1); PG_BAR; PG_SCHED;
            PG_LDA(At, 0, 1); PG_STAGE(PG_SB(0, 0), b2, voffB); PG_STAGE(PG_SB(0, 1), b2 + hstepB, voffB); PG_STAGE(PG_SA(0, 0), a2, o20);
            PG_WAIT_VL(8); PG_BAR; PG_SCHED; PG_MMA2(1, At, B0, B1); PG_BAR; PG_SCHED;
            PG_LDB(B0, 1, 0); PG_LDB(B1, 1, 1); PG_LDA(At, 1, 0); PG_STAGE(PG_SA(0, 1), a2, o21);
            PG_WAIT_VL(8); PG_BAR; PG_SCHED; PG_MMA2(0, At, B0, B1); PG_BAR; PG_SCHED;
            PG_LDA(At, 1, 1); PG_STAGE(PG_SB(1, 0), b3, voffB); PG_STAGE(PG_SB(1, 1), b3 + hstepB, voffB); PG_STAGE(PG_SA(1, 0), a3, o20);
            PG_WAIT_VL(8); PG_BAR; PG_SCHED; PG_MMA2(1, At, B0, B1); PG_BAR; PG_SCHED;
        }
        if constexpr (FP8) asm volatile("s_nop 15\n\ts_nop 15" : "+v"(acc[1][1][0][0]), "+v"(acc[1][1][0][1]), "+v"(acc[1][1][1][0]), "+v"(acc[1][1][1][1]), "+v"(acc[1][1][2][0]), "+v"(acc[1][1][2][1]), "+v"(acc[1][1][3][0]), "+v"(acc[1][1][3][1]) :: "memory");
        if constexpr (Epi::WIDE) { const int row0 = cur.pm * BM + wr * 64 + fr; const typename Epi::Ctx cx = E.prepw(cur, wc, fq, lds, ui % 3);
#pragma unroll
          for (int ai = 0; ai < 2; ++ai)
#pragma unroll
              for (int m = 0; m < 4; ++m) E.applyw(cx, row0 + ai * HALF + m * 16, acc[ai][0][m][0], acc[ai][0][m][1], acc[ai][1][m][0], acc[ai][1][m][1]); }
        else { const int row0 = cur.pm * BM + wr * 64 + fr, col0 = cur.pn * BM + wc * 32 + 4 * fq;
          const typename Epi::Ctx cx0 = E.prep(cur, col0), cx1 = E.prep(cur, col0 + HALF);
#pragma unroll
          for (int ai = 0; ai < 2; ++ai) {
              if constexpr (Epi::ROWLOAD) {
                  typename Epi::Rv rv[4][2];
#pragma unroll
                  for (int m = 0; m < 4; ++m) { rv[m][0] = E.load(row0 + ai * HALF + m * 16, col0); rv[m][1] = E.load(row0 + ai * HALF + m * 16, col0 + HALF); }
#pragma unroll
                  for (int m = 0; m < 4; ++m) { E.apply(cx0, rv[m][0], row0 + ai * HALF + m * 16, col0, acc[ai][0][m][0], acc[ai][0][m][1]);
                                                E.apply(cx1, rv[m][1], row0 + ai * HALF + m * 16, col0 + HALF, acc[ai][1][m][0], acc[ai][1][m][1]); }
              } else {
#pragma unroll
                  for (int m = 0; m < 4; ++m) { E.apply(cx0, cur, row0 + ai * HALF + m * 16, col0, acc[ai][0][m][0], acc[ai][0][m][1]);
                                                E.apply(cx1, cur, row0 + ai * HALF + m * 16, col0 + HALF, acc[ai][1][m][0], acc[ai][1][m][1]); }
              } } }
        if (!has_next) break;
#pragma unroll
        for (int a = 0; a < 2; ++a)
#pragma unroll
            for (int b = 0; b < 2; ++b)
#pragma unroll
                for (int m = 0; m < 4; ++m)
#pragma unroll
                    for (int n = 0; n < 2; ++n) acc[a][b][m][n] = (f32x4){0.f, 0.f, 0.f, 0.f};
        cur = nxt; cB = nB; ++ui;
#pragma unroll
        for (int i = 0; i < 2; ++i) { voA0[i] = vnA0[i]; voA1[i] = vnA1[i]; }
    }
    PG_WAIT_V(0);
    if (wr == 0) PG_BAR;
    PG_BAR;
#undef PG_SA
#undef PG_SB
#undef PG_STAGE
#undef PG_LDA
#undef PG_LDB
#undef PG_MMA
#undef PG_MMA2
#undef PG_WAIT_VL
#undef PG_WAIT_V
#undef PG_WAIT_L
#undef PG_BAR
#undef PG_SCHED
}
}
struct GF32 { EpiF32 e; static constexpr bool ROWLOAD = false, WIDE = false; struct Ctx {}; struct Rv {};
    __device__ __forceinline__ Ctx prep(const pg::Unit&, int) const { return Ctx{}; }
    __device__ __forceinline__ void apply(const Ctx&, const pg::Unit&, int row, int col, f32x4 a, f32x4 b) const { e(row, col, a, b); } };
struct GResid { const float* xin0; const float* xin1; float* xout; const float* g; static constexpr bool ROWLOAD = true, WIDE = false;
    struct Ctx { f32x4 g0, g1; }; struct Rv { f32x4 x0, x1; };
    __device__ __forceinline__ Ctx prep(const pg::Unit& u, int col) const { const float* gg = g + (size_t)mod_row(u.pm * 256) * 6144; return Ctx{*(const f32x4*)(gg + col), *(const f32x4*)(gg + col + 16)}; }
    __device__ __forceinline__ Rv load(int row, int col) const { const float* xi = row < NL ? xin0 + (size_t)row * D : xin1 + (size_t)(row - NL) * D; return Rv{*(const f32x4*)(xi + col), *(const f32x4*)(xi + col + 16)}; }
    __device__ __forceinline__ void apply(const Ctx& c, const Rv& r, int row, int col, f32x4 a, f32x4 b) const { float* xo = xout + (size_t)row * D;
        *(f32x4*)(xo + col) = r.x0 + c.g0 * a; *(f32x4*)(xo + col + 16) = r.x1 + c.g1 * b; } };
struct GSwiglu { bf16* act; const float* bias; static constexpr bool ROWLOAD = false, WIDE = true;
    struct Ctx { f32x4 bg0, bg1, bu0, bu1; int j; }; struct Rv {};
    __device__ __forceinline__ Ctx prepw(const pg::Unit& u, int wc, int fq, LAS unsigned char* lds, int par) const { const int jl = 8 * (4 * wc + fq); const LAS float* tb = (const LAS float*)(lds + LDS_MISC + 2560 + par * 1024);
        return Ctx{*(const LAS f32x4*)(tb + jl), *(const LAS f32x4*)(tb + jl + 4), *(const LAS f32x4*)(tb + 128 + jl), *(const LAS f32x4*)(tb + 128 + jl + 4), u.pn * 128 + jl}; }
    __device__ __forceinline__ void applyw(const Ctx& c, int row, f32x4 g0, f32x4 u0, f32x4 g1, f32x4 u1) const {
        float o[8];
#pragma unroll
        for (int i = 0; i < 4; ++i) { float hg = g0[i] + c.bg0[i], hu = u0[i] + c.bu0[i]; hg = fminf(hg, 7.f); hu = fminf(fmaxf(hu, -7.f), 7.f); o[i] = hg * __builtin_amdgcn_rcpf(1.f + __expf(-1.702f * hg)) * (hu + 1.f);
            hg = g1[i] + c.bg1[i]; hu = u1[i] + c.bu1[i]; hg = fminf(hg, 7.f); hu = fminf(fmaxf(hu, -7.f), 7.f); o[4 + i] = hg * __builtin_amdgcn_rcpf(1.f + __expf(-1.702f * hg)) * (hu + 1.f); }
        u32x2 w; w.x = pk4_fp8(o[0], o[1], o[2], o[3]); w.y = pk4_fp8(o[4], o[5], o[6], o[7]);
        *(u32x2*)((unsigned char*)act + (size_t)row * D + c.j) = w; } };
struct GBiasBf16 { bf16* Y; const float* bias; static constexpr bool ROWLOAD = false, WIDE = true;
    struct Ctx { f32x4 b00, b01, b10, b11; int col; }; struct Rv {};
    __device__ __forceinline__ Ctx prepw(const pg::Unit& u, int wc, int fq, LAS unsigned char* lds, int par) const { const int cl = 32 * wc + 8 * fq; const LAS float* tb = (const LAS float*)(lds + LDS_MISC + 2560 + par * 1024) + cl;
        return Ctx{*(const LAS f32x4*)tb, *(const LAS f32x4*)(tb + 4), *(const LAS f32x4*)(tb + 128), *(const LAS f32x4*)(tb + 132), u.pn * 256 + cl}; }
    __device__ __forceinline__ void applyw(const Ctx& c, int row, f32x4 a0, f32x4 a1, f32x4 b0, f32x4 b1) const {
        a0 += c.b00; a1 += c.b01; b0 += c.b10; b1 += c.b11;
        u32x4 w; w.x = pk2(a0[0], a0[1]); w.y = pk2(a0[2], a0[3]); w.z = pk2(a1[0], a1[1]); w.w = pk2(a1[2], a1[3]); *(u32x4*)(Y + (size_t)row * D + c.col) = w;
        w.x = pk2(b0[0], b0[1]); w.y = pk2(b0[2], b0[3]); w.z = pk2(b1[0], b1[1]); w.w = pk2(b1[2], b1[3]); *(u32x4*)(Y + (size_t)row * D + c.col + 128) = w; } };
template <class Epi>
__device__ __forceinline__ void ph_gemm(Fr& F, const bf16* A, int lda, const bf16* Bt, int ldb, int M, int N, int K, const Epi& E) {
    pg::DenseSched S; S.init(A, lda, Bt, ldb, M, N, K, F.nblk, F.blk);
    pg::gemm_phase<false>((LAS unsigned char*)F.lds, S, E);
}
template <int STAGE>
__device__ __forceinline__ void ph_moe_gemm(Fr& F, int layer, int nkt_probe = 0) {
    const Ptrs& P = F.P;
    moe_prefix(F, layer);
    const int* pre = (const int*)(F.lds + LDS_MISC + 64);
    pg::MoeSched<STAGE> S; S.ldab = 1024; S.ldbb = 1024; S.nkt = nkt_probe > 0 ? nkt_probe : 8; S.G = F.nblk; S.c = F.blk; S.NN = STAGE == 1 ? 8 : 4; S.nunits = pre[NE] * S.NN;
    S.pre = pre; S.cnt = (const int*)(P.ws + WS_CTL + CW_CNT) + layer * NE; S.toklist = WSP(int, WS_TOK);
    S.bias = STAGE == 1 ? P.in[30] + (size_t)layer * NE * 2048 : P.in[32] + (size_t)layer * NE * 1024;
    if (STAGE == 1) { S.A = WSP(bf16, WS_F); S.Bt = (const bf16*)(P.ws + WS_WGU + (size_t)layer * NE * 2048 * 1024); pg::gemm_phase<true>((LAS unsigned char*)F.lds, S, GSwiglu{WSP(bf16, WS_ACT), P.in[30] + (size_t)layer * NE * 2048}); }
    else { S.A = WSP(bf16, WS_ACT); S.Bt = (const bf16*)(P.ws + WS_WDN + (size_t)layer * NE * 1024 * 1024); pg::gemm_phase<true>((LAS unsigned char*)F.lds, S, GBiasBf16{WSP(bf16, WS_Y), P.in[32] + (size_t)layer * NE * 1024}); }
}

__device__ __forceinline__ void ph_e3(Fr& F) {
    const Ptrs& P = F.P; const int lane = F.lane;
    const float* Z = WSP(float, WS_Z); bf16* QKVN = WSP(bf16, WS_QKVN); bf16* KM = WSP(bf16, WS_KM);
    const float* ropeM = WSP(float, WS_ROPEM);
    if (F.blk < 16 && F.nblk > 32) return;
    for (int r = (F.nblk > 32 ? F.gw - 16 * NWAVES : F.gw); r < NT; r += (F.nblk > 32 ? F.ngw - 16 * NWAVES : F.ngw)) {
        const float* z = Z + (size_t)r * ZLD;
        const f32x4 qa = *(const f32x4*)(z + 1024 + 4 * lane);
        float ss = wave_sum(qa.x * qa.x + qa.y * qa.y + qa.z * qa.z + qa.w * qa.w);
        float rs = rsqrtf(ss * (1.f / 256.f) + 1e-6f);
        const f32x4 gq = *(const f32x4*)(P.in[16] + 4 * lane);
        u32x2 o; o.x = pk2(qa.x * rs * gq.x, qa.y * rs * gq.y); o.y = pk2(qa.z * rs * gq.z, qa.w * rs * gq.w);
        *(u32x2*)(QKVN + (size_t)r * 384 + 4 * lane) = o;
        const float k0 = z[1280 + 2 * lane], k1 = z[1280 + 2 * lane + 1];
        ss = wave_sum(k0 * k0 + k1 * k1); rs = rsqrtf(ss * (1.f / 128.f) + 1e-6f);
        *(unsigned*)(QKVN + (size_t)r * 384 + 256 + 2 * lane) = pk2(k0 * rs * P.in[18][2 * lane], k1 * rs * P.in[18][2 * lane + 1]);
        float kr = lane < 32 ? z[1408 + lane] : 0.f;
        ss = wave_sum(kr * kr); rs = rsqrtf(ss * (1.f / 32.f) + 1e-6f);
        kr = kr * rs * (lane < 32 ? P.in[21][32 + lane] : 0.f);
        int b, s; row_bs(r, b, s);
        const float other = __shfl_xor(kr, 16);
        float outv = kr;
        if (r < NL && lane < 32) { const int i = lane & 15; const float cs = ropeM[((size_t)s * 16 + i) * 2], sn = ropeM[((size_t)s * 16 + i) * 2 + 1];
            outv = lane < 16 ? kr * cs - other * sn : kr * cs + other * sn; }
        if (lane < 32) { const bf16 ov = (bf16)f2bf(outv);
#pragma unroll
            for (int h = 0; h < 8; ++h) KM[(((size_t)b * 8 + h) * TA + s) * 96 + 64 + lane] = ov; }
    }
}
__device__ __forceinline__ void ph_e5(Fr& F) {
    const Ptrs& P = F.P; const int lane = F.lane, sub = lane >> 4, d4 = lane & 15;
    const float* R = WSP(float, WS_QKVR); bf16* QM = WSP(bf16, WS_QM); bf16* KM = WSP(bf16, WS_KM); bf16* VT = WSP(bf16, WS_VM);
    const float* ropeM = WSP(float, WS_ROPEM);
    LAS unsigned char* scr = (LAS unsigned char*)F.lds + F.wave * LRU_WB;
    const f32x4 gqn = *(const f32x4*)(P.in[20] + 4 * d4), gkn = *(const f32x4*)(P.in[20] + 64 + 4 * d4);
    const f32x4 gqr = d4 < 8 ? *(const f32x4*)(P.in[21] + 4 * d4) : (f32x4){0.f, 0.f, 0.f, 0.f};
    if (F.blk < 16 && F.nblk > 32) return;
    for (int g = (F.nblk > 32 ? F.gw - 16 * NWAVES : F.gw); g < NT / 8; g += (F.nblk > 32 ? F.ngw - 16 * NWAVES : F.ngw)) {
        const int r0 = g * 8; int b, s0; row_bs(r0, b, s0);
#pragma unroll 2
        for (int h = 0; h < 8; ++h) {
#pragma unroll
            for (int pass = 0; pass < 2; ++pass) {
                const int rr = sub + 4 * pass, r = r0 + rr, s = s0 + rr; const float* q = R + (size_t)r * 1792;
                const size_t qo = (((size_t)b * 8 + h) * TA + s) * 96;
                f32x4 x = *(const f32x4*)(q + h * 96 + 4 * d4);
                float rs = rsqrtf(reduce16(dot4(x)) * (1.f / 64.f) + 1e-6f);
                x = x * rs * gqn;
                { u32x2 w; w.x = pk2(x.x, x.y); w.y = pk2(x.z, x.w); *(u32x2*)(QM + qo + 4 * d4) = w; }
                f32x4 y = d4 < 8 ? *(const f32x4*)(q + h * 96 + 64 + 4 * d4) : (f32x4){0.f, 0.f, 0.f, 0.f};
                rs = rsqrtf(reduce16(dot4(y)) * (1.f / 32.f) + 1e-6f);
                y = y * rs * gqr;
                f32x4 yo; yo.x = __shfl_xor(y.x, 4); yo.y = __shfl_xor(y.y, 4); yo.z = __shfl_xor(y.z, 4); yo.w = __shfl_xor(y.w, 4);
                if (r < NL && d4 < 8) { const float* rp = ropeM + ((size_t)s * 16 + 4 * (d4 & 3)) * 2; const f32x4 c0 = *(const f32x4*)rp, c1 = *(const f32x4*)(rp + 4);
                    const f32x4 cs = {c0.x, c0.z, c1.x, c1.z}, sn = {c0.y, c0.w, c1.y, c1.w};
                    y = d4 < 4 ? y * cs - yo * sn : y * cs + yo * sn; }
                if (d4 < 8) { u32x2 w; w.x = pk2(y.x, y.y); w.y = pk2(y.z, y.w); *(u32x2*)(QM + qo + 64 + 4 * d4) = w; }
                f32x4 kx = *(const f32x4*)(q + 768 + h * 128 + 4 * d4);
                rs = rsqrtf(reduce16(dot4(kx)) * (1.f / 64.f) + 1e-6f);
                kx = kx * rs * gkn;
                { u32x2 w; w.x = pk2(kx.x, kx.y); w.y = pk2(kx.z, kx.w); *(u32x2*)(KM + qo + 4 * d4) = w; }
                const f32x4 vx = *(const f32x4*)(q + 768 + h * 128 + 64 + 4 * d4);
                { u32x2 w; w.x = pk2(vx.x, vx.y); w.y = pk2(vx.z, vx.w); *(LAS u32x2*)(scr + rr * 128 + 8 * d4) = w; }
            }
            unsigned short t8[8];
#pragma unroll
            for (int rr = 0; rr < 8; ++rr) t8[rr] = *(const LAS unsigned short*)(scr + rr * 128 + 2 * lane);
            u32x4 w; w.x = t8[0] | ((unsigned)t8[1] << 16); w.y = t8[2] | ((unsigned)t8[3] << 16); w.z = t8[4] | ((unsigned)t8[5] << 16); w.w = t8[6] | ((unsigned)t8[7] << 16);
            *(u32x4*)(VT + (((size_t)b * 8 + h) * 64 + lane) * TA + s0) = w;
        }
    }
}

template <int DQ> struct ACfg { static constexpr int KP = DQ * 2 + 16, KCH = DQ / 8, KBYTES = 64 * KP, VP = 136, VBYTES = 64 * VP, BUF = KBYTES + VBYTES; };
template <int DQ, bool WIN>
__device__ __forceinline__ void attn_unit(LAS unsigned char* lds, const bf16* Qrow, const bf16* Kb, const bf16* Vtb, int a0, int a1, int b0, int b1,
                                          float c, int qpos, int ctile, float sink2, bf16* Orow, int tid, int lane) {
    typedef ACfg<DQ> C;
    const int hh = lane >> 5, ql = lane & 31;
    bf16x8 qf[DQ / 16];
#pragma unroll
    for (int ks = 0; ks < DQ / 16; ++ks) qf[ks] = *(const bf16x8*)(Qrow + 16 * ks + 8 * hh);
    f32x16 o0, o1;
#pragma unroll
    for (int r = 0; r < 16; ++r) { o0[r] = 0.f; o1[r] = 0.f; }
    float m = -1e30f, lsum = 0.f;
    const int n0 = a1 - a0, ntl = n0 + (b1 - b0);
    const int kkey0 = tid / C::KCH, kpc0 = tid % C::KCH, kkey1 = (tid + 512) / C::KCH, kpc1 = (tid + 512) % C::KCH;
    const bool two = (C::KCH == 12) && tid < 256;
    u32x4 kst0[2], kst1[2], vst[2];
    kst1[0] = (u32x4){0u, 0u, 0u, 0u}; kst1[1] = kst1[0];
#define AT_ISSUE(ti, p) do { const int _t = (ti) < n0 ? a0 + (ti) : b0 + (ti) - n0; const int _k0 = _t * 64; \
        kst0[p] = *(const u32x4*)(Kb + (size_t)(_k0 + kkey0) * DQ + kpc0 * 8); if (two) kst1[p] = *(const u32x4*)(Kb + (size_t)(_k0 + kkey1) * DQ + kpc1 * 8); \
        vst[p] = *(const u32x4*)(Vtb + (size_t)(tid >> 3) * TA + _k0 + (tid & 7) * 8); } while (0)
#define AT_COMMIT(buf, p) do { LAS unsigned char* _b = lds + (buf) * C::BUF; \
        *(LAS u32x4*)(_b + kkey0 * C::KP + kpc0 * 16) = kst0[p]; if (two) *(LAS u32x4*)(_b + kkey1 * C::KP + kpc1 * 16) = kst1[p]; \
        LAS unsigned char* _v = _b + C::KBYTES + (tid >> 3) * C::VP + (tid & 7) * 16; *(LAS u32x2*)_v = (u32x2){vst[p].x, vst[p].y}; *(LAS u32x2*)(_v + 8) = (u32x2){vst[p].z, vst[p].w}; } while (0)
    AT_ISSUE(0, 0); AT_COMMIT(0, 0);
    if (ntl > 1) AT_ISSUE(1, 1);
    __syncthreads();
    for (int tb = 0; tb < ntl; tb += 2) {
#pragma unroll
      for (int half = 0; half < 2; ++half) {
        const int ti = tb + half;
        if (ti < ntl) {
        const int buf = half;
        if (ti + 2 < ntl) AT_ISSUE(ti + 2, half);
        const LAS unsigned char* kb_ = lds + buf * C::BUF; const LAS unsigned char* vb_ = kb_ + C::KBYTES;
        bf16x8 kf0[DQ / 16], kf1[DQ / 16]; u32x2 va0[4], va1[4], vc0[4], vc1[4];
#pragma unroll
        for (int ks = 0; ks < DQ / 16; ++ks) { kf0[ks] = *(const LAS bf16x8*)(kb_ + ql * C::KP + (16 * ks + 8 * hh) * 2); kf1[ks] = *(const LAS bf16x8*)(kb_ + (32 + ql) * C::KP + (16 * ks + 8 * hh) * 2); }
#pragma unroll
        for (int s4 = 0; s4 < 4; ++s4) { const LAS unsigned char* v0 = vb_ + ql * C::VP + (16 * s4 + 4 * hh) * 2; const LAS unsigned char* v1 = v0 + 32 * C::VP;
            va0[s4] = *(const LAS u32x2*)v0; va1[s4] = *(const LAS u32x2*)(v0 + 16); vc0[s4] = *(const LAS u32x2*)v1; vc1[s4] = *(const LAS u32x2*)(v1 + 16); }
        __builtin_amdgcn_sched_barrier(0);
        f32x16 s0, s1;
#pragma unroll
        for (int r = 0; r < 16; ++r) { s0[r] = 0.f; s1[r] = 0.f; }
#pragma unroll
        for (int ks = 0; ks < DQ / 16; ++ks) {
            s0 = __builtin_amdgcn_mfma_f32_32x32x16_bf16(kf0[ks], qf[ks], s0, 0, 0, 0);
            s1 = __builtin_amdgcn_mfma_f32_32x32x16_bf16(kf1[ks], qf[ks], s1, 0, 0, 0);
        }
        const int tile = ti < n0 ? a0 + ti : b0 + ti - n0;
        const bool masked = WIN && ti < n0 && (tile - ctile >= 2 || ctile - tile >= 2);
        if (masked) {
#pragma unroll
            for (int r = 0; r < 16; ++r) { const int key = tile * 64 + (r & 3) + 8 * (r >> 2) + 4 * hh; const int d0 = qpos - key, d1 = qpos - key - 32;
                if (d0 > 128 || d0 < -128) s0[r] = -1e30f; if (d1 > 128 || d1 < -128) s1[r] = -1e30f; }
        }
        asm volatile("s_nop 15\n\ts_nop 15" : "+v"(s0), "+v"(s1));
        float mx;
        { float t0, t1, t2, t3;
          asm volatile("v_max3_f32 %0, %1, %2, %3" : "=v"(t0) : "v"(s0[0]), "v"(s0[1]), "v"(s0[2]));
          asm volatile("v_max3_f32 %0, %1, %2, %3" : "=v"(t1) : "v"(s0[3]), "v"(s0[4]), "v"(s0[5]));
          asm volatile("v_max3_f32 %0, %1, %2, %3" : "=v"(t2) : "v"(s1[0]), "v"(s1[1]), "v"(s1[2]));
          asm volatile("v_max3_f32 %0, %1, %2, %3" : "=v"(t3) : "v"(s1[3]), "v"(s1[4]), "v"(s1[5]));
#pragma unroll
          for (int r = 6; r < 16; r += 2) { asm volatile("v_max3_f32 %0, %0, %1, %2" : "+v"(t0) : "v"(s0[r]), "v"(s0[r + 1])); asm volatile("v_max3_f32 %0, %0, %1, %2" : "+v"(t2) : "v"(s1[r]), "v"(s1[r + 1])); }
          asm volatile("v_max3_f32 %0, %0, %1, %2" : "+v"(t0) : "v"(t1), "v"(t2));
          asm volatile("v_max_f32 %0, %1, %2" : "=v"(mx) : "v"(t0), "v"(t3)); }
        mx = fmaxf(mx, __shfl_xor(mx, 32)) * c;
        if (!__all(mx <= m + 8.f)) { const float mn = fmaxf(m, mx), alpha = __builtin_amdgcn_exp2f(m - mn); m = mn; lsum *= alpha;
#pragma unroll
            for (int r = 0; r < 16; ++r) { o0[r] *= alpha; o1[r] *= alpha; } }
        { f32x16 cv, mv;
#pragma unroll
          for (int r = 0; r < 16; ++r) { cv[r] = c; mv[r] = m; }
          s0 = s0 * cv - mv; s1 = s1 * cv - mv; }
#pragma unroll
        for (int r = 0; r < 16; ++r) { s0[r] = __builtin_amdgcn_exp2f(s0[r]); s1[r] = __builtin_amdgcn_exp2f(s1[r]); }
        { const f32x16 t = s0 + s1;
          typedef float f32x8_t __attribute__((ext_vector_type(8)));
          const f32x8_t u = __builtin_shufflevector(t, t, 0, 1, 2, 3, 4, 5, 6, 7) + __builtin_shufflevector(t, t, 8, 9, 10, 11, 12, 13, 14, 15);
          const f32x4 w = __builtin_shufflevector(u, u, 0, 1, 2, 3) + __builtin_shufflevector(u, u, 4, 5, 6, 7);
          lsum += (w.x + w.y) + (w.z + w.w); }
        bf16x8 pf[4];
#pragma unroll
        for (int s4 = 0; s4 < 4; ++s4) { u32x4 w;
            if (s4 < 2) { w.x = pk2(s0[8 * s4], s0[8 * s4 + 1]); w.y = pk2(s0[8 * s4 + 2], s0[8 * s4 + 3]); w.z = pk2(s0[8 * s4 + 4], s0[8 * s4 + 5]); w.w = pk2(s0[8 * s4 + 6], s0[8 * s4 + 7]); }
            else { const int q = s4 - 2; w.x = pk2(s1[8 * q], s1[8 * q + 1]); w.y = pk2(s1[8 * q + 2], s1[8 * q + 3]); w.z = pk2(s1[8 * q + 4], s1[8 * q + 5]); w.w = pk2(s1[8 * q + 6], s1[8 * q + 7]); }
            pf[s4] = __builtin_bit_cast(bf16x8, w); }
#pragma unroll
        for (int s4 = 0; s4 < 4; ++s4) {
            const bf16x8 va = __builtin_bit_cast(bf16x8, (u32x4){va0[s4].x, va0[s4].y, va1[s4].x, va1[s4].y}), vc = __builtin_bit_cast(bf16x8, (u32x4){vc0[s4].x, vc0[s4].y, vc1[s4].x, vc1[s4].y});
            o0 = __builtin_amdgcn_mfma_f32_32x32x16_bf16(va, pf[s4], o0, 0, 0, 0);
            o1 = __builtin_amdgcn_mfma_f32_32x32x16_bf16(vc, pf[s4], o1, 0, 0, 0);
        }
        if (ti + 1 < ntl) AT_COMMIT(buf ^ 1, half ^ 1);
        __syncthreads();
        }
      }
    }
#undef AT_ISSUE
#undef AT_COMMIT
    float ltot = lsum + __shfl_xor(lsum, 32);
    float fin = 1.f;
    if (WIN) { const float mn = fmaxf(m, sink2); fin = __builtin_amdgcn_exp2f(m - mn); ltot = ltot * fin + __builtin_amdgcn_exp2f(sink2 - mn); }
    const float inv = fin / ltot;
#pragma unroll
    for (int rq = 0; rq < 4; ++rq) {
        u32x2 w; w.x = pk2(o0[4 * rq] * inv, o0[4 * rq + 1] * inv); w.y = pk2(o0[4 * rq + 2] * inv, o0[4 * rq + 3] * inv); *(u32x2*)(Orow + 8 * rq + 4 * hh) = w;
        w.x = pk2(o1[4 * rq] * inv, o1[4 * rq + 1] * inv); w.y = pk2(o1[4 * rq + 2] * inv, o1[4 * rq + 3] * inv); *(u32x2*)(Orow + 32 + 8 * rq + 4 * hh) = w;
    }
}
__device__ __forceinline__ void ph_attn_mla(Fr& F) {
    const Ptrs& P = F.P;
    const bf16* QM = WSP(bf16, WS_QM); const bf16* KM = WSP(bf16, WS_KM); const bf16* VT = WSP(bf16, WS_VM);
    const int x = F.blk & 7, j = F.blk >> 3;
    const float c = 0.10206207261596577f * 1.4426950408889634f;
    for (int rd = 0; ; ++rd) {
        int bh, qb;
        if (F.nblk == 256) { if (rd < 2) { bh = rd * 16 + 2 * x + (j >> 4); qb = j & 15; } else if (rd == 2 && F.blk < 32) { bh = F.blk; qb = 16; } else break; }
        else { const int u = rd * F.nblk + F.blk; if (u >= 544) break; if (u < 512) { bh = u >> 4; qb = u & 15; } else { bh = u - 512; qb = 16; } }
        const int b = bh >> 3, h = bh & 7;
        const int s = qb * 256 + F.wave * 32 + (F.lane & 31);
        const int row = s < SEQ ? b * SEQ + s : NL + b * CTX + (s - SEQ);
        attn_unit<96, false>((LAS unsigned char*)F.lds, QM + ((size_t)bh * TA + s) * 96, KM + (size_t)bh * TA * 96, VT + (size_t)bh * 64 * TA,
                             qb < 16 ? 0 : 64, 68, 0, 0, c, 0, 0, 0.f, WSP(bf16, WS_YM) + (size_t)row * D + 512 + h * 64, F.tid, F.lane);
    }
}

__device__ __forceinline__ float gelu_fast(float x) { const float u = 1.5957691216057308f * (x + 0.044715f * x * x * x); return x / (1.f + __expf(-u)); }
__device__ __forceinline__ void ph_lru_carry(Fr& F) {
    if (F.blk < F.nblk - 8) return;
    const Ptrs& P = F.P; const int g = (F.blk - (F.nblk - 8)) * 8 + F.wave;
    const int bd = g >> 3, ch = (g & 7) * 64 + F.lane;
    const float* ag = WSP(float, WS_LA) + ((size_t)bd * 68) * 1024 + ch * 2; float* cr = WSP(float, WS_LH) + ((size_t)bd * 68) * 512 + ch;
    float h = 0.f;
#pragma unroll 17
    for (int kk = 0; kk < 68; ++kk) { cr[(size_t)kk * 512] = h; const f32x2_t ab = *(const f32x2_t*)(ag + (size_t)kk * 1024); h = ab.x * h + ab.y; }
}
template <int PASS>
__device__ __forceinline__ void ph_lru(Fr& F) {
    const Ptrs& P = F.P; const int lane = F.lane, w = F.wave, ch = w * 64 + lane, fr = lane & 15, fq = lane >> 4;
    LAS unsigned char* At = (LAS unsigned char*)F.lds + w * LRU_WB; LAS unsigned char* Gt = At + LRU_AT; LAS unsigned char* Ht = Gt + LRU_GT;
    const float* Z = WSP(float, WS_Z); const bf16* WRI = WSP(bf16, WS_WRI);
    float* AGG = WSP(float, WS_LA);
    for (int unit = F.blk; unit < NB * 68; unit += F.nblk) {
        const int b = unit / 68, k = unit % 68;
        const bool isctx = k < 4; const int T = isctx ? CTX : SEQ, t0 = isctx ? 64 * k : 64 * (k - 4), segrow0 = isctx ? NL + b * CTX : b * SEQ;
#pragma unroll 1
        for (int dir = 0; dir < 2; ++dir) {
            const int kd = dir == 0 ? k : (isctx ? 3 - k : 71 - k);
            const float cw0 = P.in[9][(dir * 4 + 0) * 512 + ch], cw1 = P.in[9][(dir * 4 + 1) * 512 + ch], cw2 = P.in[9][(dir * 4 + 2) * 512 + ch], cw3 = P.in[9][(dir * 4 + 3) * 512 + ch];
            const float cb = P.in[10][dir * 512 + ch], br = P.in[12][dir * 512 + ch], bi = P.in[14][dir * 512 + ch];
            const float sp8 = -8.f * log1pf(__expf(-P.in[15][dir * 512 + ch]));
            bf16x8 wf[2][2][4];
#pragma unroll
            for (int gate = 0; gate < 2; ++gate)
#pragma unroll
                for (int ks = 0; ks < 2; ++ks)
#pragma unroll
                    for (int n = 0; n < 4; ++n) wf[gate][ks][n] = *(const bf16x8*)(WRI + ((size_t)(dir * 8 + w) * 128 + gate * 64 + 16 * n + fr) * 64 + 32 * ks + 8 * fq);
            float uw[LRU_ST + 3], un[LRU_ST + 3], gv[LRU_ST], gn[LRU_ST];
#define LRU_LOAD(dstu, dstg, st_) do { const int _sub = dir == 0 ? (st_) : LRU_NST - 1 - (st_); const int _ts = t0 + LRU_ST * _sub; \
                _Pragma("unroll") for (int q = 0; q < LRU_ST + 3; ++q) { const int t = dir == 0 ? _ts - 3 + q : _ts + LRU_ST + 2 - q; const bool ok = t >= 0 && t < T; \
                    dstu[q] = ok ? Z[(size_t)(segrow0 + (ok ? t : 0)) * ZLD + ch] : 0.f; } \
                if (PASS == 1 && dir == 1) { _Pragma("unroll") for (int i = 0; i < LRU_ST; ++i) dstg[i] = Z[(size_t)(segrow0 + _ts + LRU_ST - 1 - i) * ZLD + 512 + ch]; } } while (0)
            LRU_LOAD(uw, gv, 0);
            float h = 0.f, pa = 1.f;
            if (PASS == 1) h = WSP(float, WS_LH)[((size_t)(b * 2 + dir) * 68 + kd) * 512 + ch];
#pragma unroll 1
            for (int st = 0; st < LRU_NST; ++st) {
                const int sub = dir == 0 ? st : LRU_NST - 1 - st;
                if (st + 1 < LRU_NST) LRU_LOAD(un, gn, st + 1);
                float xf[LRU_ST], rg[LRU_ST];
#pragma unroll
                for (int i = 0; i < LRU_ST; ++i) xf[i] = cb + cw0 * uw[i] + cw1 * uw[i + 1] + cw2 * uw[i + 2] + cw3 * uw[i + 3];
#pragma unroll
                for (int i = 0; i < LRU_ST; ++i) *(LAS bf16*)(At + i * 144 + lane * 2) = (bf16)f2bf(xf[i]);
#pragma unroll
                for (int gate = 0; gate < 2; ++gate) {
                    f32x4 acc[4];
#pragma unroll
                    for (int n = 0; n < 4; ++n) acc[n] = (f32x4){0.f, 0.f, 0.f, 0.f};
#pragma unroll
                    for (int ks = 0; ks < 2; ++ks) {
                        const bf16x8 af0 = *(const LAS bf16x8*)(At + fr * 144 + (32 * ks + 8 * fq) * 2);
#pragma unroll
                        for (int n = 0; n < 4; ++n) acc[n] = __builtin_amdgcn_mfma_f32_16x16x32_bf16(wf[gate][ks][n], af0, acc[n], 0, 0, 0);
                    }
#pragma unroll
                    for (int n = 0; n < 4; ++n) *(LAS f32x4*)(Gt + fr * 272 + (16 * n + 4 * fq) * 4) = acc[n];
#pragma unroll
                    for (int i = 0; i < LRU_ST; ++i) { const float pre = *(const LAS float*)(Gt + i * 272 + lane * 4);
                        if (gate == 0) rg[i] = sigmoidf_(pre + br);
                        else { const float gi = sigmoidf_(pre + bi); const float a = __expf(sp8 * rg[i]); rg[i] = a; xf[i] = sqrtf(fmaxf(1.f - a * a, 0.f)) * (gi * xf[i]); } }
                }
#pragma unroll
                for (int i = 0; i < LRU_ST; ++i) { const int tl = dir == 0 ? LRU_ST * sub + i : LRU_ST * sub + LRU_ST - 1 - i;
                    h = rg[i] * h + xf[i]; if (PASS == 0) pa *= rg[i];
                    if (PASS == 1) {
                        if (dir == 0) *(LAS bf16*)(Ht + tl * 128 + lane * 2) = (bf16)f2bf(h);
                        else { const float hf = bf2f(*(const LAS bf16*)(Ht + tl * 128 + lane * 2)); const size_t row = (size_t)(segrow0 + t0 + tl);
                            WSP(bf16, WS_YM)[row * D + ch] = (bf16)f2bf((hf + h) * gelu_fast(gv[i])); } } }
#pragma unroll
                for (int q = 0; q < LRU_ST + 3; ++q) uw[q] = un[q];
                if (PASS == 1) {
#pragma unroll
                    for (int i = 0; i < LRU_ST; ++i) gv[i] = gn[i]; }
            }
#undef LRU_LOAD
            if (PASS == 0) { f32x2_t o; o.x = pa; o.y = h; *(f32x2_t*)(AGG + ((size_t)(b * 2 + dir) * 68 + kd) * 1024 + ch * 2) = o; }
        }
    }
}

__device__ __forceinline__ void ph_oprep(Fr& F) {
    const Ptrs& P = F.P; const int lane = F.lane, sub = lane >> 4, d4 = lane & 15;
    const float* Z = WSP(float, WS_Z); bf16* QG = WSP(bf16, WS_QG); bf16* KG = WSP(bf16, WS_KG); bf16* VGT = WSP(bf16, WS_VG);
    const float* ropeG = WSP(float, WS_ROPEG);
    LAS unsigned char* scr = (LAS unsigned char*)F.lds + F.wave * 4096;
    const f32x4 gq = *(const f32x4*)(P.in[24] + 4 * d4), gk = *(const f32x4*)(P.in[24] + 64 + 4 * d4);
    for (int g = F.gw; g < NT / 8; g += F.ngw) {
        const int r0 = g * 8; int b, s0; row_bs(r0, b, s0);
        const bool lat = r0 < NL;
#pragma unroll 2
        for (int rr = 0; rr < 8; ++rr) {
            const int s = s0 + rr; const float* z = Z + (size_t)(r0 + rr) * ZLD;
            f32x4 cs = {1.f, 1.f, 1.f, 1.f}, sn = {0.f, 0.f, 0.f, 0.f};
            if (lat) { const float* rp = ropeG + ((size_t)s * 32 + 4 * (d4 & 7)) * 2; const f32x4 c0 = *(const f32x4*)rp, c1 = *(const f32x4*)(rp + 4);
                cs = (f32x4){c0.x, c0.z, c1.x, c1.z}; sn = (f32x4){c0.y, c0.w, c1.y, c1.w}; }
            if (d4 >= 8) sn = -sn;
            if (lat) {
#pragma unroll
                for (int pass = 0; pass < 4; ++pass) { const int hd = 4 * pass + sub;
                    f32x4 x = *(const f32x4*)(z + hd * 64 + 4 * d4);
                    const float rs = rsqrtf(reduce16(dot4(x)) * (1.f / 64.f) + 1e-6f);
                    x = x * rs * gq;
                    f32x4 xo; xo.x = dppf<0x128>(x.x); xo.y = dppf<0x128>(x.y); xo.z = dppf<0x128>(x.z); xo.w = dppf<0x128>(x.w);
                    x = x * cs - xo * sn;
                    u32x2 w; w.x = pk2(x.x, x.y); w.y = pk2(x.z, x.w); *(u32x2*)(QG + (((size_t)b * 16 + hd) * SEQ + s) * 64 + 4 * d4) = w; } }
            { f32x4 x = *(const f32x4*)(z + 1024 + sub * 64 + 4 * d4);
              const float rs = rsqrtf(reduce16(dot4(x)) * (1.f / 64.f) + 1e-6f);
              x = x * rs * gk;
              f32x4 xo; xo.x = dppf<0x128>(x.x); xo.y = dppf<0x128>(x.y); xo.z = dppf<0x128>(x.z); xo.w = dppf<0x128>(x.w);
              x = x * cs - xo * sn;
              u32x2 w; w.x = pk2(x.x, x.y); w.y = pk2(x.z, x.w); *(u32x2*)(KG + (((size_t)b * 4 + sub) * TA + s) * 64 + 4 * d4) = w;
              const f32x4 vx = *(const f32x4*)(z + 1280 + sub * 64 + 4 * d4);
              w.x = pk2(vx.x, vx.y); w.y = pk2(vx.z, vx.w); *(LAS u32x2*)(scr + (sub * 8 + rr) * 128 + 8 * d4) = w; }
        }
#pragma unroll
        for (int hh = 0; hh < 4; ++hh) {
            unsigned short t8[8];
#pragma unroll
            for (int rr = 0; rr < 8; ++rr) t8[rr] = *(const LAS unsigned short*)(scr + (hh * 8 + rr) * 128 + 2 * lane);
            u32x4 w; w.x = t8[0] | ((unsigned)t8[1] << 16); w.y = t8[2] | ((unsigned)t8[3] << 16); w.z = t8[4] | ((unsigned)t8[5] << 16); w.w = t8[6] | ((unsigned)t8[7] << 16);
            *(u32x4*)(VGT + (((size_t)b * 4 + hh) * 64 + lane) * TA + s0) = w;
        }
    }
}
__device__ __forceinline__ void ph_attn_gqa(Fr& F) {
    const Ptrs& P = F.P;
    const int x = F.blk & 7, j = F.blk >> 3;
    const float c = 0.125f * 1.4426950408889634f;
    for (int rd = 0; ; ++rd) {
        int pair, qblk;
        if (F.nblk == 256) { if (rd >= 4) break; pair = rd * 4 + (x >> 1); qblk = 32 * (x & 1) + j; }
        else { const int u = rd * F.nblk + F.blk; if (u >= 1024) break; pair = u >> 6; qblk = u & 63; }
        const int b = pair >> 2, kh = pair & 3, head = kh * 4 + (F.wave >> 1);
        const int qpos = qblk * 64 + 32 * (F.wave & 1) + (F.lane & 31);
        const int a0 = qblk - 2 < 0 ? 0 : qblk - 2, a1 = qblk + 3 > 64 ? 64 : qblk + 3;
        attn_unit<64, true>((LAS unsigned char*)F.lds, WSP(bf16, WS_QG) + (((size_t)b * 16 + head) * SEQ + qpos) * 64, WSP(bf16, WS_KG) + ((size_t)b * 4 + kh) * TA * 64,
                            WSP(bf16, WS_VG) + ((size_t)b * 4 + kh) * 64 * TA, a0, a1, 64, 68, c, qpos, qblk, P.in[25][head] * 1.4426950408889634f,
                            WSP(bf16, WS_YM) + ((size_t)b * SEQ + qpos) * D + head * 64, F.tid, F.lane);
    }
}

__device__ __forceinline__ void ph_router(Fr& F, int layer, int nrows, int dummy = 0) {
    const Ptrs& P = F.P; const int lane = F.lane;
    const float* MOD = WSP(float, WS_MOD); const float* X1 = WSP(float, WS_X1);
    { const f32x4* src = (const f32x4*)(WSP(float, WS_WRT) + (size_t)layer * 32 * 1024); LAS f32x4* dst = (LAS f32x4*)F.lds;
#pragma unroll 4
      for (int i = 0; i < 16; ++i) dst[F.tid + NTHR * i] = src[F.tid + NTHR * i];
      __syncthreads(); }
    const LAS float* wl = (const LAS float*)F.lds;
    int* cnt = (int*)(P.ws + WS_CTL + CW_CNT) + layer * NE + (dummy ? 64 : 0);
    unsigned char* const wsd = P.ws + (dummy ? (WS_XF - WS_F) : 0);
    LAS int* lcnt = (LAS int*)((LAS unsigned char*)F.lds + LDS_MISC + 4096); LAS int* lbase = lcnt + 32;
    LAS int* rec = (LAS int*)((LAS unsigned char*)F.lds + LDS_MISC + 4608) + F.wave * 80;
    if (F.tid < 32) lcnt[F.tid] = 0;
    __syncthreads();
    const int e8 = ((lane >> 5) & 1) * 4 + ((lane >> 4) & 1) * 2 + ((lane >> 3) & 1);
    int it = 0;
    for (int r0 = F.gw * 2; r0 < nrows; r0 += F.ngw * 2, ++it) {
        RowV v[2];
#pragma unroll
        for (int rr = 0; rr < 2; ++rr) { v[rr] = load_row(X1 + (size_t)(r0 + rr) * D, lane);
            const float* m = MOD + (size_t)(layer * 5 + mod_row(r0 + rr)) * 6144;
            norm_mod(v[rr], P.in[7] + layer * D, m + 4 * 1024, m + 3 * 1024, lane);
            { unsigned* f8 = (unsigned*)(wsd + WS_F + (size_t)(r0 + rr) * D) + lane;
#pragma unroll
              for (int j = 0; j < 4; ++j) f8[64 * j] = pk4_fp8(v[rr].v[j].x, v[rr].v[j].y, v[rr].v[j].z, v[rr].v[j].w); } }
        float lg[2][4];
        int zoff = 0; asm volatile("" : "+v"(zoff));
#pragma unroll
        for (int grp = 0; grp < 4; ++grp) {
            float acc[2][8];
#pragma unroll
            for (int e = 0; e < 8; ++e) { const LAS f32x4* w = (const LAS f32x4*)(wl + (grp * 8 + e) * 1024) + lane + zoff;
                const f32x4 w0 = w[0], w1 = w[64], w2 = w[128], w3 = w[192];
#pragma unroll
                for (int rr = 0; rr < 2; ++rr) { const f32x4 p = v[rr].v[0] * w0 + v[rr].v[1] * w1 + v[rr].v[2] * w2 + v[rr].v[3] * w3; acc[rr][e] = (p.x + p.y) + (p.z + p.w); }
                if ((e & 3) == 3) asm volatile("" : "+v"(zoff) : "v"(acc[1][e])); }
            const float bias = P.in[28][layer * NE + grp * 8 + e8];
#pragma unroll
            for (int rr = 0; rr < 2; ++rr) {
                float (&a)[8] = acc[rr];
#pragma unroll
                for (int i = 0; i < 4; ++i) { const bool hi = lane & 32; const float send = hi ? a[i] : a[i + 4], keep = hi ? a[i + 4] : a[i]; a[i] = keep + __shfl_xor(send, 32); }
#pragma unroll
                for (int i = 0; i < 2; ++i) { const bool hi = lane & 16; const float send = hi ? a[i] : a[i + 2], keep = hi ? a[i + 2] : a[i]; a[i] = keep + __shfl_xor(send, 16); }
                { const bool hi = lane & 8; const float send = hi ? a[0] : a[1], keep = hi ? a[1] : a[0]; a[0] = keep + dppf<0x128>(send); }
                float t = a[0]; t += dppf<0xB1>(t); t += dppf<0x4E>(t); t += dppf<0x141>(t);
                lg[rr][grp] = t + bias;
            }
        }
#pragma unroll
        for (int rr = 0; rr < 2; ++rr) {
            float c[4] = {lg[rr][0], lg[rr][1], lg[rr][2], lg[rr][3]};
            int te[4]; float tv[4];
#pragma unroll
            for (int k = 0; k < 4; ++k) {
                float bv = c[0]; int bi = e8;
#pragma unroll
                for (int g = 1; g < 4; ++g) { const bool take = c[g] > bv; bv = take ? c[g] : bv; bi = take ? 8 * g + e8 : bi; }
#pragma unroll
                for (int o = 8; o < 64; o <<= 1) { const float ov = __shfl_xor(bv, o); const int oi = __shfl_xor(bi, o); const bool take = ov > bv || (ov == bv && oi < bi); bv = take ? ov : bv; bi = take ? oi : bi; }
                te[k] = bi; tv[k] = bv;
#pragma unroll
                for (int g = 0; g < 4; ++g) c[g] = (bi == 8 * g + e8) ? -3.4e38f : c[g]; }
            const float e1 = __expf(tv[1] - tv[0]), e2 = __expf(tv[2] - tv[0]), e3 = __expf(tv[3] - tv[0]); const float inv = 1.f / (1.f + e1 + e2 + e3);
            if (lane < 4) { const int e = lane == 0 ? te[0] : lane == 1 ? te[1] : lane == 2 ? te[2] : te[3]; const float g = (lane == 0 ? 1.f : lane == 1 ? e1 : lane == 2 ? e2 : e3) * inv;
                const int rank = __hip_atomic_fetch_add(lcnt + e, 1, __ATOMIC_RELAXED, __HIP_MEMORY_SCOPE_WORKGROUP);
                rec[((it * 2 + rr) * 4 + lane) * 2] = e | (rank << 8); rec[((it * 2 + rr) * 4 + lane) * 2 + 1] = __float_as_int(g); }
        }
    }
    __syncthreads();
    if (F.tid < 32) lbase[F.tid] = atomicAdd(&cnt[F.tid], lcnt[F.tid]);
    __syncthreads();
    it = 0;
    for (int r0 = F.gw * 2; r0 < nrows; r0 += F.ngw * 2, ++it) {
        if (lane < 8) { const int rr = lane >> 2, k = lane & 3, r = r0 + rr; const int er = rec[((it * 2 + rr) * 4 + k) * 2]; const int e = er & 255, slot = lbase[e] + (er >> 8);
            ((int*)(wsd + WS_TOK))[(size_t)e * NT + slot] = r;
            ((int*)(wsd + WS_PE))[r * 4 + k] = e; ((int*)(wsd + WS_PS))[r * 4 + k] = slot; ((int*)(wsd + WS_PG))[r * 4 + k] = rec[((it * 2 + rr) * 4 + k) * 2 + 1]; }
    }
}
template <int MODE>
__device__ __forceinline__ void ph_combine(Fr& F, int layer, int nrows) {
    const Ptrs& P = F.P; const int lane = F.lane;
    moe_prefix(F, layer);
    const int* pre = (const int*)(F.lds + LDS_MISC + 64);
    const float* MOD = WSP(float, WS_MOD); const float* X1 = WSP(float, WS_X1); const bf16* Y = WSP(bf16, WS_Y);
    for (int r = F.gw; r < nrows; r += F.ngw) {
        RowV v = load_row(X1 + (size_t)r * D, lane);
        const float* g2 = MOD + (size_t)(layer * 5 + mod_row(r)) * 6144 + 5 * 1024;
        RowV acc;
#pragma unroll
        for (int j = 0; j < 4; ++j) acc.v[j] = (f32x4){0.f, 0.f, 0.f, 0.f};
#pragma unroll
        for (int k = 0; k < 4; ++k) { const int e = WSP(int, WS_PE)[r * 4 + k], slot = WSP(int, WS_PS)[r * 4 + k]; const float g = WSP(float, WS_PG)[r * 4 + k];
            const u32x2* y = (const u32x2*)(Y + ((size_t)pre[e] * 256 + slot) * D) + lane;
#pragma unroll
            for (int j = 0; j < 4; ++j) { const u32x2 w = y[64 * j]; acc.v[j] += (f32x4){bflo(w.x), bfhi(w.x), bflo(w.y), bfhi(w.y)} * g; } }
#pragma unroll
        for (int j = 0; j < 4; ++j) v.v[j] += ((const f32x4*)g2)[lane + 64 * j] * acc.v[j];
        if (MODE == 0) {
            f32x4* xo = (f32x4*)(WSP(float, WS_X2) + (size_t)r * D) + lane;
#pragma unroll
            for (int j = 0; j < 4; ++j) xo[64 * j] = v.v[j];
            const float* m = MOD + (size_t)(1 * 5 + mod_row(r)) * 6144;
            norm_mod(v, P.in[6] + D, m + 1024, m, lane);
            store_row_bf16(WSP(bf16, WS_HN) + (size_t)r * D, v, lane);
        } else {
            f32x4* xo = (f32x4*)(P.out + (size_t)r * D) + lane;
#pragma unroll
            for (int j = 0; j < 4; ++j) xo[64 * j] = v.v[j];
        }
    }
}

constexpr int NPHASE = 20;
struct Args { Ptrs P; int ph_lo, ph_hi, bar_idx, variant; };
__global__ void __launch_bounds__(NTHR, 2) mk_fwd(Args args) {
    extern __shared__ __attribute__((aligned(16))) unsigned char lds[];
    Fr F; F.P = args.P; F.lds = lds;
    F.tid = threadIdx.x; F.lane = F.tid & 63; F.wave = __builtin_amdgcn_readfirstlane(F.tid >> 6);
    F.nblk = gridDim.x; F.blk = blockIdx.x; F.gw = F.blk * NWAVES + F.wave; F.ngw = F.nblk * NWAVES;
    F.gtid = (size_t)F.blk * NTHR + F.tid; F.gsz = (size_t)F.nblk * NTHR;
    const Ptrs& P = F.P;
    if (F.tid < 64) ((unsigned*)(lds + LDS_MISC))[F.tid] = 0u;
    __syncthreads();
    const int lo = args.ph_lo, hi = args.ph_hi;
    unsigned* barw = (unsigned*)(P.ws + WS_CTL) + args.bar_idx * XCD_BAR_WORDS;
    XcdBarrier bar; bar.bar = barw; bar.x = 0; bar.st = nullptr;
    if (hi - lo > 1) bar = xcd_barrier_post(barw, (volatile LAS unsigned*)(lds + LDS_MISC));
#ifndef PROBE_MASK
#define PROBE_MASK 0u
#endif
#define IN(k) (lo <= (k) && (k) < hi)
#define REP(k) for (int _rep = 0; _rep < (((PROBE_MASK >> (k)) & 1u) ? 2 : 1); ++_rep)
#define SEAM(k) do { if (IN(k) && IN((k) + 1)) xcd_barrier(bar); } while (0)
    const float* MOD = WSP(float, WS_MOD);
    if (IN(0)) REP(0) { ph_prologue(F); } if (IN(0)) conv_fill<0>(F); SEAM(0);
    if (IN(1)) REP(1) { ph_norm0(F); } SEAM(1);
    if (IN(2)) REP(2) { ph_gemm(F, WSP(bf16, WS_HN), 1024, WSP(bf16, WS_WIN), 1024, NT, 1536, 1024, GF32{EpiF32{WSP(float, WS_Z), ZLD, EVEN_IN}}); } if (IN(2)) conv_fill<2>(F); SEAM(2);
    if (IN(3)) { REP(20) { ph_e3(F); } REP(21) { ph_lru<0>(F); } } if (IN(3)) conv_fill<3>(F); SEAM(3);
    if (IN(4)) REP(4) { ph_gemm(F, WSP(bf16, WS_QKVN), 384, WSP(bf16, WS_WQKVB), 384, NT, 1792, 384, GF32{EpiF32{WSP(float, WS_QKVR), 1792, 1792}}); ph_lru_carry(F); } SEAM(4);
    if (IN(5)) { REP(22) { ph_lru<1>(F); } REP(23) { ph_e5(F); } } if (IN(5)) conv_fill<5>(F); SEAM(5);
    if (IN(6)) REP(6) { ph_attn_mla(F); } SEAM(6);
    if (IN(7)) REP(7) { ph_gemm(F, WSP(bf16, WS_YM), 1024, WSP(bf16, WS_WOE), 1024, NT, 1024, 1024, GResid{P.in[0], P.in[2], WSP(float, WS_X1), MOD + 2 * 1024}); } if (IN(7)) conv_fill<7>(F); SEAM(7);
    if (IN(8)) REP(8) { ph_router(F, 0, NT, args.variant); } SEAM(8);
    if (IN(9)) REP(9) { ph_moe_gemm<1>(F, 0, args.variant); } SEAM(9);
    if (IN(10)) REP(10) { ph_moe_gemm<2>(F, 0, args.variant); } if (IN(10)) conv_fill<10>(F); SEAM(10);
    if (IN(11)) REP(11) { ph_combine<0>(F, 0, NT); } if (IN(11)) conv_fill<11>(F); SEAM(11);
    if (IN(12)) REP(12) { ph_gemm(F, WSP(bf16, WS_HN), 1024, WSP(bf16, WS_WQO), 1024, NT, 1536, 1024, GF32{EpiF32{WSP(float, WS_Z), ZLD, 1536}}); } if (IN(12)) conv_fill<12>(F); SEAM(12);
    if (IN(13)) REP(13) { ph_oprep(F); } SEAM(13);
    if (IN(14)) REP(14) { ph_attn_gqa(F); } SEAM(14);
    if (IN(15)) REP(15) { ph_gemm(F, WSP(bf16, WS_YM), 1024, WSP(bf16, WS_WOO), 1024, NL, 1024, 1024, GResid{WSP(float, WS_X2), WSP(float, WS_X2) + (size_t)NL * D, WSP(float, WS_X1), MOD + 5 * 6144 + 2 * 1024}); } SEAM(15);
    if (IN(16)) REP(16) { ph_router(F, 1, NL, args.variant); } SEAM(16);
    if (IN(17)) REP(17) { ph_moe_gemm<1>(F, 1); } SEAM(17);
    if (IN(18)) REP(18) { ph_moe_gemm<2>(F, 1); } SEAM(18);
    if (IN(19)) REP(19) { ph_combine<1>(F, 1, NL); }
#undef IN
#undef SEAM
}

#ifndef MK_N_LAUNCHES
#define MK_N_LAUNCHES 1
#endif
extern "C" void kernel_launch(void* const* d_in, const int* in_sizes, int n_in, void* d_out, int out_size, void* d_ws, size_t ws_size, hipStream_t stream) {
    static int grid = 0;
    if (grid == 0) {
        if (n_in != 33 || ws_size < WS_END) { fprintf(stderr, "kernel_launch: unexpected n_in %d or ws_size %zu < %zu\n", n_in, ws_size, (size_t)WS_END); grid = -1; return; }
        int dev = 0, cus = 0, per_cu = 0;
        if (hipGetDevice(&dev) != hipSuccess || hipDeviceGetAttribute(&cus, hipDeviceAttributeMultiprocessorCount, dev) != hipSuccess) { grid = -1; return; }
        if (hipFuncSetAttribute((const void*)mk_fwd, hipFuncAttributeMaxDynamicSharedMemorySize, LDS_BYTES) != hipSuccess) { fprintf(stderr, "kernel_launch: hipFuncSetAttribute failed\n"); grid = -1; return; }
        if (hipOccupancyMaxActiveBlocksPerMultiprocessor(&per_cu, (const void*)mk_fwd, NTHR, LDS_BYTES) != hipSuccess || per_cu < 1) { fprintf(stderr, "kernel_launch: occupancy query says %d blocks per CU\n", per_cu); grid = -1; return; }
        (void)hipGetLastError();
        grid = cus;
    }
    if (grid < 0) return;
    Args a{};
    for (int i = 0; i < 33; ++i) a.P.in[i] = (const float*)d_in[i];
    a.P.out = (float*)d_out; a.P.ws = (unsigned char*)d_ws;
    (void)hipMemsetAsync((unsigned char*)d_ws + WS_CTL, 0, CTL_BYTES, stream);
    a.bar_idx = 0; a.variant = 0;
#if defined(PROBE_PHASE)
    { const int k = PROBE_PHASE; a.ph_lo = 0; a.ph_hi = k; a.bar_idx = 0; hipLaunchKernelGGL(mk_fwd, dim3(grid), dim3(NTHR), LDS_BYTES, stream, a);
      for (int r = 0; r < PROBE_REPEAT; ++r) { a.ph_lo = k; a.ph_hi = k + 1; a.bar_idx = 2; a.variant = PROBE_VARIANT; hipLaunchKernelGGL(mk_fwd, dim3(grid), dim3(NTHR), LDS_BYTES, stream, a); }
      a.variant = 0; a.ph_lo = k; a.ph_hi = NPHASE; a.bar_idx = 1; hipLaunchKernelGGL(mk_fwd, dim3(grid), dim3(NTHR), LDS_BYTES, stream, a); }
#else
    a.ph_lo = 0; a.ph_hi = NPHASE; hipLaunchKernelGGL(mk_fwd, dim3(grid), dim3(NTHR), LDS_BYTES, stream, a);
#endif
}
```

```cpp
#include <hip/hip_runtime.h>
#include <stdint.h>
#include <stdio.h>

typedef unsigned short bf16;
typedef short bf16x8 __attribute__((ext_vector_type(8)));
typedef float f32x4 __attribute__((ext_vector_type(4)));
typedef float f32x16 __attribute__((ext_vector_type(16)));
typedef unsigned u32x2 __attribute__((ext_vector_type(2)));
typedef unsigned u32x4 __attribute__((ext_vector_type(4)));
typedef int i32x8 __attribute__((ext_vector_type(8)));
typedef int i32x4 __attribute__((ext_vector_type(4)));

constexpr int D = 1024, NB = 4, SEQ = 4096, CTX = 256;
constexpr int NL = NB * SEQ, NC = NB * CTX, NT = NL + NC;
constexpr int TA = SEQ + CTX;
constexpr int NE = 32, TOPK = 4;
constexpr int EVEN_IN = 1440, ZLD = 1536;
constexpr int MAXT256 = 304;
constexpr int ACT_ROWS = MAXT256 * 256;

constexpr size_t al256(size_t x) { return (x + 255) & ~(size_t)255; }
constexpr size_t WS_CTL = 0, CTL_BYTES = 128u << 10;
constexpr size_t CW_CNT = 65536;
constexpr size_t WS_MOD = WS_CTL + CTL_BYTES;
constexpr size_t WS_ROPEM = al256(WS_MOD + 2 * 5 * 6144 * 4);
constexpr size_t WS_ROPEG = al256(WS_ROPEM + 4096 * 16 * 2 * 4);
constexpr size_t WS_WRT = al256(WS_ROPEG + 4096 * 32 * 2 * 4);
constexpr size_t WS_WRI = al256(WS_WRT + 2 * 32 * 1024 * 4);
constexpr size_t WS_WIN = al256(WS_WRI + 2 * 8 * 128 * 64 * 2);
constexpr size_t WS_WQKVB = al256(WS_WIN + 1536 * 1024 * 2);
constexpr size_t WS_WOE = al256(WS_WQKVB + 1792 * 384 * 2);
constexpr size_t WS_WQO = al256(WS_WOE + 1024 * 1024 * 2);
constexpr size_t WS_WOO = al256(WS_WQO + 1536 * 1024 * 2);
constexpr size_t WS_WGU = al256(WS_WOO + 1024 * 1024 * 2);
constexpr size_t WS_WDN = al256(WS_WGU + (size_t)2 * 32 * 2048 * 1024 * 2);
constexpr size_t WS_HN = al256(WS_WDN + (size_t)2 * 32 * 1024 * 1024 * 2);
constexpr size_t WS_Z = al256(WS_HN + (size_t)NT * D * 2);
constexpr size_t WS_QKVN = al256(WS_Z + (size_t)NT * ZLD * 4);
constexpr size_t WS_QKVR = al256(WS_QKVN + (size_t)NT * 384 * 2);
constexpr size_t WS_QM = al256(WS_QKVR + (size_t)NT * 1792 * 4);
constexpr size_t WS_KM = al256(WS_QM + (size_t)NB * 8 * TA * 96 * 2);
constexpr size_t WS_VM = al256(WS_KM + (size_t)NB * 8 * TA * 96 * 2);
constexpr size_t WS_QG = al256(WS_VM + (size_t)NB * 8 * TA * 64 * 2);
constexpr size_t WS_KG = al256(WS_QG + (size_t)NB * 16 * SEQ * 64 * 2);
constexpr size_t WS_VG = al256(WS_KG + (size_t)NB * 4 * TA * 64 * 2);
constexpr size_t WS_YM = al256(WS_VG + (size_t)NB * 4 * TA * 64 * 2);
constexpr size_t WS_X1 = al256(WS_YM + (size_t)NT * D * 2);
constexpr size_t WS_X2 = al256(WS_X1 + (size_t)NT * D * 4);
constexpr size_t WS_F = al256(WS_X2 + (size_t)NT * D * 4);
constexpr size_t WS_LA = al256(WS_F + (size_t)NT * D * 2);
constexpr size_t WS_LB = al256(WS_LA + (size_t)2 * NT * 512 * 4);
constexpr size_t WS_LH = al256(WS_LB + (size_t)2 * NT * 512 * 4);
constexpr size_t WS_XF = al256(WS_LH + (size_t)2 * NT * 512 * 4);
constexpr size_t WS_PE = al256(WS_XF + (size_t)2 * NT * 512 * 4);
constexpr size_t WS_PS = al256(WS_PE + (size_t)NT * 4 * 4);
constexpr size_t WS_PG = al256(WS_PS + (size_t)NT * 4 * 4);
constexpr size_t WS_TOK = al256(WS_PG + (size_t)NT * 4 * 4);
constexpr size_t WS_ACT = al256(WS_TOK + (size_t)NE * NT * 4);
constexpr size_t WS_Y = al256(WS_ACT + (size_t)ACT_ROWS * D * 2);
constexpr size_t WS_END = al256(WS_Y + (size_t)ACT_ROWS * D * 2);

__device__ __forceinline__ unsigned f2bf(float f) { unsigned u = __float_as_uint(f); u += 0x7FFFu + ((u >> 16) & 1u); return u >> 16; }
typedef float f32x2_t __attribute__((ext_vector_type(2)));
typedef __bf16 bf16x2_t __attribute__((ext_vector_type(2)));
__device__ __forceinline__ unsigned pk2(float a, float b) { const f32x2_t v = {a, b}; return __builtin_bit_cast(unsigned, __builtin_convertvector(v, bf16x2_t)); }

__device__ __forceinline__ unsigned pk4_fp8(float a, float b, float c, float d) { unsigned w = 0; w = __builtin_amdgcn_cvt_pk_fp8_f32(a, b, w, false); w = __builtin_amdgcn_cvt_pk_fp8_f32(c, d, w, true); return w; }
__device__ __forceinline__ float bf2f(unsigned b) { return __uint_as_float(b << 16); }
__device__ __forceinline__ float bflo(unsigned u) { return __uint_as_float(u << 16); }
__device__ __forceinline__ float bfhi(unsigned u) { return __uint_as_float(u & 0xffff0000u); }
__device__ __forceinline__ float wave_sum(float v) {
#pragma unroll
    for (int o = 1; o < 64; o <<= 1) v += __shfl_xor(v, o);
    return v;
}

template <int CTRL> __device__ __forceinline__ float dppf(float v) { return __int_as_float(__builtin_amdgcn_update_dpp(0, __float_as_int(v), CTRL, 0xf, 0xf, true)); }
__device__ __forceinline__ float reduce16(float v) { v += dppf<0xB1>(v); v += dppf<0x4E>(v); v += dppf<0x124>(v); v += dppf<0x128>(v); return v; }
__device__ __forceinline__ float dot4(f32x4 a) { return a.x * a.x + a.y * a.y + a.z * a.z + a.w * a.w; }
__device__ __forceinline__ float sigmoidf_(float x) { return 1.f / (1.f + __expf(-x)); }
__device__ __forceinline__ float gelu_tanh(float x) { const float u = 0.7978845608028654f * (x + 0.044715f * x * x * x); return 0.5f * x * (1.f + tanhf(u)); }
__device__ __forceinline__ int mod_row(int r) { return r < NL ? (r >> 12) : 4; }
__device__ __forceinline__ void row_bs(int r, int& b, int& s) { if (r < NL) { b = r >> 12; s = r & 4095; } else { const int rc = r - NL; b = rc >> 8; s = SEQ + (rc & 255); } }


struct Ptrs {
    const float* in[33];
    float* out;
    unsigned char* ws;
};
#define WSP(T, off) ((T*)(P.ws + (off)))
#define LAS __attribute__((address_space(3)))

#define XB_TMO      128
#define XB_XCNT(j)  (256  + 64 * (j))
#define XB_XSUB(j)  (1280 + 64 * (j))
#define XB_XGEN(j)  (2304 + 64 * (j))
#define XB_TOP      3328
#define XB_TOPGEN   3392
#define XCD_BAR_WORDS 3456
#define XB_SPIN_CAP (1u << 18)
__device__ __forceinline__ unsigned xb_ld(unsigned* p)              { return __hip_atomic_load(p, __ATOMIC_RELAXED, __HIP_MEMORY_SCOPE_AGENT); }
__device__ __forceinline__ unsigned xb_add(unsigned* p, unsigned v) { return __hip_atomic_fetch_add(p, v, __ATOMIC_RELAXED, __HIP_MEMORY_SCOPE_AGENT); }
__device__ __forceinline__ unsigned xb_xcc_id() { return (unsigned)__builtin_amdgcn_s_getreg((3 << 11) | 20) & 0xFu; }
#define XB_SPIN(cond, bar) do { unsigned _sp = 0; while (cond) { __builtin_amdgcn_s_sleep(1); \
    if ((++_sp & 255u) == 0u) { if (xb_ld(&(bar)[XB_TMO])) break; if (_sp > XB_SPIN_CAP) { atomicAdd(&(bar)[XB_TMO], 1u); break; } } } } while (0)
struct XcdBarrier { unsigned* bar; unsigned x; volatile LAS unsigned* st; };
__device__ __forceinline__ XcdBarrier xcd_barrier_post(unsigned* bar, volatile LAS unsigned* st) {
    XcdBarrier b; b.bar = bar; b.x = xb_xcc_id(); b.st = st;
    if (threadIdx.x == 0) (void)xb_add(&bar[XB_XCNT(b.x)], 1u);
    return b;
}
__device__ __forceinline__ void xcd_barrier_complete(unsigned* bar, unsigned x, unsigned& nloc, unsigned& nx) {
    const unsigned G = gridDim.x * gridDim.y * gridDim.z;
    unsigned sum, cnt, mine, sp = 0u;
    for (;;) {
        sum = 0u; cnt = 0u; mine = 0u;
#pragma unroll
        for (unsigned j = 0; j < 16; ++j) { const unsigned c = xb_ld(&bar[XB_XCNT(j)]); sum += c; cnt += (c > 0u) ? 1u : 0u; mine = (j == x) ? c : mine; }
        if (sum == G) break;
        __builtin_amdgcn_s_sleep(1);
        if ((++sp & 255u) == 0u) { if (xb_ld(&bar[XB_TMO])) break; if (sp > XB_SPIN_CAP) { atomicAdd(&bar[XB_TMO], 1u); break; } }
    }
    nloc = mine > 0u ? mine : 1u; nx = cnt > 0u ? cnt : 1u;
}
__device__ __forceinline__ void xcd_barrier(const XcdBarrier& b) {
    asm volatile("s_waitcnt vmcnt(0)" ::: "memory");
    __syncthreads();
    if (threadIdx.x == 0) {
        unsigned* bar = b.bar;
        __builtin_amdgcn_s_waitcnt(0);
        unsigned nloc = b.st[0], nx = b.st[1];
        if (nloc == 0u) { xcd_barrier_complete(bar, b.x, nloc, nx); b.st[0] = nloc; b.st[1] = nx; }
        const unsigned old = xb_add(&bar[XB_XSUB(b.x)], 1u);
        const unsigned gen = old / nloc;
        if (old + 1u == (gen + 1u) * nloc) {
            __builtin_amdgcn_fence(__ATOMIC_RELEASE, "agent");
            asm volatile("s_waitcnt vmcnt(0)" ::: "memory");
            const unsigned og = xb_add(&bar[XB_TOP], 1u);
            const unsigned tg = og / nx;
            if (og + 1u == (tg + 1u) * nx) xb_add(&bar[XB_TOPGEN], 1u);
            else XB_SPIN(xb_ld(&bar[XB_TOPGEN]) == tg, bar);
            __builtin_amdgcn_fence(__ATOMIC_ACQUIRE, "agent");
            xb_add(&bar[XB_XGEN(b.x)], 1u);
            asm volatile("s_waitcnt vmcnt(0)" ::: "memory");
        } else {
            XB_SPIN(xb_ld(&bar[XB_XGEN(b.x)]) == gen, bar);
            __builtin_amdgcn_fence(__ATOMIC_ACQUIRE, "agent");
            asm volatile("s_waitcnt vmcnt(0)" ::: "memory");
        }
    }
    __syncthreads();
}

constexpr int NTHR = 512, NWAVES = 8;
constexpr int LRU_ST = 16, LRU_NST = 64 / LRU_ST;
constexpr int LRU_AT = LRU_ST * 144, LRU_GT = LRU_ST * 272, LRU_HT = 64 * 128, LRU_WB = LRU_AT + LRU_GT + LRU_HT;

constexpr int LDS_RING = 131072;
constexpr int LDS_MISC = LDS_RING;
constexpr int LDS_BYTES = LDS_RING + 8192;
struct Fr {
    Ptrs P; unsigned char* lds;
    int tid, lane, wave, gw, ngw, nblk, blk; size_t gtid, gsz;
};

__device__ __forceinline__ void transpose_item(const float* W, int ldw, bf16* WT, int ldt, int k0, int n0, int row_off, int col_off, int map, float* scr, int lane) {
#pragma unroll 8
    for (int i = 0; i < 32; ++i) { const int kk = 2 * i + (lane >> 5); scr[kk * 33 + (lane & 31)] = W[(size_t)(k0 + kk) * ldw + n0 + (lane & 31)]; }
    __builtin_amdgcn_s_waitcnt(0xc07f); asm volatile("" ::: "memory");
    const int c = lane & 7;
#pragma unroll
    for (int j = 0; j < 4; ++j) { const int n = (lane >> 3) + 8 * j; const float* s = scr + (8 * c) * 33 + n;
        u32x4 o; o.x = pk2(s[0 * 33], s[1 * 33]); o.y = pk2(s[2 * 33], s[3 * 33]); o.z = pk2(s[4 * 33], s[5 * 33]); o.w = pk2(s[6 * 33], s[7 * 33]);
        int nn = n0 + n;
        if (map & 1) { const int up = nn >= 1024, jj = nn & 1023; nn = (jj >> 4) * 32 + up * 16 + (jj & 15); }
        if (map & 2) { u32x2 o8; o8.x = pk4_fp8(s[0 * 33] * 64.f, s[1 * 33] * 64.f, s[2 * 33] * 64.f, s[3 * 33] * 64.f); o8.y = pk4_fp8(s[4 * 33] * 64.f, s[5 * 33] * 64.f, s[6 * 33] * 64.f, s[7 * 33] * 64.f);
            *(u32x2*)((unsigned char*)WT + (size_t)(row_off + nn) * ldt + col_off + k0 + 8 * c) = o8; }
        else *(u32x4*)(WT + (size_t)(row_off + nn) * ldt + col_off + k0 + 8 * c) = o; }
    __builtin_amdgcn_s_waitcnt(0xc07f); asm volatile("" ::: "memory");
}
struct TJob { const float* W; bf16* WT; int K, N, ldw, ldt, row_off, col_off, map; long wstride, tstride; int count; };
constexpr int NJOBS = 8;
__device__ __forceinline__ TJob get_job(const Ptrs& P, int j) {
    TJob t; t.row_off = 0; t.col_off = 0; t.map = 0; t.wstride = 0; t.tstride = 0; t.count = 1;
    switch (j) {
    case 0: t.W = P.in[29]; t.WT = WSP(bf16, WS_WGU); t.K = 1024; t.N = 2048; t.ldw = 2048; t.ldt = 1024; t.map = 3; t.wstride = (long)1024 * 2048; t.tstride = (long)2048 * 1024 / 2; t.count = 64; break;
    case 1: t.W = P.in[31]; t.WT = WSP(bf16, WS_WDN); t.K = 1024; t.N = 1024; t.ldw = 1024; t.ldt = 1024; t.map = 2; t.wstride = (long)1024 * 1024; t.tstride = (long)1024 * 1024 / 2; t.count = 64; break;
    case 2: t.W = P.in[8]; t.WT = WSP(bf16, WS_WIN); t.K = 1024; t.N = 1440; t.ldw = 1440; t.ldt = 1024; break;
    case 3: t.W = P.in[17]; t.WT = WSP(bf16, WS_WQKVB); t.K = 256; t.N = 768; t.ldw = 768; t.ldt = 384; break;
    case 4: t.W = P.in[19]; t.WT = WSP(bf16, WS_WQKVB); t.K = 128; t.N = 1024; t.ldw = 1024; t.ldt = 384; t.row_off = 768; t.col_off = 256; break;
    case 5: t.W = P.in[22]; t.WT = WSP(bf16, WS_WOE); t.K = 1024; t.N = 1024; t.ldw = 1024; t.ldt = 1024; break;
    case 6: t.W = P.in[23]; t.WT = WSP(bf16, WS_WQO); t.K = 1024; t.N = 1536; t.ldw = 1536; t.ldt = 1024; break;
    default: t.W = P.in[26]; t.WT = WSP(bf16, WS_WOO); t.K = 1024; t.N = 1024; t.ldw = 1024; t.ldt = 1024; break;
    }
    return t;
}

constexpr int Q_ITEMS_L = 32 * 64 * 16 + 32 * 32 * 16, Q_ITEMS = 2 * Q_ITEMS_L;
struct CItem { const float* W; unsigned char* WT; int ldw, k0, n0, map; };
__device__ __forceinline__ CItem conv_decode(const Ptrs& P, int id) {
    CItem c; const int layer = id / Q_ITEMS_L, r = id % Q_ITEMS_L;
    if (r < 32768) { const int m = layer * 32 + (r >> 10), q = r & 1023; c.W = P.in[29] + (size_t)m * 1024 * 2048; c.WT = P.ws + WS_WGU + (size_t)m * 2048 * 1024; c.ldw = 2048; c.n0 = (q >> 4) * 32; c.k0 = (q & 15) * 64; c.map = 1; }
    else { const int r2 = r - 32768; const int m = layer * 32 + (r2 >> 9), q = r2 & 511; c.W = P.in[31] + (size_t)m * 1024 * 1024; c.WT = P.ws + WS_WDN + (size_t)m * 1024 * 1024; c.ldw = 1024; c.n0 = (q >> 4) * 32; c.k0 = (q & 15) * 64; c.map = 0; }
    return c;
}
__device__ __forceinline__ void conv_load(const CItem& c, float (&v)[32], int lane) {
#pragma unroll
    for (int i = 0; i < 32; ++i) v[i] = c.W[(size_t)(c.k0 + 2 * i + (lane >> 5)) * c.ldw + c.n0 + (lane & 31)];
}
__device__ __forceinline__ void conv_finish(const CItem& c, const float (&v)[32], float* scr, int lane) {
#pragma unroll
    for (int i = 0; i < 32; ++i) scr[(2 * i + (lane >> 5)) * 33 + (lane & 31)] = v[i];
    __builtin_amdgcn_s_waitcnt(0xc07f); asm volatile("" ::: "memory");
    const int cc = lane & 7;
#pragma unroll
    for (int j = 0; j < 4; ++j) { const int n = (lane >> 3) + 8 * j; const float* s = scr + (8 * cc) * 33 + n;
        int nn = c.n0 + n;
        if (c.map & 1) { const int up = nn >= 1024, jj = nn & 1023, jl = jj & 127, q = jl >> 3;
            nn = (jj >> 7) * 256 + ((jl >> 2) & 1) * 128 + (q >> 2) * 32 + up * 16 + (q & 3) * 4 + (jl & 3); }
        else { const int cl = nn & 255;
            nn = (nn & ~255) + (cl & 0xE0) + ((cl >> 2) & 1) * 16 + ((cl >> 3) & 3) * 4 + (cl & 3); }
        u32x2 o8; o8.x = pk4_fp8(s[0 * 33] * 64.f, s[1 * 33] * 64.f, s[2 * 33] * 64.f, s[3 * 33] * 64.f); o8.y = pk4_fp8(s[4 * 33] * 64.f, s[5 * 33] * 64.f, s[6 * 33] * 64.f, s[7 * 33] * 64.f);
        *(u32x2*)(c.WT + (size_t)nn * 1024 + c.k0 + 8 * cc) = o8; }
    __builtin_amdgcn_s_waitcnt(0xc07f); asm volatile("" ::: "memory");
}
__device__ __forceinline__ void conv_seq(Fr& F, int start, int n) {
    if (start + n > Q_ITEMS) n = Q_ITEMS - start;
    if (n <= 0) return;
    float* scr = (float*)(F.lds + F.wave * 64 * 33 * 4);
    float va[32], vb[32];
    CItem ca = conv_decode(F.P, start), cb = ca;
    conv_load(ca, va, F.lane);
#pragma unroll 1
    for (int i = 0; i < n; i += 2) {
        if (i + 1 < n) { cb = conv_decode(F.P, start + i + 1); conv_load(cb, vb, F.lane); }
        conv_finish(ca, va, scr, F.lane);
        if (i + 2 < n) { ca = conv_decode(F.P, start + i + 2); conv_load(ca, va, F.lane); }
        if (i + 1 < n) conv_finish(cb, vb, scr, F.lane);
    }
}
struct Slot { int phase, b0, nb, n; };
constexpr Slot SLOTS[] = {{0, 0, 256, 1}, {2, 152, 104, 6}, {3, 16, 240, 6}, {5, 16, 240, 10}, {7, 16, 240, 6}, {10, 144, 112, 4}, {11, 0, 256, 20}, {12, 152, 104, 6}};
constexpr int NSLOTS = sizeof(SLOTS) / sizeof(Slot);
constexpr int slot_base(int k) { int b = 0; for (int i = 0; i < k; ++i) b += SLOTS[i].nb * 8 * SLOTS[i].n; return b; }
static_assert(slot_base(5) >= Q_ITEMS_L && slot_base(NSLOTS) >= Q_ITEMS, "conversion schedule must cover layer 0 before phase 9 and everything before phase 17");
template <int PH>
__device__ __forceinline__ void conv_fill(Fr& F) {
#pragma unroll
    for (int k = 0; k < NSLOTS; ++k) if (SLOTS[k].phase == PH) {
        __syncthreads();
        if (F.blk >= SLOTS[k].b0 && F.blk < SLOTS[k].b0 + SLOTS[k].nb) conv_seq(F, slot_base(k) + ((F.blk - SLOTS[k].b0) * 8 + F.wave) * SLOTS[k].n, SLOTS[k].n);
    }
}
__device__ __forceinline__ void ph_prologue(Fr& F) {
    const Ptrs& P = F.P;
    if (F.blk < 192) {
        float* sl = (float*)(F.lds + 8 * 64 * 33 * 4);
        float* red = sl + 5 * 1024;
        const float* c = P.in[1]; const float* cc = P.in[3];
        for (int i = F.tid; i < 5 * 1024; i += NTHR) { const int r = i >> 10, k = i & 1023; const float v = r < 4 ? c[r * 1024 + k] : cc[k]; sl[i] = v / (1.f + __expf(-v)); }
        __syncthreads();
        const int l = F.blk / 96, j = (F.blk % 96) * 64 + (F.tid & 63), ks = F.tid >> 6;
        const float* w = P.in[4] + ((size_t)l * 1024 + ks * 128) * 6144 + j;
        float acc[5] = {0.f, 0.f, 0.f, 0.f, 0.f};
#pragma unroll 16
        for (int k = 0; k < 128; ++k) { const float wv = w[(size_t)k * 6144];
#pragma unroll
            for (int r = 0; r < 5; ++r) acc[r] += sl[r * 1024 + ks * 128 + k] * wv; }
#pragma unroll
        for (int r = 0; r < 5; ++r) red[(ks * 5 + r) * 64 + (F.tid & 63)] = acc[r];
        __syncthreads();
        if (F.tid < 320) { const int r = F.tid >> 6, cidx = F.tid & 63; float sum = 0.f;
#pragma unroll
            for (int q = 0; q < 8; ++q) sum += red[(q * 5 + r) * 64 + cidx];
            const int jj = (F.blk % 96) * 64 + cidx;
            WSP(float, WS_MOD)[(l * 5 + r) * 6144 + jj] = sum + P.in[5][l * 6144 + jj]; }
        __syncthreads();
    }
    for (size_t gid = F.gtid; gid < 4096 * 48; gid += F.gsz) {
        const int s = (int)(gid / 48), i = (int)(gid % 48); const int row = s >> 6, col = s & 63;
        if (i < 16) { const int fi = i & 7; const float fr = powf(10000.f, -(float)fi / 8.f); const float ang = (float)(i < 8 ? row : col) * fr;
            float* T = WSP(float, WS_ROPEM) + ((size_t)s * 16 + i) * 2; T[0] = cosf(ang); T[1] = sinf(ang); }
        else { const int ii = i - 16, fi = ii & 15; const float fr = powf(10000.f, -(float)fi / 16.f); const float ang = (float)(ii < 16 ? row : col) * fr;
            float* T = WSP(float, WS_ROPEG) + ((size_t)s * 32 + ii) * 2; T[0] = cosf(ang); T[1] = sinf(ang); }
    }
    for (size_t gid = F.gtid; gid < 2 * 32 * 1024; gid += F.gsz) { const int l = (int)(gid >> 15), e = (int)(gid >> 10) & 31, k = (int)gid & 1023;
        WSP(float, WS_WRT)[gid] = P.in[27][((size_t)l * 1024 + k) * 32 + e]; }
    for (size_t gid = F.gtid; gid < 2 * 8 * 128 * 64; gid += F.gsz) { const int c = (int)gid & 63, o = (int)(gid >> 6) & 127, blk = (int)(gid >> 13) & 7, dir = (int)(gid >> 16);
        const float* src = o < 64 ? P.in[11] : P.in[13];
        WSP(bf16, WS_WRI)[gid] = (bf16)f2bf(src[(((size_t)dir * 8 + blk) * 64 + c) * 64 + (o & 63)]); }
    { u32x4* z = (u32x4*)(WSP(bf16, WS_WIN) + (size_t)1440 * 1024); for (size_t i = F.gtid; i < (size_t)96 * 1024 * 2 / 16; i += F.gsz) z[i] = (u32x4){0u, 0u, 0u, 0u};
      bf16* q = WSP(bf16, WS_WQKVB);
      for (size_t i = F.gtid; i < (size_t)768 * 16; i += F.gsz) { const int r = (int)(i >> 4), c = (int)(i & 15); *(u32x4*)(q + (size_t)r * 384 + 256 + c * 8) = (u32x4){0u, 0u, 0u, 0u}; }
      for (size_t i = F.gtid; i < (size_t)1024 * 32; i += F.gsz) { const int r = (int)(i >> 5), c = (int)(i & 31); *(u32x4*)(q + (size_t)(768 + r) * 384 + c * 8) = (u32x4){0u, 0u, 0u, 0u}; } }
    float* scr = (float*)(F.lds + F.wave * 64 * 33 * 4);
    long base = 0;
#pragma unroll 1
    for (int j = 2; j < NJOBS; ++j) {
        const TJob t = get_job(P, j);
        const int nnb = t.N / 32; const long per = (long)(t.K / 64) * nnb, total = per * t.count;
        long first = ((long)F.gw - base % F.ngw + F.ngw) % F.ngw;
        for (long it = first; it < total; it += F.ngw) {
            const int m = (int)(it / per); const int r = (int)(it % per); const int kb = r / nnb, nb = r % nnb;
            transpose_item(t.W + (size_t)m * t.wstride, t.ldw, t.WT + (size_t)m * t.tstride, t.ldt, kb * 64, nb * 32, t.row_off, t.col_off, t.map, scr, F.lane);
        }
        base += total;
    }
}

struct RowV { f32x4 v[4]; };
__device__ __forceinline__ RowV load_row(const float* p, int lane) { RowV r; const f32x4* q = (const f32x4*)p + lane;
#pragma unroll
    for (int j = 0; j < 4; ++j) r.v[j] = q[64 * j]; return r; }
__device__ __forceinline__ void norm_mod(RowV& r, const float* g, const float* sc, const float* sh, int lane) {
    float s = 0.f;
#pragma unroll
    for (int j = 0; j < 4; ++j) s += r.v[j].x * r.v[j].x + r.v[j].y * r.v[j].y + r.v[j].z * r.v[j].z + r.v[j].w * r.v[j].w;
    const float rs = rsqrtf(wave_sum(s) * (1.f / D) + 1e-6f);
#pragma unroll
    for (int j = 0; j < 4; ++j) { const f32x4 gv = ((const f32x4*)g)[lane + 64 * j], scv = ((const f32x4*)sc)[lane + 64 * j], shv = ((const f32x4*)sh)[lane + 64 * j];
        r.v[j] = (r.v[j] * rs * gv) * (scv + 1.f) + shv; }
}
__device__ __forceinline__ void store_row_bf16(bf16* p, const RowV& r, int lane) { u32x2* q = (u32x2*)p + lane;
#pragma unroll
    for (int j = 0; j < 4; ++j) { u32x2 o; o.x = pk2(r.v[j].x, r.v[j].y); o.y = pk2(r.v[j].z, r.v[j].w); q[64 * j] = o; } }
__device__ __forceinline__ const float* xrow0(const Ptrs& P, int r) { return r < NL ? P.in[0] + (size_t)r * D : P.in[2] + (size_t)(r - NL) * D; }

__device__ __forceinline__ void ph_norm0(Fr& F) {
    const Ptrs& P = F.P; const float* MOD = WSP(float, WS_MOD);
    for (int r = F.gw; r < NT; r += F.ngw) {
        RowV v = load_row(xrow0(P, r), F.lane);
        const float* m = MOD + (size_t)mod_row(r) * 6144;
        norm_mod(v, P.in[6], m + 1024, m, F.lane);
        store_row_bf16(WSP(bf16, WS_HN) + (size_t)r * D, v, F.lane);
    }
}

__device__ __forceinline__ void wtile(const bf16* a0, const bf16* a1, const bf16* b0, const bf16* b1, int K, f32x4 (&acc)[2][2]) {
#pragma unroll
    for (int m = 0; m < 2; ++m)
#pragma unroll
        for (int n = 0; n < 2; ++n) acc[m][n] = (f32x4){0.f, 0.f, 0.f, 0.f};
#pragma unroll 2
    for (int k = 0; k < K; k += 32) {
        const bf16x8 A0 = *(const bf16x8*)(a0 + k), A1 = *(const bf16x8*)(a1 + k), B0 = *(const bf16x8*)(b0 + k), B1 = *(const bf16x8*)(b1 + k);
        acc[0][0] = __builtin_amdgcn_mfma_f32_16x16x32_bf16(B0, A0, acc[0][0], 0, 0, 0);
        acc[0][1] = __builtin_amdgcn_mfma_f32_16x16x32_bf16(B1, A0, acc[0][1], 0, 0, 0);
        acc[1][0] = __builtin_amdgcn_mfma_f32_16x16x32_bf16(B0, A1, acc[1][0], 0, 0, 0);
        acc[1][1] = __builtin_amdgcn_mfma_f32_16x16x32_bf16(B1, A1, acc[1][1], 0, 0, 0);
    }
}
struct EpiF32 { float* C; int ldc, nvalid;
    __device__ __forceinline__ void operator()(int row, int col, f32x4 a, f32x4 b) const {
        if (col < nvalid) *(f32x4*)(C + (size_t)row * ldc + col) = a;
        if (col + 16 < nvalid) *(f32x4*)(C + (size_t)row * ldc + col + 16) = b; } };
struct EpiResid { const float* xin0; const float* xin1; float* xout; const float* g;
    __device__ __forceinline__ void operator()(int row, int col, f32x4 a, f32x4 b) const {
        const float* xi = row < NL ? xin0 + (size_t)row * D : xin1 + (size_t)(row - NL) * D; const float* gg = g + (size_t)mod_row(row) * 6144;
        float* xo = xout + (size_t)row * D;
        *(f32x4*)(xo + col) = *(const f32x4*)(xi + col) + *(const f32x4*)(gg + col) * a;
        *(f32x4*)(xo + col + 16) = *(const f32x4*)(xi + col + 16) + *(const f32x4*)(gg + col + 16) * b; } };
struct EpiSwiglu { bf16* act; const float* bias;
    __device__ __forceinline__ void operator()(int row, int col, f32x4 a, f32x4 b) const {
        const int j = (col >> 5) * 16 + (col & 15);
        const f32x4 bg = *(const f32x4*)(bias + j), bu = *(const f32x4*)(bias + 1024 + j);
        float o[4];
#pragma unroll
        for (int i = 0; i < 4; ++i) { float hg = a[i] + bg[i], hu = b[i] + bu[i]; hg = fminf(hg, 7.f); hu = fminf(fmaxf(hu, -7.f), 7.f);
            o[i] = hg * sigmoidf_(1.702f * hg) * (hu + 1.f); }
        *(unsigned*)((unsigned char*)act + (size_t)row * D + j) = pk4_fp8(o[0], o[1], o[2], o[3]); } };
struct EpiBiasBf16 { bf16* Y; const float* bias;
    __device__ __forceinline__ void operator()(int row, int col, f32x4 a, f32x4 b) const {
        const f32x4 b0 = *(const f32x4*)(bias + col), b1 = *(const f32x4*)(bias + col + 16);
        u32x2 w; w.x = pk2(a[0] + b0[0], a[1] + b0[1]); w.y = pk2(a[2] + b0[2], a[3] + b0[3]); *(u32x2*)(Y + (size_t)row * D + col) = w;
        w.x = pk2(b[0] + b1[0], b[1] + b1[1]); w.y = pk2(b[2] + b1[2], b[3] + b1[3]); *(u32x2*)(Y + (size_t)row * D + col + 16) = w; } };

__device__ __forceinline__ void moe_prefix(Fr& F, int layer) {
    int* pre = (int*)(F.lds + LDS_MISC + 64);
    const int* cnt = (const int*)(F.P.ws + WS_CTL + CW_CNT) + layer * NE;
    __syncthreads();
    if (F.tid == 0) { int s = 0; for (int e = 0; e < NE; ++e) { pre[e] = s; s += (cnt[e] + 255) >> 8; } pre[NE] = s; }
    __syncthreads();
}
__device__ __forceinline__ int moe_find(const int* pre, int t256) {
    const int lane = threadIdx.x & 63; const int v = lane < NE ? pre[lane + 1] : 0x7fffffff; return __popcll(__ballot(v <= t256)); }

namespace pg {
constexpr int BM = 256, BK = 64, HALF = 128, HTB = HALF * BK * 2, STAGE_BYTES = 8 * HTB, NXCD = 8, WGM = 8;
__device__ __forceinline__ int lds_byte(int r, int c) { const int st = (r >> 4) * 2 + (c >> 5), rr = r & 15, cc = c & 31, ob = rr * 64 + cc * 2; return st * 1024 + (ob ^ (((ob >> 9) & 1) << 5)); }
__device__ __forceinline__ void stage_rc(int b, int& R, int& C) { const int st = b / 1024, sb = b % 1024, swz = sb ^ (((sb >> 9) & 1) << 5); R = (st >> 1) * 16 + swz / 64; C = (st & 1) * 32 + (swz % 64) / 2; }
struct Unit { int pm, pn, e, mt; };
struct DenseSched {
    const bf16* A; const bf16* Bt; int ldab, ldbb, nkt; int nM, nN, nwg, G, c;
    __device__ __forceinline__ void init(const bf16* A_, int lda_, const bf16* Bt_, int ldb_, int M, int N, int K_, int G_, int c_) { A = A_; Bt = Bt_; ldab = lda_ * 2; ldbb = ldb_ * 2; nkt = K_ / BK; nM = M / BM; nN = N / BM; nwg = nM * nN; G = G_; c = c_; }
    __device__ __forceinline__ bool next(int i, Unit& u) const {
        const long L = (long)i * G + c; if (L >= nwg) return false;
        int wgid = (int)L; { const int q = nwg / NXCD, r = nwg % NXCD, xcd = wgid % NXCD, off = wgid / NXCD; wgid = (xcd < r ? xcd * (q + 1) : r * (q + 1) + (xcd - r) * q) + off; }
        const int nig = WGM * nN, gid = wgid / nig, fm = gid * WGM, gsz = (nM - fm) < WGM ? (nM - fm) : WGM;
        u.pm = fm + ((wgid % nig) % gsz); u.pn = (wgid % nig) / gsz; u.e = 0; u.mt = 0; return true;
    }
    __device__ __forceinline__ void fill(const Unit&, int, int, LAS unsigned char*, int) const {}
    __device__ __forceinline__ unsigned aoff(const Unit& u, int, LAS unsigned char*, int r, int C) const { return (unsigned)((u.pm * BM + r) * ldab + C * 2); }
    __device__ __forceinline__ const char* bbase(const Unit& u) const { return (const char*)Bt + (size_t)u.pn * BM * ldbb; }
};
template <int STAGE> struct MoeSched {
    const bf16* A; const bf16* Bt; int ldab, ldbb, nkt; int G, c, NN, nunits; const int* pre; const int* cnt; const int* toklist; const float* bias;
    __device__ __forceinline__ bool next(int i, Unit& u) const {
        int t256;
        if (G == 256) { const int x = c & 7, j = c >> 3;
            const int tpr = 256 / NN, nfull = (nunits / NN) / tpr;
            if (i < nfull) { if (STAGE == 1) { t256 = i * 32 + x * 4 + (j >> 3); u.pn = j & 7; } else { t256 = i * 64 + x * 8 + (j >> 2); u.pn = j & 3; } }
            else { const long L = (long)nfull * 256 + (long)(i - nfull) * 256 + c; if (L >= nunits) return false; t256 = (int)(L / NN); u.pn = (int)(L % NN); } }
        else { const long L = (long)i * G + c; if (L >= nunits) return false; t256 = (int)(L / NN); u.pn = (int)(L % NN); }
        u.pm = t256; u.e = moe_find(pre, t256); u.mt = t256 - pre[u.e]; return true;
    }
    __device__ __forceinline__ void fill(const Unit& u, int par, int slot3, LAS unsigned char* lds, int tid) const {
        if (STAGE == 1 && tid < 256) { const int c = cnt[u.e]; int slot = u.mt * BM + tid; slot = slot < c ? slot : c - 1;
            __builtin_amdgcn_global_load_lds((const unsigned*)(toklist + (size_t)u.e * NT + slot), (LAS unsigned*)(lds + LDS_MISC + 512 + par * 1024 + (tid >> 6) * 256), 4, 0, 0); }
        if (tid >= 256) { const int w = (tid >> 6) - 4, l = tid & 63;
            const float* src = STAGE == 1 ? bias + (size_t)u.e * 2048 + (w >> 1) * 1024 + u.pn * 128 + (w & 1) * 64 + l : bias + (size_t)u.e * 1024 + u.pn * 256 + w * 64 + l;
            __builtin_amdgcn_global_load_lds((const unsigned*)src, (LAS unsigned*)(lds + LDS_MISC + 2560 + slot3 * 1024 + w * 256), 4, 0, 0); }
    }
    __device__ __forceinline__ unsigned aoff(const Unit& u, int par, LAS unsigned char* lds, int r, int C) const {
        if (STAGE == 1) { const int tok = *(const LAS int*)(lds + LDS_MISC + 512 + par * 1024 + r * 4); return (unsigned)(tok * ldab + C * 2); }
        return (unsigned)((u.pm * BM + r) * ldab + C * 2);
    }
    __device__ __forceinline__ const char* bbase(const Unit& u) const { return (const char*)Bt + ((size_t)u.e * NN * BM + (size_t)u.pn * BM) * ldbb; }
};

template <bool FP8, class Sched, class Epi>
__device__ __forceinline__ void gemm_phase(LAS unsigned char* lds, const Sched& S, const Epi& E) {
    const int tid = threadIdx.x, wid = __builtin_amdgcn_readfirstlane(tid >> 6), lane = tid & 63, wr = wid >> 2, wc = wid & 3, fr = lane & 15, fq = lane >> 4;
    const int nt = S.nkt;
    int Rr[2], Cc[2]; unsigned voffB[2];
#pragma unroll
    for (int i = 0; i < 2; ++i) { stage_rc(tid * 16 + i * 8192, Rr[i], Cc[i]); voffB[i] = (unsigned)(Rr[i] * S.ldbb + Cc[i] * 2); }
    const size_t kstep = (size_t)(BK * 2);
    const size_t hstepB = (size_t)HALF * S.ldbb;
    const unsigned ldsw = (unsigned)wid * 1024u;
    const int aoff = lds_byte(wr * 64 + fr, fq * 8), boff = lds_byte(wc * 32 + fr, fq * 8);
#define PG_SA(b, h) (((b) * 2 + (h)) * HTB)
#define PG_SB(b, h) ((4 + (b) * 2 + (h)) * HTB)
#define PG_STAGE(bufoff, gbase, voff) do { _Pragma("unroll") for (int _i = 0; _i < 2; ++_i) \
        __builtin_amdgcn_global_load_lds((const unsigned*)((const char*)(gbase) + (voff)[_i]), (LAS unsigned*)(lds + (bufoff) + ldsw + _i * 8192), 16, 0, 0); } while (0)
#define PG_LDA(dst, b, h) do { if constexpr (FP8) { _Pragma("unroll") for (int m = 0; m < 4; ++m) { const i32x4 _l = *(const LAS i32x4*)(lds + PG_SA(b, h) + aoff + m * 2048), _h = *(const LAS i32x4*)(lds + PG_SA(b, h) + aoff + m * 2048 + 1024); \
        dst##8[m] = __builtin_shufflevector(_l, _h, 0, 1, 2, 3, 4, 5, 6, 7); } } \
    else { _Pragma("unroll") for (int m = 0; m < 4; ++m) _Pragma("unroll") for (int k = 0; k < 2; ++k) dst[m][k] = *(const LAS bf16x8*)(lds + PG_SA(b, h) + aoff + m * 2048 + k * 1024); } } while (0)
#define PG_LDB(dst, b, h) do { if constexpr (FP8) { _Pragma("unroll") for (int n = 0; n < 2; ++n) { const i32x4 _l = *(const LAS i32x4*)(lds + PG_SB(b, h) + boff + n * 2048), _h = *(const LAS i32x4*)(lds + PG_SB(b, h) + boff + n * 2048 + 1024); \
        dst##8[n] = __builtin_shufflevector(_l, _h, 0, 1, 2, 3, 4, 5, 6, 7); } } \
    else { _Pragma("unroll") for (int n = 0; n < 2; ++n) _Pragma("unroll") for (int k = 0; k < 2; ++k) dst[n][k] = *(const LAS bf16x8*)(lds + PG_SB(b, h) + boff + n * 2048 + k * 1024); } } while (0)
#define PG_MMA(ai, bj, At, Bt) do { __builtin_amdgcn_s_setprio(1); if constexpr (FP8) { _Pragma("unroll") for (int m = 0; m < 4; ++m) _Pragma("unroll") for (int n = 0; n < 2; ++n) \
        asm volatile("v_mfma_scale_f32_16x16x128_f8f6f4 %0, %1, %2, %0, %3, %4 op_sel_hi:[0,0,0]" : "+v"(acc[ai][bj][m][n]) : "v"(Bt##8[n]), "v"(At##8[m]), "v"(sc_w), "v"(sc_a)); } \
    else { _Pragma("unroll") for (int m = 0; m < 4; ++m) _Pragma("unroll") for (int n = 0; n < 2; ++n) _Pragma("unroll") for (int k = 0; k < 2; ++k) \
        acc[ai][bj][m][n] = __builtin_amdgcn_mfma_f32_16x16x32_bf16(Bt[n][k], At[m][k], acc[ai][bj][m][n], 0, 0, 0); } __builtin_amdgcn_s_setprio(0); } while (0)
#define PG_MMA2(ai, At, B0, B1) do { PG_MMA(ai, 0, At, B0); PG_MMA(ai, 1, At, B1); } while (0)
#define PG_WAIT_V(n) asm volatile("s_waitcnt vmcnt(" #n ")" ::: "memory")
#define PG_WAIT_VL(n) asm volatile("s_waitcnt vmcnt(" #n ") lgkmcnt(0)" ::: "memory")
#define PG_WAIT_L(n) asm volatile("s_waitcnt lgkmcnt(" #n ")" ::: "memory")
#define PG_BAR __builtin_amdgcn_s_barrier()
#define PG_SCHED __builtin_amdgcn_sched_barrier(0)
    Unit cur, nxt; int ui = 0;
    if (!S.next(0, cur)) return;
    f32x4 acc[2][2][4][2];
#pragma unroll
    for (int a = 0; a < 2; ++a)
#pragma unroll
        for (int b = 0; b < 2; ++b)
#pragma unroll
            for (int m = 0; m < 4; ++m)
#pragma unroll
                for (int n = 0; n < 2; ++n) acc[a][b][m][n] = (f32x4){0.f, 0.f, 0.f, 0.f};
    bf16x8 At[4][2], B0[2][2], B1[2][2]; i32x8 At8[4], B08[2], B18[2];
    int sc_w = 0x79797979, sc_a = 0x7F7F7F7F;
    asm volatile("" : "+v"(sc_w), "+v"(sc_a));
    unsigned voA0[2], voA1[2], vnA0[2], vnA1[2];
    S.fill(cur, 0, 0, lds, tid);
    asm volatile("s_waitcnt vmcnt(0)" ::: "memory"); __syncthreads();
#pragma unroll
    for (int i = 0; i < 2; ++i) { voA0[i] = S.aoff(cur, 0, lds, Rr[i], Cc[i]); voA1[i] = S.aoff(cur, 0, lds, HALF + Rr[i], Cc[i]); }
    const char* Ab = (const char*)S.A; const char* cB = S.bbase(cur);
    PG_STAGE(PG_SB(0, 0), cB, voffB); PG_STAGE(PG_SB(0, 1), cB + hstepB, voffB); PG_STAGE(PG_SA(0, 0), Ab, voA0); PG_STAGE(PG_SA(0, 1), Ab, voA1);
    if (wr == 1) PG_BAR;
    PG_WAIT_V(2); PG_BAR;
    PG_STAGE(PG_SB(1, 0), cB + kstep, voffB); PG_STAGE(PG_SA(1, 0), Ab + kstep, voA0); PG_STAGE(PG_SB(1, 1), cB + hstepB + kstep, voffB);
    PG_WAIT_V(6); PG_BAR;
    for (;;) {
        const bool has_next = S.next(ui + 1, nxt);
        const char* nB = has_next ? S.bbase(nxt) : cB;
        if (has_next) S.fill(nxt, (ui + 1) & 1, (ui + 1) % 3, lds, tid);
        for (int t = 0; t < nt; t += 2) {
            const bool last = (t == nt - 2);
            if (last) {
#pragma unroll
                for (int i = 0; i < 2; ++i) { vnA0[i] = has_next ? S.aoff(nxt, (ui + 1) & 1, lds, Rr[i], Cc[i]) : voA0[i]; vnA1[i] = has_next ? S.aoff(nxt, (ui + 1) & 1, lds, HALF + Rr[i], Cc[i]) : voA1[i]; } }
            const char* a1 = Ab + (size_t)(t + 1) * kstep;
            const char* a2 = last ? Ab : Ab + (size_t)(t + 2) * kstep; const char* b2 = last ? nB : cB + (size_t)(t + 2) * kstep;
            const char* a3 = a2 + kstep; const char* b3 = b2 + kstep;
            unsigned o20[2], o21[2];
#pragma unroll
            for (int i = 0; i < 2; ++i) { o20[i] = last ? vnA0[i] : voA0[i]; o21[i] = last ? vnA1[i] : voA1[i]; }
            PG_LDB(B0, 0, 0); PG_LDB(B1, 0, 1); PG_LDA(At, 0, 0); PG_STAGE(PG_SA(1, 1), a1, voA1);
            PG_WAIT_VL(8); PG_BAR; PG_SCHED; PG_MMA2(0, At, B0, B1); PG_BAR; PG_SCHED;
            PG_LDA(At, 0, 1); PG_STAGE(PG_SB(0, 0), b2, voffB); PG_STAGE(PG_SB(0, 1), b2 + hstepB, voffB); PG_STAGE(PG_SA(0, 0), a2, o20);
            PG_WAIT_VL(8); PG_BAR; PG_SCHED; PG_MMA2(1, At, B0, B1); PG_BAR; PG_SCHED;
            PG_LDB(B0, 1, 0); PG_LDB(B1, 1, 1); PG_LDA(At, 1, 0); PG_STAGE(PG_SA(0, 1), a2, o21);
            PG_WAIT_VL(8); PG_BAR; PG_SCHED; PG_MMA2(0, At, B0, B1); PG_BAR; PG_SCHED;
            PG_LDA(At, 1, 1); PG_STAGE(PG_SB(1, 0), b3, voffB); PG_STAGE(PG_SB(1, 1), b3 + hstepB, voffB); PG_STAGE(PG_SA(1, 0), a3, o20);
            PG_WAIT_VL(8); PG_BAR; PG_SCHED; PG_MMA2(1, At, B0, B1); PG_BAR; PG_SCHED;
        }
        if constexpr (FP8) asm volatile("s_nop 15\n\ts_nop 15" : "+v"(acc[1][1][0][0]), "+v"(acc[1][1][0][1]), "+v"(acc[1][1][1][0]), "+v"(acc[1][1][1][1]), "+v"(acc[1][1][2][0]), "+v"(acc[1][1][2][1]), "+v"(acc[1][1][3][0]), "+v"(acc[1][1][3][1]) :: "memory");
        if constexpr (Epi::WIDE) { const int row0 = cur.pm * BM + wr * 64 + fr; const typename Epi::Ctx cx = E.prepw(cur, wc, fq, lds, ui % 3);
#pragma unroll
          for (int ai = 0; ai < 2; ++ai)
#pragma unroll
              for (int m = 0; m < 4; ++m) E.applyw(cx, row0 + ai * HALF + m * 16, acc[ai][0][m][0], acc[ai][0][m][1], acc[ai][1][m][0], acc[ai][1][m][1]); }
        else { const int row0 = cur.pm * BM + wr * 64 + fr, col0 = cur.pn * BM + wc * 32 + 4 * fq;
          const typename Epi::Ctx cx0 = E.prep(cur, col0), cx1 = E.prep(cur, col0 + HALF);
#pragma unroll
          for (int ai = 0; ai < 2; ++ai) {
              if constexpr (Epi::ROWLOAD) {
                  typename Epi::Rv rv[4][2];
#pragma unroll
                  for (int m = 0; m < 4; ++m) { rv[m][0] = E.load(row0 + ai * HALF + m * 16, col0); rv[m][1] = E.load(row0 + ai * HALF + m * 16, col0 + HALF); }
#pragma unroll
                  for (int m = 0; m < 4; ++m) { E.apply(cx0, rv[m][0], row0 + ai * HALF + m * 16, col0, acc[ai][0][m][0], acc[ai][0][m][1]);
                                                E.apply(cx1, rv[m][1], row0 + ai * HALF + m * 16, col0 + HALF, acc[ai][1][m][0], acc[ai][1][m][1]); }
              } else {
#pragma unroll
                  for (int m = 0; m < 4; ++m) { E.apply(cx0, cur, row0 + ai * HALF + m * 16, col0, acc[ai][0][m][0], acc[ai][0][m][1]);
                                                E.apply(cx1, cur, row0 + ai * HALF + m * 16, col0 + HALF, acc[ai][1][m][0], acc[ai][1][m][1]); }
              } } }
        if (!has_next) break;
#pragma unroll
        for (int a = 0; a < 2; ++a)
#pragma unroll
            for (int b = 0; b < 2; ++b)
#pragma unroll
                for (int m = 0; m < 4; ++m)
#pragma unroll
                    for (int n = 0; n < 2; ++n) acc[a][b][m][n] = (f32x4){0.f, 0.f, 0.f, 0.f};
        cur = nxt; cB = nB; ++ui;
#pragma unroll
        for (int i = 0; i < 2; ++i) { voA0[i] = vnA0[i]; voA1[i] = vnA1[i]; }
    }
    PG_WAIT_V(0);
    if (wr == 0) PG_BAR;
    PG_BAR;
#undef PG_SA
#undef PG_SB
#undef PG_STAGE
#undef PG_LDA
#undef PG_LDB
#undef PG_MMA
#undef PG_MMA2
#undef PG_WAIT_VL
#undef PG_WAIT_V
#undef PG_WAIT_L
#undef PG_BAR
#undef PG_SCHED
}
}
struct GF32 { EpiF32 e; static constexpr bool ROWLOAD = false, WIDE = false; struct Ctx {}; struct Rv {};
    __device__ __forceinline__ Ctx prep(const pg::Unit&, int) const { return Ctx{}; }
    __device__ __forceinline__ void apply(const Ctx&, const pg::Unit&, int row, int col, f32x4 a, f32x4 b) const { e(row, col, a, b); } };
struct GResid { const float* xin0; const float* xin1; float* xout; const float* g; static constexpr bool ROWLOAD = true, WIDE = false;
    struct Ctx { f32x4 g0, g1; }; struct Rv { f32x4 x0, x1; };
    __device__ __forceinline__ Ctx prep(const pg::Unit& u, int col) const { const float* gg = g + (size_t)mod_row(u.pm * 256) * 6144; return Ctx{*(const f32x4*)(gg + col), *(const f32x4*)(gg + col + 16)}; }
    __device__ __forceinline__ Rv load(int row, int col) const { const float* xi = row < NL ? xin0 + (size_t)row * D : xin1 + (size_t)(row - NL) * D; return Rv{*(const f32x4*)(xi + col), *(const f32x4*)(xi + col + 16)}; }
    __device__ __forceinline__ void apply(const Ctx& c, const Rv& r, int row, int col, f32x4 a, f32x4 b) const { float* xo = xout + (size_t)row * D;
        *(f32x4*)(xo + col) = r.x0 + c.g0 * a; *(f32x4*)(xo + col + 16) = r.x1 + c.g1 * b; } };
struct GSwiglu { bf16* act; const float* bias; static constexpr bool ROWLOAD = false, WIDE = true;
    struct Ctx { f32x4 bg0, bg1, bu0, bu1; int j; }; struct Rv {};
    __device__ __forceinline__ Ctx prepw(const pg::Unit& u, int wc, int fq, LAS unsigned char* lds, int par) const { const int jl = 8 * (4 * wc + fq); const LAS float* tb = (const LAS float*)(lds + LDS_MISC + 2560 + par * 1024);
        const f32x4 one = {1.f, 1.f, 1.f, 1.f};
        return Ctx{*(const LAS f32x4*)(tb + jl), *(const LAS f32x4*)(tb + jl + 4), *(const LAS f32x4*)(tb + 128 + jl) + one, *(const LAS f32x4*)(tb + 128 + jl + 4) + one, u.pn * 128 + jl}; }
    __device__ __forceinline__ f32x4 glu4(f32x4 g, f32x4 u, f32x4 bg, f32x4 bu) const {
        f32x4 hg = g + bg, hu = u + bu;
#pragma unroll
        for (int i = 0; i < 4; ++i) { hg[i] = __builtin_amdgcn_fmed3f(hg[i], -20.f, 7.f); hu[i] = __builtin_amdgcn_fmed3f(hu[i], -6.f, 8.f); }
        const f32x4 kk = {-1.702f * 1.4426950408889634f, -1.702f * 1.4426950408889634f, -1.702f * 1.4426950408889634f, -1.702f * 1.4426950408889634f}, one = {1.f, 1.f, 1.f, 1.f};
        f32x4 e = hg * kk;
#pragma unroll
        for (int i = 0; i < 4; ++i) e[i] = __builtin_amdgcn_exp2f(e[i]);
        const f32x4 d = e + one;
        const float r01 = __builtin_amdgcn_rcpf(d[0] * d[1]), r23 = __builtin_amdgcn_rcpf(d[2] * d[3]);
        const f32x4 rr = {r01, r01, r23, r23}, ds = {d[1], d[0], d[3], d[2]};
        return (hg * hu) * (rr * ds);
    }
    __device__ __forceinline__ void applyw(const Ctx& c, int row, f32x4 g0, f32x4 u0, f32x4 g1, f32x4 u1) const {
        const f32x4 o0 = glu4(g0, u0, c.bg0, c.bu0), o1 = glu4(g1, u1, c.bg1, c.bu1);
        u32x2 w; w.x = pk4_fp8(o0[0], o0[1], o0[2], o0[3]); w.y = pk4_fp8(o1[0], o1[1], o1[2], o1[3]);
        *(u32x2*)((unsigned char*)act + (size_t)row * D + c.j) = w; } };
struct GBiasBf16 { bf16* Y; const float* bias; static constexpr bool ROWLOAD = false, WIDE = true;
    struct Ctx { f32x4 b00, b01, b10, b11; int col; }; struct Rv {};
    __device__ __forceinline__ Ctx prepw(const pg::Unit& u, int wc, int fq, LAS unsigned char* lds, int par) const { const int cl = 32 * wc + 8 * fq; const LAS float* tb = (const LAS float*)(lds + LDS_MISC + 2560 + par * 1024) + cl;
        return Ctx{*(const LAS f32x4*)tb, *(const LAS f32x4*)(tb + 4), *(const LAS f32x4*)(tb + 128), *(const LAS f32x4*)(tb + 132), u.pn * 256 + cl}; }
    __device__ __forceinline__ void applyw(const Ctx& c, int row, f32x4 a0, f32x4 a1, f32x4 b0, f32x4 b1) const {
        a0 += c.b00; a1 += c.b01; b0 += c.b10; b1 += c.b11;
        u32x4 w; w.x = pk2(a0[0], a0[1]); w.y = pk2(a0[2], a0[3]); w.z = pk2(a1[0], a1[1]); w.w = pk2(a1[2], a1[3]); *(u32x4*)(Y + (size_t)row * D + c.col) = w;
        w.x = pk2(b0[0], b0[1]); w.y = pk2(b0[2], b0[3]); w.z = pk2(b1[0], b1[1]); w.w = pk2(b1[2], b1[3]); *(u32x4*)(Y + (size_t)row * D + c.col + 128) = w; } };
template <class Epi>
__device__ __forceinline__ void ph_gemm(Fr& F, const bf16* A, int lda, const bf16* Bt, int ldb, int M, int N, int K, const Epi& E) {
    pg::DenseSched S; S.init(A, lda, Bt, ldb, M, N, K, F.nblk, F.blk);
    pg::gemm_phase<false>((LAS unsigned char*)F.lds, S, E);
}
template <int STAGE>
__device__ __forceinline__ void ph_moe_gemm(Fr& F, int layer, int nkt_probe = 0) {
    const Ptrs& P = F.P;
    moe_prefix(F, layer);
    const int* pre = (const int*)(F.lds + LDS_MISC + 64);
    pg::MoeSched<STAGE> S; S.ldab = 1024; S.ldbb = 1024; S.nkt = nkt_probe > 0 ? nkt_probe : 8; S.G = F.nblk; S.c = F.blk; S.NN = STAGE == 1 ? 8 : 4; S.nunits = pre[NE] * S.NN;
    S.pre = pre; S.cnt = (const int*)(P.ws + WS_CTL + CW_CNT) + layer * NE; S.toklist = WSP(int, WS_TOK);
    S.bias = STAGE == 1 ? P.in[30] + (size_t)layer * NE * 2048 : P.in[32] + (size_t)layer * NE * 1024;
    if (STAGE == 1) { S.A = WSP(bf16, WS_F); S.Bt = (const bf16*)(P.ws + WS_WGU + (size_t)layer * NE * 2048 * 1024); pg::gemm_phase<true>((LAS unsigned char*)F.lds, S, GSwiglu{WSP(bf16, WS_ACT), P.in[30] + (size_t)layer * NE * 2048}); }
    else { S.A = WSP(bf16, WS_ACT); S.Bt = (const bf16*)(P.ws + WS_WDN + (size_t)layer * NE * 1024 * 1024); pg::gemm_phase<true>((LAS unsigned char*)F.lds, S, GBiasBf16{WSP(bf16, WS_Y), P.in[32] + (size_t)layer * NE * 1024}); }
}

__device__ __forceinline__ void ph_e3(Fr& F) {
    const Ptrs& P = F.P; const int lane = F.lane;
    const float* Z = WSP(float, WS_Z); bf16* QKVN = WSP(bf16, WS_QKVN); bf16* KM = WSP(bf16, WS_KM);
    const float* ropeM = WSP(float, WS_ROPEM);
    if (F.blk < 16 && F.nblk > 32) return;
    for (int r = (F.nblk > 32 ? F.gw - 16 * NWAVES : F.gw); r < NT; r += (F.nblk > 32 ? F.ngw - 16 * NWAVES : F.ngw)) {
        const float* z = Z + (size_t)r * ZLD;
        const f32x4 qa = *(const f32x4*)(z + 1024 + 4 * lane);
        float ss = wave_sum(qa.x * qa.x + qa.y * qa.y + qa.z * qa.z + qa.w * qa.w);
        float rs = rsqrtf(ss * (1.f / 256.f) + 1e-6f);
        const f32x4 gq = *(const f32x4*)(P.in[16] + 4 * lane);
        u32x2 o; o.x = pk2(qa.x * rs * gq.x, qa.y * rs * gq.y); o.y = pk2(qa.z * rs * gq.z, qa.w * rs * gq.w);
        *(u32x2*)(QKVN + (size_t)r * 384 + 4 * lane) = o;
        const float k0 = z[1280 + 2 * lane], k1 = z[1280 + 2 * lane + 1];
        ss = wave_sum(k0 * k0 + k1 * k1); rs = rsqrtf(ss * (1.f / 128.f) + 1e-6f);
        *(unsigned*)(QKVN + (size_t)r * 384 + 256 + 2 * lane) = pk2(k0 * rs * P.in[18][2 * lane], k1 * rs * P.in[18][2 * lane + 1]);
        float kr = lane < 32 ? z[1408 + lane] : 0.f;
        ss = wave_sum(kr * kr); rs = rsqrtf(ss * (1.f / 32.f) + 1e-6f);
        kr = kr * rs * (lane < 32 ? P.in[21][32 + lane] : 0.f);
        int b, s; row_bs(r, b, s);
        const float other = __shfl_xor(kr, 16);
        float outv = kr;
        if (r < NL && lane < 32) { const int i = lane & 15; const float cs = ropeM[((size_t)s * 16 + i) * 2], sn = ropeM[((size_t)s * 16 + i) * 2 + 1];
            outv = lane < 16 ? kr * cs - other * sn : kr * cs + other * sn; }
        if (lane < 32) { const bf16 ov = (bf16)f2bf(outv);
#pragma unroll
            for (int h = 0; h < 8; ++h) KM[(((size_t)b * 8 + h) * TA + s) * 96 + 64 + lane] = ov; }
    }
}
__device__ __forceinline__ void ph_e5(Fr& F) {
    const Ptrs& P = F.P; const int lane = F.lane, sub = lane >> 4, d4 = lane & 15;
    const float* R = WSP(float, WS_QKVR); bf16* QM = WSP(bf16, WS_QM); bf16* KM = WSP(bf16, WS_KM); bf16* VT = WSP(bf16, WS_VM);
    const float* ropeM = WSP(float, WS_ROPEM);
    LAS unsigned char* scr = (LAS unsigned char*)F.lds + F.wave * LRU_WB;
    const f32x4 gqn = *(const f32x4*)(P.in[20] + 4 * d4), gkn = *(const f32x4*)(P.in[20] + 64 + 4 * d4);
    const f32x4 gqr = d4 < 8 ? *(const f32x4*)(P.in[21] + 4 * d4) : (f32x4){0.f, 0.f, 0.f, 0.f};
    if (F.blk < 16 && F.nblk > 32) return;
    for (int g = (F.nblk > 32 ? F.gw - 16 * NWAVES : F.gw); g < NT / 8; g += (F.nblk > 32 ? F.ngw - 16 * NWAVES : F.ngw)) {
        const int r0 = g * 8; int b, s0; row_bs(r0, b, s0);
#pragma unroll 2
        for (int h = 0; h < 8; ++h) {
#pragma unroll
            for (int pass = 0; pass < 2; ++pass) {
                const int rr = sub + 4 * pass, r = r0 + rr, s = s0 + rr; const float* q = R + (size_t)r * 1792;
                const size_t qo = (((size_t)b * 8 + h) * TA + s) * 96;
                f32x4 x = *(const f32x4*)(q + h * 96 + 4 * d4);
                float rs = rsqrtf(reduce16(dot4(x)) * (1.f / 64.f) + 1e-6f);
                x = x * rs * gqn;
                { u32x2 w; w.x = pk2(x.x, x.y); w.y = pk2(x.z, x.w); *(u32x2*)(QM + qo + 4 * d4) = w; }
                f32x4 y = d4 < 8 ? *(const f32x4*)(q + h * 96 + 64 + 4 * d4) : (f32x4){0.f, 0.f, 0.f, 0.f};
                rs = rsqrtf(reduce16(dot4(y)) * (1.f / 32.f) + 1e-6f);
                y = y * rs * gqr;
                f32x4 yo; yo.x = __shfl_xor(y.x, 4); yo.y = __shfl_xor(y.y, 4); yo.z = __shfl_xor(y.z, 4); yo.w = __shfl_xor(y.w, 4);
                if (r < NL && d4 < 8) { const float* rp = ropeM + ((size_t)s * 16 + 4 * (d4 & 3)) * 2; const f32x4 c0 = *(const f32x4*)rp, c1 = *(const f32x4*)(rp + 4);
                    const f32x4 cs = {c0.x, c0.z, c1.x, c1.z}, sn = {c0.y, c0.w, c1.y, c1.w};
                    y = d4 < 4 ? y * cs - yo * sn : y * cs + yo * sn; }
                if (d4 < 8) { u32x2 w; w.x = pk2(y.x, y.y); w.y = pk2(y.z, y.w); *(u32x2*)(QM + qo + 64 + 4 * d4) = w; }
                f32x4 kx = *(const f32x4*)(q + 768 + h * 128 + 4 * d4);
                rs = rsqrtf(reduce16(dot4(kx)) * (1.f / 64.f) + 1e-6f);
                kx = kx * rs * gkn;
                { u32x2 w; w.x = pk2(kx.x, kx.y); w.y = pk2(kx.z, kx.w); *(u32x2*)(KM + qo + 4 * d4) = w; }
                const f32x4 vx = *(const f32x4*)(q + 768 + h * 128 + 64 + 4 * d4);
                { u32x2 w; w.x = pk2(vx.x, vx.y); w.y = pk2(vx.z, vx.w); *(LAS u32x2*)(scr + rr * 128 + 8 * d4) = w; }
            }
            unsigned short t8[8];
#pragma unroll
            for (int rr = 0; rr < 8; ++rr) t8[rr] = *(const LAS unsigned short*)(scr + rr * 128 + 2 * lane);
            u32x4 w; w.x = t8[0] | ((unsigned)t8[1] << 16); w.y = t8[2] | ((unsigned)t8[3] << 16); w.z = t8[4] | ((unsigned)t8[5] << 16); w.w = t8[6] | ((unsigned)t8[7] << 16);
            *(u32x4*)(VT + (((size_t)b * 8 + h) * 64 + lane) * TA + s0) = w;
        }
    }
}

template <int DQ> struct ACfg { static constexpr int KP = DQ * 2 + 16, KCH = DQ / 8, KBYTES = 64 * KP, VP = 136, VBYTES = 64 * VP, BUF = KBYTES + VBYTES; };
template <int DQ, bool WIN>
__device__ __forceinline__ void attn_unit(LAS unsigned char* lds, const bf16* Qrow, const bf16* Kb, const bf16* Vtb, int a0, int a1, int b0, int b1,
                                          float c, int qpos, int ctile, float sink2, bf16* Orow, int tid, int lane) {
    typedef ACfg<DQ> C;
    const int hh = lane >> 5, ql = lane & 31;
    bf16x8 qf[DQ / 16];
#pragma unroll
    for (int ks = 0; ks < DQ / 16; ++ks) qf[ks] = *(const bf16x8*)(Qrow + 16 * ks + 8 * hh);
    f32x16 o0, o1;
#pragma unroll
    for (int r = 0; r < 16; ++r) { o0[r] = 0.f; o1[r] = 0.f; }
    float m = -1e30f, lsum = 0.f;
    const int n0 = a1 - a0, ntl = n0 + (b1 - b0);
    const int kkey0 = tid / C::KCH, kpc0 = tid % C::KCH, kkey1 = (tid + 512) / C::KCH, kpc1 = (tid + 512) % C::KCH;
    const bool two = (C::KCH == 12) && tid < 256;
    u32x4 kst0[2], kst1[2], vst[2];
    kst1[0] = (u32x4){0u, 0u, 0u, 0u}; kst1[1] = kst1[0];
#define AT_ISSUE(ti, p) do { const int _t = (ti) < n0 ? a0 + (ti) : b0 + (ti) - n0; const int _k0 = _t * 64; \
        kst0[p] = *(const u32x4*)(Kb + (size_t)(_k0 + kkey0) * DQ + kpc0 * 8); if (two) kst1[p] = *(const u32x4*)(Kb + (size_t)(_k0 + kkey1) * DQ + kpc1 * 8); \
        vst[p] = *(const u32x4*)(Vtb + (size_t)(tid >> 3) * TA + _k0 + (tid & 7) * 8); } while (0)
#define AT_COMMIT(buf, p) do { LAS unsigned char* _b = lds + (buf) * C::BUF; \
        *(LAS u32x4*)(_b + kkey0 * C::KP + kpc0 * 16) = kst0[p]; if (two) *(LAS u32x4*)(_b + kkey1 * C::KP + kpc1 * 16) = kst1[p]; \
        LAS unsigned char* _v = _b + C::KBYTES + (tid >> 3) * C::VP + (tid & 7) * 16; *(LAS u32x2*)_v = (u32x2){vst[p].x, vst[p].y}; *(LAS u32x2*)(_v + 8) = (u32x2){vst[p].z, vst[p].w}; } while (0)
    AT_ISSUE(0, 0); AT_COMMIT(0, 0);
    if (ntl > 1) AT_ISSUE(1, 1);
    __syncthreads();
    for (int tb = 0; tb < ntl; tb += 2) {
#pragma unroll
      for (int half = 0; half < 2; ++half) {
        const int ti = tb + half;
        if (ti < ntl) {
        const int buf = half;
        if (ti + 2 < ntl) AT_ISSUE(ti + 2, half);
        const LAS unsigned char* kb_ = lds + buf * C::BUF; const LAS unsigned char* vb_ = kb_ + C::KBYTES;
        bf16x8 kf0[DQ / 16], kf1[DQ / 16]; u32x2 va0[4], va1[4], vc0[4], vc1[4];
#pragma unroll
        for (int ks = 0; ks < DQ / 16; ++ks) { kf0[ks] = *(const LAS bf16x8*)(kb_ + ql * C::KP + (16 * ks + 8 * hh) * 2); kf1[ks] = *(const LAS bf16x8*)(kb_ + (32 + ql) * C::KP + (16 * ks + 8 * hh) * 2); }
#pragma unroll
        for (int s4 = 0; s4 < 4; ++s4) { const LAS unsigned char* v0 = vb_ + ql * C::VP + (16 * s4 + 4 * hh) * 2; const LAS unsigned char* v1 = v0 + 32 * C::VP;
            va0[s4] = *(const LAS u32x2*)v0; va1[s4] = *(const LAS u32x2*)(v0 + 16); vc0[s4] = *(const LAS u32x2*)v1; vc1[s4] = *(const LAS u32x2*)(v1 + 16); }
        __builtin_amdgcn_sched_barrier(0);
        f32x16 s0, s1;
#pragma unroll
        for (int r = 0; r < 16; ++r) { s0[r] = 0.f; s1[r] = 0.f; }
#pragma unroll
        for (int ks = 0; ks < DQ / 16; ++ks) {
            s0 = __builtin_amdgcn_mfma_f32_32x32x16_bf16(kf0[ks], qf[ks], s0, 0, 0, 0);
            s1 = __builtin_amdgcn_mfma_f32_32x32x16_bf16(kf1[ks], qf[ks], s1, 0, 0, 0);
        }
        const int tile = ti < n0 ? a0 + ti : b0 + ti - n0;
        const bool masked = WIN && ti < n0 && (tile - ctile >= 2 || ctile - tile >= 2);
        if (masked) {
#pragma unroll
            for (int r = 0; r < 16; ++r) { const int key = tile * 64 + (r & 3) + 8 * (r >> 2) + 4 * hh; const int d0 = qpos - key, d1 = qpos - key - 32;
                if (d0 > 128 || d0 < -128) s0[r] = -1e30f; if (d1 > 128 || d1 < -128) s1[r] = -1e30f; }
        }
        asm volatile("s_nop 15\n\ts_nop 15" : "+v"(s0), "+v"(s1));
        float mx;
        { float t0, t1, t2, t3;
          asm volatile("v_max3_f32 %0, %1, %2, %3" : "=v"(t0) : "v"(s0[0]), "v"(s0[1]), "v"(s0[2]));
          asm volatile("v_max3_f32 %0, %1, %2, %3" : "=v"(t1) : "v"(s0[3]), "v"(s0[4]), "v"(s0[5]));
          asm volatile("v_max3_f32 %0, %1, %2, %3" : "=v"(t2) : "v"(s1[0]), "v"(s1[1]), "v"(s1[2]));
          asm volatile("v_max3_f32 %0, %1, %2, %3" : "=v"(t3) : "v"(s1[3]), "v"(s1[4]), "v"(s1[5]));
#pragma unroll
          for (int r = 6; r < 16; r += 2) { asm volatile("v_max3_f32 %0, %0, %1, %2" : "+v"(t0) : "v"(s0[r]), "v"(s0[r + 1])); asm volatile("v_max3_f32 %0, %0, %1, %2" : "+v"(t2) : "v"(s1[r]), "v"(s1[r + 1])); }
          asm volatile("v_max3_f32 %0, %0, %1, %2" : "+v"(t0) : "v"(t1), "v"(t2));
          asm volatile("v_max_f32 %0, %1, %2" : "=v"(mx) : "v"(t0), "v"(t3)); }
        mx = fmaxf(mx, __shfl_xor(mx, 32)) * c;
        if (!__all(mx <= m + 8.f)) { const float mn = fmaxf(m, mx), alpha = __builtin_amdgcn_exp2f(m - mn); m = mn; lsum *= alpha;
#pragma unroll
            for (int r = 0; r < 16; ++r) { o0[r] *= alpha; o1[r] *= alpha; } }
        { f32x16 cv, mv;
#pragma unroll
          for (int r = 0; r < 16; ++r) { cv[r] = c; mv[r] = m; }
          s0 = s0 * cv - mv; s1 = s1 * cv - mv; }
#pragma unroll
        for (int r = 0; r < 16; ++r) { s0[r] = __builtin_amdgcn_exp2f(s0[r]); s1[r] = __builtin_amdgcn_exp2f(s1[r]); }
        { const f32x16 t = s0 + s1;
          typedef float f32x8_t __attribute__((ext_vector_type(8)));
          const f32x8_t u = __builtin_shufflevector(t, t, 0, 1, 2, 3, 4, 5, 6, 7) + __builtin_shufflevector(t, t, 8, 9, 10, 11, 12, 13, 14, 15);
          const f32x4 w = __builtin_shufflevector(u, u, 0, 1, 2, 3) + __builtin_shufflevector(u, u, 4, 5, 6, 7);
          lsum += (w.x + w.y) + (w.z + w.w); }
        bf16x8 pf[4];
#pragma unroll
        for (int s4 = 0; s4 < 4; ++s4) { u32x4 w;
            if (s4 < 2) { w.x = pk2(s0[8 * s4], s0[8 * s4 + 1]); w.y = pk2(s0[8 * s4 + 2], s0[8 * s4 + 3]); w.z = pk2(s0[8 * s4 + 4], s0[8 * s4 + 5]); w.w = pk2(s0[8 * s4 + 6], s0[8 * s4 + 7]); }
            else { const int q = s4 - 2; w.x = pk2(s1[8 * q], s1[8 * q + 1]); w.y = pk2(s1[8 * q + 2], s1[8 * q + 3]); w.z = pk2(s1[8 * q + 4], s1[8 * q + 5]); w.w = pk2(s1[8 * q + 6], s1[8 * q + 7]); }
            pf[s4] = __builtin_bit_cast(bf16x8, w); }
#pragma unroll
        for (int s4 = 0; s4 < 4; ++s4) {
            const bf16x8 va = __builtin_bit_cast(bf16x8, (u32x4){va0[s4].x, va0[s4].y, va1[s4].x, va1[s4].y}), vc = __builtin_bit_cast(bf16x8, (u32x4){vc0[s4].x, vc0[s4].y, vc1[s4].x, vc1[s4].y});
            o0 = __builtin_amdgcn_mfma_f32_32x32x16_bf16(va, pf[s4], o0, 0, 0, 0);
            o1 = __builtin_amdgcn_mfma_f32_32x32x16_bf16(vc, pf[s4], o1, 0, 0, 0);
        }
        if (ti + 1 < ntl) AT_COMMIT(buf ^ 1, half ^ 1);
        __syncthreads();
        }
      }
    }
#undef AT_ISSUE
#undef AT_COMMIT
    float ltot = lsum + __shfl_xor(lsum, 32);
    float fin = 1.f;
    if (WIN) { const float mn = fmaxf(m, sink2); fin = __builtin_amdgcn_exp2f(m - mn); ltot = ltot * fin + __builtin_amdgcn_exp2f(sink2 - mn); }
    const float inv = fin / ltot;
#pragma unroll
    for (int rq = 0; rq < 4; ++rq) {
        u32x2 w; w.x = pk2(o0[4 * rq] * inv, o0[4 * rq + 1] * inv); w.y = pk2(o0[4 * rq + 2] * inv, o0[4 * rq + 3] * inv); *(u32x2*)(Orow + 8 * rq + 4 * hh) = w;
        w.x = pk2(o1[4 * rq] * inv, o1[4 * rq + 1] * inv); w.y = pk2(o1[4 * rq + 2] * inv, o1[4 * rq + 3] * inv); *(u32x2*)(Orow + 32 + 8 * rq + 4 * hh) = w;
    }
}
__device__ __forceinline__ void ph_attn_mla(Fr& F) {
    const Ptrs& P = F.P;
    const bf16* QM = WSP(bf16, WS_QM); const bf16* KM = WSP(bf16, WS_KM); const bf16* VT = WSP(bf16, WS_VM);
    const int x = F.blk & 7, j = F.blk >> 3;
    const float c = 0.10206207261596577f * 1.4426950408889634f;
    for (int rd = 0; ; ++rd) {
        int bh, qb;
        if (F.nblk == 256) { if (rd < 2) { bh = rd * 16 + 2 * x + (j >> 4); qb = j & 15; } else if (rd == 2 && F.blk < 32) { bh = F.blk; qb = 16; } else break; }
        else { const int u = rd * F.nblk + F.blk; if (u >= 544) break; if (u < 512) { bh = u >> 4; qb = u & 15; } else { bh = u - 512; qb = 16; } }
        const int b = bh >> 3, h = bh & 7;
        const int s = qb * 256 + F.wave * 32 + (F.lane & 31);
        const int row = s < SEQ ? b * SEQ + s : NL + b * CTX + (s - SEQ);
        attn_unit<96, false>((LAS unsigned char*)F.lds, QM + ((size_t)bh * TA + s) * 96, KM + (size_t)bh * TA * 96, VT + (size_t)bh * 64 * TA,
                             qb < 16 ? 0 : 64, 68, 0, 0, c, 0, 0, 0.f, WSP(bf16, WS_YM) + (size_t)row * D + 512 + h * 64, F.tid, F.lane);
    }
}

__device__ __forceinline__ float gelu_fast(float x) { const float u = 1.5957691216057308f * (x + 0.044715f * x * x * x); return x / (1.f + __expf(-u)); }
__device__ __forceinline__ void ph_lru_carry(Fr& F) {
    if (F.blk < F.nblk - 8) return;
    const Ptrs& P = F.P; const int g = (F.blk - (F.nblk - 8)) * 8 + F.wave;
    const int bd = g >> 3, ch = (g & 7) * 64 + F.lane;
    const float* ag = WSP(float, WS_LA) + ((size_t)bd * 68) * 1024 + ch * 2; float* cr = WSP(float, WS_LH) + ((size_t)bd * 68) * 512 + ch;
    float h = 0.f;
#pragma unroll 17
    for (int kk = 0; kk < 68; ++kk) { cr[(size_t)kk * 512] = h; const f32x2_t ab = *(const f32x2_t*)(ag + (size_t)kk * 1024); h = ab.x * h + ab.y; }
}
template <int PASS>
__device__ __forceinline__ void ph_lru(Fr& F) {
    const Ptrs& P = F.P; const int lane = F.lane, w = F.wave, ch = w * 64 + lane, fr = lane & 15, fq = lane >> 4;
    LAS unsigned char* At = (LAS unsigned char*)F.lds + w * LRU_WB; LAS unsigned char* Gt = At + LRU_AT; LAS unsigned char* Ht = Gt + LRU_GT;
    const float* Z = WSP(float, WS_Z); const bf16* WRI = WSP(bf16, WS_WRI);
    float* AGG = WSP(float, WS_LA);
    for (int unit = F.blk; unit < NB * 68; unit += F.nblk) {
        const int b = unit / 68, k = unit % 68;
        const bool isctx = k < 4; const int T = isctx ? CTX : SEQ, t0 = isctx ? 64 * k : 64 * (k - 4), segrow0 = isctx ? NL + b * CTX : b * SEQ;
#pragma unroll 1
        for (int dir = 0; dir < 2; ++dir) {
            const int kd = dir == 0 ? k : (isctx ? 3 - k : 71 - k);
            const float cw0 = P.in[9][(dir * 4 + 0) * 512 + ch], cw1 = P.in[9][(dir * 4 + 1) * 512 + ch], cw2 = P.in[9][(dir * 4 + 2) * 512 + ch], cw3 = P.in[9][(dir * 4 + 3) * 512 + ch];
            const float cb = P.in[10][dir * 512 + ch], br = P.in[12][dir * 512 + ch], bi = P.in[14][dir * 512 + ch];
            const float sp8 = -8.f * log1pf(__expf(-P.in[15][dir * 512 + ch]));
            bf16x8 wf[2][2][4];
#pragma unroll
            for (int gate = 0; gate < 2; ++gate)
#pragma unroll
                for (int ks = 0; ks < 2; ++ks)
#pragma unroll
                    for (int n = 0; n < 4; ++n) wf[gate][ks][n] = *(const bf16x8*)(WRI + ((size_t)(dir * 8 + w) * 128 + gate * 64 + 16 * n + fr) * 64 + 32 * ks + 8 * fq);
            float uw[LRU_ST + 3], un[LRU_ST + 3], gv[LRU_ST], gn[LRU_ST];
#define LRU_LOAD(dstu, dstg, st_) do { const int _sub = dir == 0 ? (st_) : LRU_NST - 1 - (st_); const int _ts = t0 + LRU_ST * _sub; \
                _Pragma("unroll") for (int q = 0; q < LRU_ST + 3; ++q) { const int t = dir == 0 ? _ts - 3 + q : _ts + LRU_ST + 2 - q; const bool ok = t >= 0 && t < T; \
                    dstu[q] = ok ? Z[(size_t)(segrow0 + (ok ? t : 0)) * ZLD + ch] : 0.f; } \
                if (PASS == 1 && dir == 1) { _Pragma("unroll") for (int i = 0; i < LRU_ST; ++i) dstg[i] = Z[(size_t)(segrow0 + _ts + LRU_ST - 1 - i) * ZLD + 512 + ch]; } } while (0)
            LRU_LOAD(uw, gv, 0);
            float h = 0.f, pa = 1.f;
            if (PASS == 1) h = WSP(float, WS_LH)[((size_t)(b * 2 + dir) * 68 + kd) * 512 + ch];
#pragma unroll 1
            for (int st = 0; st < LRU_NST; ++st) {
                const int sub = dir == 0 ? st : LRU_NST - 1 - st;
                if (st + 1 < LRU_NST) LRU_LOAD(un, gn, st + 1);
                float xf[LRU_ST], rg[LRU_ST];
#pragma unroll
                for (int i = 0; i < LRU_ST; ++i) xf[i] = cb + cw0 * uw[i] + cw1 * uw[i + 1] + cw2 * uw[i + 2] + cw3 * uw[i + 3];
#pragma unroll
                for (int i = 0; i < LRU_ST; ++i) *(LAS bf16*)(At + i * 144 + lane * 2) = (bf16)f2bf(xf[i]);
#pragma unroll
                for (int gate = 0; gate < 2; ++gate) {
                    f32x4 acc[4];
#pragma unroll
                    for (int n = 0; n < 4; ++n) acc[n] = (f32x4){0.f, 0.f, 0.f, 0.f};
#pragma unroll
                    for (int ks = 0; ks < 2; ++ks) {
                        const bf16x8 af0 = *(const LAS bf16x8*)(At + fr * 144 + (32 * ks + 8 * fq) * 2);
#pragma unroll
                        for (int n = 0; n < 4; ++n) acc[n] = __builtin_amdgcn_mfma_f32_16x16x32_bf16(wf[gate][ks][n], af0, acc[n], 0, 0, 0);
                    }
#pragma unroll
                    for (int n = 0; n < 4; ++n) *(LAS f32x4*)(Gt + fr * 272 + (16 * n + 4 * fq) * 4) = acc[n];
#pragma unroll
                    for (int i = 0; i < LRU_ST; ++i) { const float pre = *(const LAS float*)(Gt + i * 272 + lane * 4);
                        if (gate == 0) rg[i] = sigmoidf_(pre + br);
                        else { const float gi = sigmoidf_(pre + bi); const float a = __expf(sp8 * rg[i]); rg[i] = a; xf[i] = sqrtf(fmaxf(1.f - a * a, 0.f)) * (gi * xf[i]); } }
                }
#pragma unroll
                for (int i = 0; i < LRU_ST; ++i) { const int tl = dir == 0 ? LRU_ST * sub + i : LRU_ST * sub + LRU_ST - 1 - i;
                    h = rg[i] * h + xf[i]; if (PASS == 0) pa *= rg[i];
                    if (PASS == 1) {
                        if (dir == 0) *(LAS bf16*)(Ht + tl * 128 + lane * 2) = (bf16)f2bf(h);
                        else { const float hf = bf2f(*(const LAS bf16*)(Ht + tl * 128 + lane * 2)); const size_t row = (size_t)(segrow0 + t0 + tl);
                            WSP(bf16, WS_YM)[row * D + ch] = (bf16)f2bf((hf + h) * gelu_fast(gv[i])); } } }
#pragma unroll
                for (int q = 0; q < LRU_ST + 3; ++q) uw[q] = un[q];
                if (PASS == 1) {
#pragma unroll
                    for (int i = 0; i < LRU_ST; ++i) gv[i] = gn[i]; }
            }
#undef LRU_LOAD
            if (PASS == 0) { f32x2_t o; o.x = pa; o.y = h; *(f32x2_t*)(AGG + ((size_t)(b * 2 + dir) * 68 + kd) * 1024 + ch * 2) = o; }
        }
    }
}

__device__ __forceinline__ void ph_oprep(Fr& F) {
    const Ptrs& P = F.P; const int lane = F.lane, sub = lane >> 4, d4 = lane & 15;
    const float* Z = WSP(float, WS_Z); bf16* QG = WSP(bf16, WS_QG); bf16* KG = WSP(bf16, WS_KG); bf16* VGT = WSP(bf16, WS_VG);
    const float* ropeG = WSP(float, WS_ROPEG);
    LAS unsigned char* scr = (LAS unsigned char*)F.lds + F.wave * 4096;
    const f32x4 gq = *(const f32x4*)(P.in[24] + 4 * d4), gk = *(const f32x4*)(P.in[24] + 64 + 4 * d4);
    for (int g = F.gw; g < NT / 8; g += F.ngw) {
        const int r0 = g * 8; int b, s0; row_bs(r0, b, s0);
        const bool lat = r0 < NL;
#pragma unroll 2
        for (int rr = 0; rr < 8; ++rr) {
            const int s = s0 + rr; const float* z = Z + (size_t)(r0 + rr) * ZLD;
            f32x4 cs = {1.f, 1.f, 1.f, 1.f}, sn = {0.f, 0.f, 0.f, 0.f};
            if (lat) { const float* rp = ropeG + ((size_t)s * 32 + 4 * (d4 & 7)) * 2; const f32x4 c0 = *(const f32x4*)rp, c1 = *(const f32x4*)(rp + 4);
                cs = (f32x4){c0.x, c0.z, c1.x, c1.z}; sn = (f32x4){c0.y, c0.w, c1.y, c1.w}; }
            if (d4 >= 8) sn = -sn;
            if (lat) {
#pragma unroll
                for (int pass = 0; pass < 4; ++pass) { const int hd = 4 * pass + sub;
                    f32x4 x = *(const f32x4*)(z + hd * 64 + 4 * d4);
                    const float rs = rsqrtf(reduce16(dot4(x)) * (1.f / 64.f) + 1e-6f);
                    x = x * rs * gq;
                    f32x4 xo; xo.x = dppf<0x128>(x.x); xo.y = dppf<0x128>(x.y); xo.z = dppf<0x128>(x.z); xo.w = dppf<0x128>(x.w);
                    x = x * cs - xo * sn;
                    u32x2 w; w.x = pk2(x.x, x.y); w.y = pk2(x.z, x.w); *(u32x2*)(QG + (((size_t)b * 16 + hd) * SEQ + s) * 64 + 4 * d4) = w; } }
            { f32x4 x = *(const f32x4*)(z + 1024 + sub * 64 + 4 * d4);
              const float rs = rsqrtf(reduce16(dot4(x)) * (1.f / 64.f) + 1e-6f);
              x = x * rs * gk;
              f32x4 xo; xo.x = dppf<0x128>(x.x); xo.y = dppf<0x128>(x.y); xo.z = dppf<0x128>(x.z); xo.w = dppf<0x128>(x.w);
              x = x * cs - xo * sn;
              u32x2 w; w.x = pk2(x.x, x.y); w.y = pk2(x.z, x.w); *(u32x2*)(KG + (((size_t)b * 4 + sub) * TA + s) * 64 + 4 * d4) = w;
              const f32x4 vx = *(const f32x4*)(z + 1280 + sub * 64 + 4 * d4);
              w.x = pk2(vx.x, vx.y); w.y = pk2(vx.z, vx.w); *(LAS u32x2*)(scr + (sub * 8 + rr) * 128 + 8 * d4) = w; }
        }
#pragma unroll
        for (int hh = 0; hh < 4; ++hh) {
            unsigned short t8[8];
#pragma unroll
            for (int rr = 0; rr < 8; ++rr) t8[rr] = *(const LAS unsigned short*)(scr + (hh * 8 + rr) * 128 + 2 * lane);
            u32x4 w; w.x = t8[0] | ((unsigned)t8[1] << 16); w.y = t8[2] | ((unsigned)t8[3] << 16); w.z = t8[4] | ((unsigned)t8[5] << 16); w.w = t8[6] | ((unsigned)t8[7] << 16);
            *(u32x4*)(VGT + (((size_t)b * 4 + hh) * 64 + lane) * TA + s0) = w;
        }
    }
}
__device__ __forceinline__ void ph_attn_gqa(Fr& F) {
    const Ptrs& P = F.P;
    const int x = F.blk & 7, j = F.blk >> 3;
    const float c = 0.125f * 1.4426950408889634f;
    for (int rd = 0; ; ++rd) {
        int pair, qblk;
        if (F.nblk == 256) { if (rd >= 4) break; pair = rd * 4 + (x >> 1); qblk = 32 * (x & 1) + j; }
        else { const int u = rd * F.nblk + F.blk; if (u >= 1024) break; pair = u >> 6; qblk = u & 63; }
        const int b = pair >> 2, kh = pair & 3, head = kh * 4 + (F.wave >> 1);
        const int qpos = qblk * 64 + 32 * (F.wave & 1) + (F.lane & 31);
        const int a0 = qblk - 2 < 0 ? 0 : qblk - 2, a1 = qblk + 3 > 64 ? 64 : qblk + 3;
        attn_unit<64, true>((LAS unsigned char*)F.lds, WSP(bf16, WS_QG) + (((size_t)b * 16 + head) * SEQ + qpos) * 64, WSP(bf16, WS_KG) + ((size_t)b * 4 + kh) * TA * 64,
                            WSP(bf16, WS_VG) + ((size_t)b * 4 + kh) * 64 * TA, a0, a1, 64, 68, c, qpos, qblk, P.in[25][head] * 1.4426950408889634f,
                            WSP(bf16, WS_YM) + ((size_t)b * SEQ + qpos) * D + head * 64, F.tid, F.lane);
    }
}

__device__ __forceinline__ void ph_router(Fr& F, int layer, int nrows, int dummy = 0) {
    const Ptrs& P = F.P; const int lane = F.lane;
    const float* MOD = WSP(float, WS_MOD); const float* X1 = WSP(float, WS_X1);
    { const f32x4* src = (const f32x4*)(WSP(float, WS_WRT) + (size_t)layer * 32 * 1024); LAS f32x4* dst = (LAS f32x4*)F.lds;
#pragma unroll 4
      for (int i = 0; i < 16; ++i) dst[F.tid + NTHR * i] = src[F.tid + NTHR * i];
      __syncthreads(); }
    const LAS float* wl = (const LAS float*)F.lds;
    int* cnt = (int*)(P.ws + WS_CTL + CW_CNT) + layer * NE + (dummy ? 64 : 0);
    unsigned char* const wsd = P.ws + (dummy ? (WS_XF - WS_F) : 0);
    LAS int* lcnt = (LAS int*)((LAS unsigned char*)F.lds + LDS_MISC + 4096); LAS int* lbase = lcnt + 32;
    LAS int* rec = (LAS int*)((LAS unsigned char*)F.lds + LDS_MISC + 4608) + F.wave * 80;
    if (F.tid < 32) lcnt[F.tid] = 0;
    __syncthreads();
    const int e8 = ((lane >> 5) & 1) * 4 + ((lane >> 4) & 1) * 2 + ((lane >> 3) & 1);
    int it = 0;
    for (int r0 = F.gw * 2; r0 < nrows; r0 += F.ngw * 2, ++it) {
        RowV v[2];
#pragma unroll
        for (int rr = 0; rr < 2; ++rr) { v[rr] = load_row(X1 + (size_t)(r0 + rr) * D, lane);
            const float* m = MOD + (size_t)(layer * 5 + mod_row(r0 + rr)) * 6144;
            norm_mod(v[rr], P.in[7] + layer * D, m + 4 * 1024, m + 3 * 1024, lane);
            { unsigned* f8 = (unsigned*)(wsd + WS_F + (size_t)(r0 + rr) * D) + lane;
#pragma unroll
              for (int j = 0; j < 4; ++j) f8[64 * j] = pk4_fp8(v[rr].v[j].x, v[rr].v[j].y, v[rr].v[j].z, v[rr].v[j].w); } }
        float lg[2][4];
        int zoff = 0; asm volatile("" : "+v"(zoff));
#pragma unroll
        for (int grp = 0; grp < 4; ++grp) {
            float acc[2][8];
#pragma unroll
            for (int e = 0; e < 8; ++e) { const LAS f32x4* w = (const LAS f32x4*)(wl + (grp * 8 + e) * 1024) + lane + zoff;
                const f32x4 w0 = w[0], w1 = w[64], w2 = w[128], w3 = w[192];
#pragma unroll
                for (int rr = 0; rr < 2; ++rr) { const f32x4 p = v[rr].v[0] * w0 + v[rr].v[1] * w1 + v[rr].v[2] * w2 + v[rr].v[3] * w3; acc[rr][e] = (p.x + p.y) + (p.z + p.w); }
                if ((e & 3) == 3) asm volatile("" : "+v"(zoff) : "v"(acc[1][e])); }
            const float bias = P.in[28][layer * NE + grp * 8 + e8];
#pragma unroll
            for (int rr = 0; rr < 2; ++rr) {
                float (&a)[8] = acc[rr];
#pragma unroll
                for (int i = 0; i < 4; ++i) { const bool hi = lane & 32; const float send = hi ? a[i] : a[i + 4], keep = hi ? a[i + 4] : a[i]; a[i] = keep + __shfl_xor(send, 32); }
#pragma unroll
                for (int i = 0; i < 2; ++i) { const bool hi = lane & 16; const float send = hi ? a[i] : a[i + 2], keep = hi ? a[i + 2] : a[i]; a[i] = keep + __shfl_xor(send, 16); }
                { const bool hi = lane & 8; const float send = hi ? a[0] : a[1], keep = hi ? a[1] : a[0]; a[0] = keep + dppf<0x128>(send); }
                float t = a[0]; t += dppf<0xB1>(t); t += dppf<0x4E>(t); t += dppf<0x141>(t);
                lg[rr][grp] = t + bias;
            }
        }
#pragma unroll
        for (int rr = 0; rr < 2; ++rr) {
            float c[4] = {lg[rr][0], lg[rr][1], lg[rr][2], lg[rr][3]};
            int te[4]; float tv[4];
#pragma unroll
            for (int k = 0; k < 4; ++k) {
                float bv = c[0]; int bi = e8;
#pragma unroll
                for (int g = 1; g < 4; ++g) { const bool take = c[g] > bv; bv = take ? c[g] : bv; bi = take ? 8 * g + e8 : bi; }
#pragma unroll
                for (int o = 8; o < 64; o <<= 1) { const float ov = __shfl_xor(bv, o); const int oi = __shfl_xor(bi, o); const bool take = ov > bv || (ov == bv && oi < bi); bv = take ? ov : bv; bi = take ? oi : bi; }
                te[k] = bi; tv[k] = bv;
#pragma unroll
                for (int g = 0; g < 4; ++g) c[g] = (bi == 8 * g + e8) ? -3.4e38f : c[g]; }
            const float e1 = __expf(tv[1] - tv[0]), e2 = __expf(tv[2] - tv[0]), e3 = __expf(tv[3] - tv[0]); const float inv = 1.f / (1.f + e1 + e2 + e3);
            if (lane < 4) { const int e = lane == 0 ? te[0] : lane == 1 ? te[1] : lane == 2 ? te[2] : te[3]; const float g = (lane == 0 ? 1.f : lane == 1 ? e1 : lane == 2 ? e2 : e3) * inv;
                const int rank = __hip_atomic_fetch_add(lcnt + e, 1, __ATOMIC_RELAXED, __HIP_MEMORY_SCOPE_WORKGROUP);
                rec[((it * 2 + rr) * 4 + lane) * 2] = e | (rank << 8); rec[((it * 2 + rr) * 4 + lane) * 2 + 1] = __float_as_int(g); }
        }
    }
    __syncthreads();
    if (F.tid < 32) lbase[F.tid] = atomicAdd(&cnt[F.tid], lcnt[F.tid]);
    __syncthreads();
    it = 0;
    for (int r0 = F.gw * 2; r0 < nrows; r0 += F.ngw * 2, ++it) {
        if (lane < 8) { const int rr = lane >> 2, k = lane & 3, r = r0 + rr; const int er = rec[((it * 2 + rr) * 4 + k) * 2]; const int e = er & 255, slot = lbase[e] + (er >> 8);
            ((int*)(wsd + WS_TOK))[(size_t)e * NT + slot] = r;
            ((int*)(wsd + WS_PE))[r * 4 + k] = e; ((int*)(wsd + WS_PS))[r * 4 + k] = slot; ((int*)(wsd + WS_PG))[r * 4 + k] = rec[((it * 2 + rr) * 4 + k) * 2 + 1]; }
    }
}
template <int MODE>
__device__ __forceinline__ void ph_combine(Fr& F, int layer, int nrows) {
    const Ptrs& P = F.P; const int lane = F.lane;
    moe_prefix(F, layer);
    const int* pre = (const int*)(F.lds + LDS_MISC + 64);
    const float* MOD = WSP(float, WS_MOD); const float* X1 = WSP(float, WS_X1); const bf16* Y = WSP(bf16, WS_Y);
    for (int r = F.gw; r < nrows; r += F.ngw) {
        RowV v = load_row(X1 + (size_t)r * D, lane);
        const float* g2 = MOD + (size_t)(layer * 5 + mod_row(r)) * 6144 + 5 * 1024;
        RowV acc;
#pragma unroll
        for (int j = 0; j < 4; ++j) acc.v[j] = (f32x4){0.f, 0.f, 0.f, 0.f};
#pragma unroll
        for (int k = 0; k < 4; ++k) { const int e = WSP(int, WS_PE)[r * 4 + k], slot = WSP(int, WS_PS)[r * 4 + k]; const float g = WSP(float, WS_PG)[r * 4 + k];
            const u32x2* y = (const u32x2*)(Y + ((size_t)pre[e] * 256 + slot) * D) + lane;
#pragma unroll
            for (int j = 0; j < 4; ++j) { const u32x2 w = y[64 * j]; acc.v[j] += (f32x4){bflo(w.x), bfhi(w.x), bflo(w.y), bfhi(w.y)} * g; } }
#pragma unroll
        for (int j = 0; j < 4; ++j) v.v[j] += ((const f32x4*)g2)[lane + 64 * j] * acc.v[j];
        if (MODE == 0) {
            f32x4* xo = (f32x4*)(WSP(float, WS_X2) + (size_t)r * D) + lane;
#pragma unroll
            for (int j = 0; j < 4; ++j) xo[64 * j] = v.v[j];
            const float* m = MOD + (size_t)(1 * 5 + mod_row(r)) * 6144;
            norm_mod(v, P.in[6] + D, m + 1024, m, lane);
            store_row_bf16(WSP(bf16, WS_HN) + (size_t)r * D, v, lane);
        } else {
            f32x4* xo = (f32x4*)(P.out + (size_t)r * D) + lane;
#pragma unroll
            for (int j = 0; j < 4; ++j) xo[64 * j] = v.v[j];
        }
    }
}

constexpr int NPHASE = 20;
struct Args { Ptrs P; int ph_lo, ph_hi, bar_idx, variant; };
__global__ void __launch_bounds__(NTHR, 2) mk_fwd(Args args) {
    extern __shared__ __attribute__((aligned(16))) unsigned char lds[];
    Fr F; F.P = args.P; F.lds = lds;
    F.tid = threadIdx.x; F.lane = F.tid & 63; F.wave = __builtin_amdgcn_readfirstlane(F.tid >> 6);
    F.nblk = gridDim.x; F.blk = blockIdx.x; F.gw = F.blk * NWAVES + F.wave; F.ngw = F.nblk * NWAVES;
    F.gtid = (size_t)F.blk * NTHR + F.tid; F.gsz = (size_t)F.nblk * NTHR;
    const Ptrs& P = F.P;
    if (F.tid < 64) ((unsigned*)(lds + LDS_MISC))[F.tid] = 0u;
    __syncthreads();
    const int lo = args.ph_lo, hi = args.ph_hi;
    unsigned* barw = (unsigned*)(P.ws + WS_CTL) + args.bar_idx * XCD_BAR_WORDS;
    XcdBarrier bar; bar.bar = barw; bar.x = 0; bar.st = nullptr;
    if (hi - lo > 1) bar = xcd_barrier_post(barw, (volatile LAS unsigned*)(lds + LDS_MISC));
#ifndef PROBE_MASK
#define PROBE_MASK 0u
#endif
#define IN(k) (lo <= (k) && (k) < hi)
#define REP(k) for (int _rep = 0; _rep < (((PROBE_MASK >> (k)) & 1u) ? 2 : 1); ++_rep)
#define SEAM(k) do { if (IN(k) && IN((k) + 1)) xcd_barrier(bar); } while (0)
    const float* MOD = WSP(float, WS_MOD);
    if (IN(0)) REP(0) { ph_prologue(F); } if (IN(0)) conv_fill<0>(F); SEAM(0);
    if (IN(1)) REP(1) { ph_norm0(F); } SEAM(1);
    if (IN(2)) REP(2) { ph_gemm(F, WSP(bf16, WS_HN), 1024, WSP(bf16, WS_WIN), 1024, NT, 1536, 1024, GF32{EpiF32{WSP(float, WS_Z), ZLD, EVEN_IN}}); } if (IN(2)) conv_fill<2>(F); SEAM(2);
    if (IN(3)) { REP(20) { ph_e3(F); } REP(21) { ph_lru<0>(F); } } if (IN(3)) conv_fill<3>(F); SEAM(3);
    if (IN(4)) REP(4) { ph_gemm(F, WSP(bf16, WS_QKVN), 384, WSP(bf16, WS_WQKVB), 384, NT, 1792, 384, GF32{EpiF32{WSP(float, WS_QKVR), 1792, 1792}}); ph_lru_carry(F); } SEAM(4);
    if (IN(5)) { REP(22) { ph_lru<1>(F); } REP(23) { ph_e5(F); } } if (IN(5)) conv_fill<5>(F); SEAM(5);
    if (IN(6)) REP(6) { ph_attn_mla(F); } SEAM(6);
    if (IN(7)) REP(7) { ph_gemm(F, WSP(bf16, WS_YM), 1024, WSP(bf16, WS_WOE), 1024, NT, 1024, 1024, GResid{P.in[0], P.in[2], WSP(float, WS_X1), MOD + 2 * 1024}); } if (IN(7)) conv_fill<7>(F); SEAM(7);
    if (IN(8)) REP(8) { ph_router(F, 0, NT, args.variant); } SEAM(8);
    if (IN(9)) REP(9) { ph_moe_gemm<1>(F, 0, args.variant); } SEAM(9);
    if (IN(10)) REP(10) { ph_moe_gemm<2>(F, 0, args.variant); } if (IN(10)) conv_fill<10>(F); SEAM(10);
    if (IN(11)) REP(11) { ph_combine<0>(F, 0, NT); } if (IN(11)) conv_fill<11>(F); SEAM(11);
    if (IN(12)) REP(12) { ph_gemm(F, WSP(bf16, WS_HN), 1024, WSP(bf16, WS_WQO), 1024, NT, 1536, 1024, GF32{EpiF32{WSP(float, WS_Z), ZLD, 1536}}); } if (IN(12)) conv_fill<12>(F); SEAM(12);
    if (IN(13)) REP(13) { ph_oprep(F); } SEAM(13);
    if (IN(14)) REP(14) { ph_attn_gqa(F); } SEAM(14);
    if (IN(15)) REP(15) { ph_gemm(F, WSP(bf16, WS_YM), 1024, WSP(bf16, WS_WOO), 1024, NL, 1024, 1024, GResid{WSP(float, WS_X2), WSP(float, WS_X2) + (size_t)NL * D, WSP(float, WS_X1), MOD + 5 * 6144 + 2 * 1024}); } SEAM(15);
    if (IN(16)) REP(16) { ph_router(F, 1, NL, args.variant); } SEAM(16);
    if (IN(17)) REP(17) { ph_moe_gemm<1>(F, 1); } SEAM(17);
    if (IN(18)) REP(18) { ph_moe_gemm<2>(F, 1); } SEAM(18);
    if (IN(19)) REP(19) { ph_combine<1>(F, 1, NL); }
#undef IN
#undef SEAM
}

#ifndef MK_N_LAUNCHES
#define MK_N_LAUNCHES 1
#endif
extern "C" void kernel_launch(void* const* d_in, const int* in_sizes, int n_in, void* d_out, int out_size, void* d_ws, size_t ws_size, hipStream_t stream) {
    static int grid = 0;
    if (grid == 0) {
        if (n_in != 33 || ws_size < WS_END) { fprintf(stderr, "kernel_launch: unexpected n_in %d or ws_size %zu < %zu\n", n_in, ws_size, (size_t)WS_END); grid = -1; return; }
        int dev = 0, cus = 0, per_cu = 0;
        if (hipGetDevice(&dev) != hipSuccess || hipDeviceGetAttribute(&cus, hipDeviceAttributeMultiprocessorCount, dev) != hipSuccess) { grid = -1; return; }
        if (hipFuncSetAttribute((const void*)mk_fwd, hipFuncAttributeMaxDynamicSharedMemorySize, LDS_BYTES) != hipSuccess) { fprintf(stderr, "kernel_launch: hipFuncSetAttribute failed\n"); grid = -1; return; }
        if (hipOccupancyMaxActiveBlocksPerMultiprocessor(&per_cu, (const void*)mk_fwd, NTHR, LDS_BYTES) != hipSuccess || per_cu < 1) { fprintf(stderr, "kernel_launch: occupancy query says %d blocks per CU\n", per_cu); grid = -1; return; }
        (void)hipGetLastError();
        grid = cus;
    }
    if (grid < 0) return;
    Args a{};
    for (int i = 0; i < 33; ++i) a.P.in[i] = (const float*)d_in[i];
    a.P.out = (float*)d_out; a.P.ws = (unsigned char*)d_ws;
    (void)hipMemsetAsync((unsigned char*)d_ws + WS_CTL, 0, CTL_BYTES, stream);
    a.bar_idx = 0; a.variant = 0;
#if defined(PROBE_PHASE)
    { const int k = PROBE_PHASE; a.ph_lo = 0; a.ph_hi = k; a.bar_idx = 0; hipLaunchKernelGGL(mk_fwd, dim3(grid), dim3(NTHR), LDS_BYTES, stream, a);
      for (int r = 0; r < PROBE_REPEAT; ++r) { a.ph_lo = k; a.ph_hi = k + 1; a.bar_idx = 2; a.variant = PROBE_VARIANT; hipLaunchKernelGGL(mk_fwd, dim3(grid), dim3(NTHR), LDS_BYTES, stream, a); }
      a.variant = 0; a.ph_lo = k; a.ph_hi = NPHASE; a.bar_idx = 1; hipLaunchKernelGGL(mk_fwd, dim3(grid), dim3(NTHR), LDS_BYTES, stream, a); }
#else
    a.ph_lo = 0; a.ph_hi = NPHASE; hipLaunchKernelGGL(mk_fwd, dim3(grid), dim3(NTHR), LDS_BYTES, stream, a);
#endif
}
```

```cpp
#include <hip/hip_runtime.h>
#include <stdint.h>
#include <stdio.h>

typedef unsigned short bf16;
typedef short bf16x8 __attribute__((ext_vector_type(8)));
typedef float f32x4 __attribute__((ext_vector_type(4)));
typedef float f32x16 __attribute__((ext_vector_type(16)));
typedef unsigned u32x2 __attribute__((ext_vector_type(2)));
typedef unsigned u32x4 __attribute__((ext_vector_type(4)));
typedef int i32x8 __attribute__((ext_vector_type(8)));
typedef int i32x4 __attribute__((ext_vector_type(4)));

constexpr int D = 1024, NB = 4, SEQ = 4096, CTX = 256;
constexpr int NL = NB * SEQ, NC = NB * CTX, NT = NL + NC;
constexpr int TA = SEQ + CTX;
constexpr int NE = 32, TOPK = 4;
constexpr int EVEN_IN = 1440, ZLD = 1536;
constexpr int MAXT256 = 304;
constexpr int ACT_ROWS = MAXT256 * 256;

constexpr size_t al256(size_t x) { return (x + 255) & ~(size_t)255; }
constexpr size_t WS_CTL = 0, CTL_BYTES = 128u << 10;
constexpr size_t CW_CNT = 65536;
constexpr size_t WS_MOD = WS_CTL + CTL_BYTES;
constexpr size_t WS_ROPEM = al256(WS_MOD + 2 * 5 * 6144 * 4);
constexpr size_t WS_ROPEG = al256(WS_ROPEM + 4096 * 16 * 2 * 4);
constexpr size_t WS_WRT = al256(WS_ROPEG + 4096 * 32 * 2 * 4);
constexpr size_t WS_WRI = al256(WS_WRT + 2 * 32 * 1024 * 4);
constexpr size_t WS_WIN = al256(WS_WRI + 2 * 8 * 128 * 64 * 2);
constexpr size_t WS_WQKVB = al256(WS_WIN + 1536 * 1024 * 2);
constexpr size_t WS_WOE = al256(WS_WQKVB + 1792 * 384 * 2);
constexpr size_t WS_WQO = al256(WS_WOE + 1024 * 1024 * 2);
constexpr size_t WS_WOO = al256(WS_WQO + 1536 * 1024 * 2);
constexpr size_t WS_WGU = al256(WS_WOO + 1024 * 1024 * 2);
constexpr size_t WS_WDN = al256(WS_WGU + (size_t)2 * 32 * 2048 * 1024 * 2);
constexpr size_t WS_HN = al256(WS_WDN + (size_t)2 * 32 * 1024 * 1024 * 2);
constexpr size_t WS_Z = al256(WS_HN + (size_t)NT * D * 2);
constexpr size_t WS_QKVN = al256(WS_Z + (size_t)NT * ZLD * 4);
constexpr size_t WS_QKVR = al256(WS_QKVN + (size_t)NT * 384 * 2);
constexpr size_t WS_QM = al256(WS_QKVR + (size_t)NT * 1792 * 4);
constexpr size_t WS_KM = al256(WS_QM + (size_t)NB * 8 * TA * 96 * 2);
constexpr size_t WS_VM = al256(WS_KM + (size_t)NB * 8 * TA * 96 * 2);
constexpr size_t WS_QG = al256(WS_VM + (size_t)NB * 8 * TA * 64 * 2);
constexpr size_t WS_KG = al256(WS_QG + (size_t)NB * 16 * SEQ * 64 * 2);
constexpr size_t WS_VG = al256(WS_KG + (size_t)NB * 4 * TA * 64 * 2);
constexpr size_t WS_YM = al256(WS_VG + (size_t)NB * 4 * TA * 64 * 2);
constexpr size_t WS_X1 = al256(WS_YM + (size_t)NT * D * 2);
constexpr size_t WS_X2 = al256(WS_X1 + (size_t)NT * D * 4);
constexpr size_t WS_F = al256(WS_X2 + (size_t)NT * D * 4);
constexpr size_t WS_LA = al256(WS_F + (size_t)NT * D * 2);
constexpr size_t WS_LB = al256(WS_LA + (size_t)2 * NT * 512 * 4);
constexpr size_t WS_LH = al256(WS_LB + (size_t)2 * NT * 512 * 4);
constexpr size_t WS_XF = al256(WS_LH + (size_t)2 * NT * 512 * 4);
constexpr size_t WS_PE = al256(WS_XF + (size_t)2 * NT * 512 * 4);
constexpr size_t WS_PS = al256(WS_PE + (size_t)NT * 4 * 4);
constexpr size_t WS_PG = al256(WS_PS + (size_t)NT * 4 * 4);
constexpr size_t WS_TOK = al256(WS_PG + (size_t)NT * 4 * 4);
constexpr size_t WS_ACT = al256(WS_TOK + (size_t)NE * NT * 4);
constexpr size_t WS_Y = al256(WS_ACT + (size_t)ACT_ROWS * D * 2);
constexpr size_t WS_END = al256(WS_Y + (size_t)ACT_ROWS * D * 2);

__device__ __forceinline__ unsigned f2bf(float f) { unsigned u = __float_as_uint(f); u += 0x7FFFu + ((u >> 16) & 1u); return u >> 16; }
typedef float f32x2_t __attribute__((ext_vector_type(2)));
typedef __bf16 bf16x2_t __attribute__((ext_vector_type(2)));
__device__ __forceinline__ unsigned pk2(float a, float b) { const f32x2_t v = {a, b}; return __builtin_bit_cast(unsigned, __builtin_convertvector(v, bf16x2_t)); }

__device__ __forceinline__ unsigned pk4_fp8(float a, float b, float c, float d) { unsigned w = 0; w = __builtin_amdgcn_cvt_pk_fp8_f32(a, b, w, false); w = __builtin_amdgcn_cvt_pk_fp8_f32(c, d, w, true); return w; }
__device__ __forceinline__ float bf2f(unsigned b) { return __uint_as_float(b << 16); }
__device__ __forceinline__ float bflo(unsigned u) { return __uint_as_float(u << 16); }
__device__ __forceinline__ float bfhi(unsigned u) { return __uint_as_float(u & 0xffff0000u); }
__device__ __forceinline__ float wave_sum(float v) {
#pragma unroll
    for (int o = 1; o < 64; o <<= 1) v += __shfl_xor(v, o);
    return v;
}

template <int CTRL> __device__ __forceinline__ float dppf(float v) { return __int_as_float(__builtin_amdgcn_update_dpp(0, __float_as_int(v), CTRL, 0xf, 0xf, true)); }
__device__ __forceinline__ float reduce16(float v) { v += dppf<0xB1>(v); v += dppf<0x4E>(v); v += dppf<0x124>(v); v += dppf<0x128>(v); return v; }
__device__ __forceinline__ float dot4(f32x4 a) { return a.x * a.x + a.y * a.y + a.z * a.z + a.w * a.w; }
__device__ __forceinline__ float sigmoidf_(float x) { return 1.f / (1.f + __expf(-x)); }
__device__ __forceinline__ float gelu_tanh(float x) { const float u = 0.7978845608028654f * (x + 0.044715f * x * x * x); return 0.5f * x * (1.f + tanhf(u)); }
__device__ __forceinline__ int mod_row(int r) { return r < NL ? (r >> 12) : 4; }
__device__ __forceinline__ void row_bs(int r, int& b, int& s) { if (r < NL) { b = r >> 12; s = r & 4095; } else { const int rc = r - NL; b = rc >> 8; s = SEQ + (rc & 255); } }


struct Ptrs {
    const float* in[33];
    float* out;
    unsigned char* ws;
};
#define WSP(T, off) ((T*)(P.ws + (off)))
#define LAS __attribute__((address_space(3)))

#define XB_TMO      128
#define XB_XCNT(j)  (256  + 64 * (j))
#define XB_XSUB(j)  (1280 + 64 * (j))
#define XB_XGEN(j)  (2304 + 64 * (j))
#define XB_TOP      3328
#define XB_TOPGEN   3392
#define XCD_BAR_WORDS 3456
#define XB_SPIN_CAP (1u << 18)
__device__ __forceinline__ unsigned xb_ld(unsigned* p)              { return __hip_atomic_load(p, __ATOMIC_RELAXED, __HIP_MEMORY_SCOPE_AGENT); }
__device__ __forceinline__ unsigned xb_add(unsigned* p, unsigned v) { return __hip_atomic_fetch_add(p, v, __ATOMIC_RELAXED, __HIP_MEMORY_SCOPE_AGENT); }
__device__ __forceinline__ unsigned xb_xcc_id() { return (unsigned)__builtin_amdgcn_s_getreg((3 << 11) | 20) & 0xFu; }
#define XB_SPIN(cond, bar) do { unsigned _sp = 0; while (cond) { __builtin_amdgcn_s_sleep(1); \
    if ((++_sp & 255u) == 0u) { if (xb_ld(&(bar)[XB_TMO])) break; if (_sp > XB_SPIN_CAP) { atomicAdd(&(bar)[XB_TMO], 1u); break; } } } } while (0)
struct XcdBarrier { unsigned* bar; unsigned x; volatile LAS unsigned* st; };
__device__ __forceinline__ XcdBarrier xcd_barrier_post(unsigned* bar, volatile LAS unsigned* st) {
    XcdBarrier b; b.bar = bar; b.x = xb_xcc_id(); b.st = st;
    if (threadIdx.x == 0) (void)xb_add(&bar[XB_XCNT(b.x)], 1u);
    return b;
}
__device__ __forceinline__ void xcd_barrier_complete(unsigned* bar, unsigned x, unsigned& nloc, unsigned& nx) {
    const unsigned G = gridDim.x * gridDim.y * gridDim.z;
    unsigned sum, cnt, mine, sp = 0u;
    for (;;) {
        sum = 0u; cnt = 0u; mine = 0u;
#pragma unroll
        for (unsigned j = 0; j < 16; ++j) { const unsigned c = xb_ld(&bar[XB_XCNT(j)]); sum += c; cnt += (c > 0u) ? 1u : 0u; mine = (j == x) ? c : mine; }
        if (sum == G) break;
        __builtin_amdgcn_s_sleep(1);
        if ((++sp & 255u) == 0u) { if (xb_ld(&bar[XB_TMO])) break; if (sp > XB_SPIN_CAP) { atomicAdd(&bar[XB_TMO], 1u); break; } }
    }
    nloc = mine > 0u ? mine : 1u; nx = cnt > 0u ? cnt : 1u;
}
__device__ __forceinline__ void xcd_barrier(const XcdBarrier& b) {
    asm volatile("s_waitcnt vmcnt(0)" ::: "memory");
    __syncthreads();
    if (threadIdx.x == 0) {
        unsigned* bar = b.bar;
        __builtin_amdgcn_s_waitcnt(0);
        unsigned nloc = b.st[0], nx = b.st[1];
        if (nloc == 0u) { xcd_barrier_complete(bar, b.x, nloc, nx); b.st[0] = nloc; b.st[1] = nx; }
        const unsigned old = xb_add(&bar[XB_XSUB(b.x)], 1u);
        const unsigned gen = old / nloc;
        if (old + 1u == (gen + 1u) * nloc) {
            __builtin_amdgcn_fence(__ATOMIC_RELEASE, "agent");
            asm volatile("s_waitcnt vmcnt(0)" ::: "memory");
            const unsigned og = xb_add(&bar[XB_TOP], 1u);
            const unsigned tg = og / nx;
            if (og + 1u == (tg + 1u) * nx) xb_add(&bar[XB_TOPGEN], 1u);
            else XB_SPIN(xb_ld(&bar[XB_TOPGEN]) == tg, bar);
            __builtin_amdgcn_fence(__ATOMIC_ACQUIRE, "agent");
            xb_add(&bar[XB_XGEN(b.x)], 1u);
            asm volatile("s_waitcnt vmcnt(0)" ::: "memory");
        } else {
            XB_SPIN(xb_ld(&bar[XB_XGEN(b.x)]) == gen, bar);
            __builtin_amdgcn_fence(__ATOMIC_ACQUIRE, "agent");
            asm volatile("s_waitcnt vmcnt(0)" ::: "memory");
        }
    }
    __syncthreads();
}

constexpr int NTHR = 512, NWAVES = 8;
constexpr int LRU_ST = 16, LRU_NST = 64 / LRU_ST;
constexpr int LRU_AT = LRU_ST * 144, LRU_GT = LRU_ST * 272, LRU_HT = 64 * 128, LRU_WB = LRU_AT + LRU_GT + LRU_HT;

constexpr int LDS_RING = 131072;
constexpr int LDS_MISC = LDS_RING;
constexpr int LDS_BYTES = LDS_RING + 8192;
struct Fr {
    Ptrs P; unsigned char* lds;
    int tid, lane, wave, gw, ngw, nblk, blk; size_t gtid, gsz;
};

__device__ __forceinline__ void transpose_item(const float* W, int ldw, bf16* WT, int ldt, int k0, int n0, int row_off, int col_off, int map, float* scr, int lane) {
#pragma unroll 8
    for (int i = 0; i < 32; ++i) { const int kk = 2 * i + (lane >> 5); scr[kk * 33 + (lane & 31)] = W[(size_t)(k0 + kk) * ldw + n0 + (lane & 31)]; }
    __builtin_amdgcn_s_waitcnt(0xc07f); asm volatile("" ::: "memory");
    const int c = lane & 7;
#pragma unroll
    for (int j = 0; j < 4; ++j) { const int n = (lane >> 3) + 8 * j; const float* s = scr + (8 * c) * 33 + n;
        u32x4 o; o.x = pk2(s[0 * 33], s[1 * 33]); o.y = pk2(s[2 * 33], s[3 * 33]); o.z = pk2(s[4 * 33], s[5 * 33]); o.w = pk2(s[6 * 33], s[7 * 33]);
        int nn = n0 + n;
        if (map & 1) { const int up = nn >= 1024, jj = nn & 1023; nn = (jj >> 4) * 32 + up * 16 + (jj & 15); }
        if (map & 2) { u32x2 o8; o8.x = pk4_fp8(s[0 * 33] * 64.f, s[1 * 33] * 64.f, s[2 * 33] * 64.f, s[3 * 33] * 64.f); o8.y = pk4_fp8(s[4 * 33] * 64.f, s[5 * 33] * 64.f, s[6 * 33] * 64.f, s[7 * 33] * 64.f);
            *(u32x2*)((unsigned char*)WT + (size_t)(row_off + nn) * ldt + col_off + k0 + 8 * c) = o8; }
        else *(u32x4*)(WT + (size_t)(row_off + nn) * ldt + col_off + k0 + 8 * c) = o; }
    __builtin_amdgcn_s_waitcnt(0xc07f); asm volatile("" ::: "memory");
}
struct TJob { const float* W; bf16* WT; int K, N, ldw, ldt, row_off, col_off, map; long wstride, tstride; int count; };
constexpr int NJOBS = 8;
__device__ __forceinline__ TJob get_job(const Ptrs& P, int j) {
    TJob t; t.row_off = 0; t.col_off = 0; t.map = 0; t.wstride = 0; t.tstride = 0; t.count = 1;
    switch (j) {
    case 0: t.W = P.in[29]; t.WT = WSP(bf16, WS_WGU); t.K = 1024; t.N = 2048; t.ldw = 2048; t.ldt = 1024; t.map = 3; t.wstride = (long)1024 * 2048; t.tstride = (long)2048 * 1024 / 2; t.count = 64; break;
    case 1: t.W = P.in[31]; t.WT = WSP(bf16, WS_WDN); t.K = 1024; t.N = 1024; t.ldw = 1024; t.ldt = 1024; t.map = 2; t.wstride = (long)1024 * 1024; t.tstride = (long)1024 * 1024 / 2; t.count = 64; break;
    case 2: t.W = P.in[8]; t.WT = WSP(bf16, WS_WIN); t.K = 1024; t.N = 1440; t.ldw = 1440; t.ldt = 1024; break;
    case 3: t.W = P.in[17]; t.WT = WSP(bf16, WS_WQKVB); t.K = 256; t.N = 768; t.ldw = 768; t.ldt = 384; break;
    case 4: t.W = P.in[19]; t.WT = WSP(bf16, WS_WQKVB); t.K = 128; t.N = 1024; t.ldw = 1024; t.ldt = 384; t.row_off = 768; t.col_off = 256; break;
    case 5: t.W = P.in[22]; t.WT = WSP(bf16, WS_WOE); t.K = 1024; t.N = 1024; t.ldw = 1024; t.ldt = 1024; break;
    case 6: t.W = P.in[23]; t.WT = WSP(bf16, WS_WQO); t.K = 1024; t.N = 1536; t.ldw = 1536; t.ldt = 1024; break;
    default: t.W = P.in[26]; t.WT = WSP(bf16, WS_WOO); t.K = 1024; t.N = 1024; t.ldw = 1024; t.ldt = 1024; break;
    }
    return t;
}

constexpr int Q_ITEMS_L = 32 * 64 * 16 + 32 * 32 * 16, Q_ITEMS = 2 * Q_ITEMS_L;
struct CItem { const float* W; unsigned char* WT; int ldw, k0, n0, map; };
__device__ __forceinline__ CItem conv_decode(const Ptrs& P, int id) {
    CItem c; const int layer = id / Q_ITEMS_L, r = id % Q_ITEMS_L;
    if (r < 32768) { const int m = layer * 32 + (r >> 10), q = r & 1023; c.W = P.in[29] + (size_t)m * 1024 * 2048; c.WT = P.ws + WS_WGU + (size_t)m * 2048 * 1024; c.ldw = 2048; c.n0 = (q >> 4) * 32; c.k0 = (q & 15) * 64; c.map = 1; }
    else { const int r2 = r - 32768; const int m = layer * 32 + (r2 >> 9), q = r2 & 511; c.W = P.in[31] + (size_t)m * 1024 * 1024; c.WT = P.ws + WS_WDN + (size_t)m * 1024 * 1024; c.ldw = 1024; c.n0 = (q >> 4) * 32; c.k0 = (q & 15) * 64; c.map = 0; }
    return c;
}
__device__ __forceinline__ void conv_load(const CItem& c, float (&v)[32], int lane) {
#pragma unroll
    for (int i = 0; i < 32; ++i) v[i] = c.W[(size_t)(c.k0 + 2 * i + (lane >> 5)) * c.ldw + c.n0 + (lane & 31)];
}
__device__ __forceinline__ void conv_finish(const CItem& c, const float (&v)[32], float* scr, int lane) {
#pragma unroll
    for (int i = 0; i < 32; ++i) scr[(2 * i + (lane >> 5)) * 33 + (lane & 31)] = v[i];
    __builtin_amdgcn_s_waitcnt(0xc07f); asm volatile("" ::: "memory");
    const int cc = lane & 7;
#pragma unroll
    for (int j = 0; j < 4; ++j) { const int n = (lane >> 3) + 8 * j; const float* s = scr + (8 * cc) * 33 + n;
        int nn = c.n0 + n;
        if (c.map & 1) { const int up = nn >= 1024, jj = nn & 1023, jl = jj & 127, q = jl >> 3;
            nn = (jj >> 7) * 256 + ((jl >> 2) & 1) * 128 + (q >> 2) * 32 + up * 16 + (q & 3) * 4 + (jl & 3); }
        else { const int cl = nn & 255;
            nn = (nn & ~255) + (cl & 0xE0) + ((cl >> 2) & 1) * 16 + ((cl >> 3) & 3) * 4 + (cl & 3); }
        u32x2 o8; o8.x = pk4_fp8(s[0 * 33] * 64.f, s[1 * 33] * 64.f, s[2 * 33] * 64.f, s[3 * 33] * 64.f); o8.y = pk4_fp8(s[4 * 33] * 64.f, s[5 * 33] * 64.f, s[6 * 33] * 64.f, s[7 * 33] * 64.f);
        *(u32x2*)(c.WT + (size_t)nn * 1024 + c.k0 + 8 * cc) = o8; }
    __builtin_amdgcn_s_waitcnt(0xc07f); asm volatile("" ::: "memory");
}
__device__ __forceinline__ void conv_seq(Fr& F, int start, int n) {
    if (start + n > Q_ITEMS) n = Q_ITEMS - start;
    if (n <= 0) return;
    float* scr = (float*)(F.lds + F.wave * 64 * 33 * 4);
    float va[32], vb[32];
    CItem ca = conv_decode(F.P, start), cb = ca;
    conv_load(ca, va, F.lane);
#pragma unroll 1
    for (int i = 0; i < n; i += 2) {
        if (i + 1 < n) { cb = conv_decode(F.P, start + i + 1); conv_load(cb, vb, F.lane); }
        conv_finish(ca, va, scr, F.lane);
        if (i + 2 < n) { ca = conv_decode(F.P, start + i + 2); conv_load(ca, va, F.lane); }
        if (i + 1 < n) conv_finish(cb, vb, scr, F.lane);
    }
}
struct Slot { int phase, b0, nb, n; };
constexpr Slot SLOTS[] = {{0, 0, 256, 1}, {2, 152, 104, 6}, {3, 16, 240, 6}, {5, 16, 240, 10}, {7, 16, 240, 6}, {10, 144, 112, 4}, {11, 0, 256, 20}, {12, 152, 104, 6}};
constexpr int NSLOTS = sizeof(SLOTS) / sizeof(Slot);
constexpr int slot_base(int k) { int b = 0; for (int i = 0; i < k; ++i) b += SLOTS[i].nb * 8 * SLOTS[i].n; return b; }
static_assert(slot_base(5) >= Q_ITEMS_L && slot_base(NSLOTS) >= Q_ITEMS, "conversion schedule must cover layer 0 before phase 9 and everything before phase 17");
template <int PH>
__device__ __forceinline__ void conv_fill(Fr& F) {
#pragma unroll
    for (int k = 0; k < NSLOTS; ++k) if (SLOTS[k].phase == PH) {
        __syncthreads();
        if (F.blk >= SLOTS[k].b0 && F.blk < SLOTS[k].b0 + SLOTS[k].nb) conv_seq(F, slot_base(k) + ((F.blk - SLOTS[k].b0) * 8 + F.wave) * SLOTS[k].n, SLOTS[k].n);
    }
}
__device__ __forceinline__ void ph_prologue(Fr& F) {
    const Ptrs& P = F.P;
    if (F.blk < 192) {
        float* sl = (float*)(F.lds + 8 * 64 * 33 * 4);
        float* red = sl + 5 * 1024;
        const float* c = P.in[1]; const float* cc = P.in[3];
        for (int i = F.tid; i < 5 * 1024; i += NTHR) { const int r = i >> 10, k = i & 1023; const float v = r < 4 ? c[r * 1024 + k] : cc[k]; sl[i] = v / (1.f + __expf(-v)); }
        __syncthreads();
        const int l = F.blk / 96, j = (F.blk % 96) * 64 + (F.tid & 63), ks = F.tid >> 6;
        const float* w = P.in[4] + ((size_t)l * 1024 + ks * 128) * 6144 + j;
        float acc[5] = {0.f, 0.f, 0.f, 0.f, 0.f};
#pragma unroll 16
        for (int k = 0; k < 128; ++k) { const float wv = w[(size_t)k * 6144];
#pragma unroll
            for (int r = 0; r < 5; ++r) acc[r] += sl[r * 1024 + ks * 128 + k] * wv; }
#pragma unroll
        for (int r = 0; r < 5; ++r) red[(ks * 5 + r) * 64 + (F.tid & 63)] = acc[r];
        __syncthreads();
        if (F.tid < 320) { const int r = F.tid >> 6, cidx = F.tid & 63; float sum = 0.f;
#pragma unroll
            for (int q = 0; q < 8; ++q) sum += red[(q * 5 + r) * 64 + cidx];
            const int jj = (F.blk % 96) * 64 + cidx;
            WSP(float, WS_MOD)[(l * 5 + r) * 6144 + jj] = sum + P.in[5][l * 6144 + jj]; }
        __syncthreads();
    }
    for (size_t gid = F.gtid; gid < 4096 * 48; gid += F.gsz) {
        const int s = (int)(gid / 48), i = (int)(gid % 48); const int row = s >> 6, col = s & 63;
        if (i < 16) { const int fi = i & 7; const float fr = powf(10000.f, -(float)fi / 8.f); const float ang = (float)(i < 8 ? row : col) * fr;
            float* T = WSP(float, WS_ROPEM) + ((size_t)s * 16 + i) * 2; T[0] = cosf(ang); T[1] = sinf(ang); }
        else { const int ii = i - 16, fi = ii & 15; const float fr = powf(10000.f, -(float)fi / 16.f); const float ang = (float)(ii < 16 ? row : col) * fr;
            float* T = WSP(float, WS_ROPEG) + ((size_t)s * 32 + ii) * 2; T[0] = cosf(ang); T[1] = sinf(ang); }
    }
    for (size_t gid = F.gtid; gid < 2 * 32 * 1024; gid += F.gsz) { const int l = (int)(gid >> 15), e = (int)(gid >> 10) & 31, k = (int)gid & 1023;
        WSP(float, WS_WRT)[gid] = P.in[27][((size_t)l * 1024 + k) * 32 + e]; }
    for (size_t gid = F.gtid; gid < 2 * 8 * 128 * 64; gid += F.gsz) { const int c = (int)gid & 63, o = (int)(gid >> 6) & 127, blk = (int)(gid >> 13) & 7, dir = (int)(gid >> 16);
        const float* src = o < 64 ? P.in[11] : P.in[13];
        WSP(bf16, WS_WRI)[gid] = (bf16)f2bf(src[(((size_t)dir * 8 + blk) * 64 + c) * 64 + (o & 63)]); }
    { u32x4* z = (u32x4*)(WSP(bf16, WS_WIN) + (size_t)1440 * 1024); for (size_t i = F.gtid; i < (size_t)96 * 1024 * 2 / 16; i += F.gsz) z[i] = (u32x4){0u, 0u, 0u, 0u};
      bf16* q = WSP(bf16, WS_WQKVB);
      for (size_t i = F.gtid; i < (size_t)768 * 16; i += F.gsz) { const int r = (int)(i >> 4), c = (int)(i & 15); *(u32x4*)(q + (size_t)r * 384 + 256 + c * 8) = (u32x4){0u, 0u, 0u, 0u}; }
      for (size_t i = F.gtid; i < (size_t)1024 * 32; i += F.gsz) { const int r = (int)(i >> 5), c = (int)(i & 31); *(u32x4*)(q + (size_t)(768 + r) * 384 + c * 8) = (u32x4){0u, 0u, 0u, 0u}; } }
    float* scr = (float*)(F.lds + F.wave * 64 * 33 * 4);
    long base = 0;
#pragma unroll 1
    for (int j = 2; j < NJOBS; ++j) {
        const TJob t = get_job(P, j);
        const int nnb = t.N / 32; const long per = (long)(t.K / 64) * nnb, total = per * t.count;
        long first = ((long)F.gw - base % F.ngw + F.ngw) % F.ngw;
        for (long it = first; it < total; it += F.ngw) {
            const int m = (int)(it / per); const int r = (int)(it % per); const int kb = r / nnb, nb = r % nnb;
            transpose_item(t.W + (size_t)m * t.wstride, t.ldw, t.WT + (size_t)m * t.tstride, t.ldt, kb * 64, nb * 32, t.row_off, t.col_off, t.map, scr, F.lane);
        }
        base += total;
    }
}

struct RowV { f32x4 v[4]; };
__device__ __forceinline__ RowV load_row(const float* p, int lane) { RowV r; const f32x4* q = (const f32x4*)p + lane;
#pragma unroll
    for (int j = 0; j < 4; ++j) r.v[j] = q[64 * j]; return r; }
__device__ __forceinline__ void norm_mod(RowV& r, const float* g, const float* sc, const float* sh, int lane) {
    float s = 0.f;
#pragma unroll
    for (int j = 0; j < 4; ++j) s += r.v[j].x * r.v[j].x + r.v[j].y * r.v[j].y + r.v[j].z * r.v[j].z + r.v[j].w * r.v[j].w;
    const float rs = rsqrtf(wave_sum(s) * (1.f / D) + 1e-6f);
#pragma unroll
    for (int j = 0; j < 4; ++j) { const f32x4 gv = ((const f32x4*)g)[lane + 64 * j], scv = ((const f32x4*)sc)[lane + 64 * j], shv = ((const f32x4*)sh)[lane + 64 * j];
        r.v[j] = (r.v[j] * rs * gv) * (scv + 1.f) + shv; }
}
__device__ __forceinline__ void store_row_bf16(bf16* p, const RowV& r, int lane) { u32x2* q = (u32x2*)p + lane;
#pragma unroll
    for (int j = 0; j < 4; ++j) { u32x2 o; o.x = pk2(r.v[j].x, r.v[j].y); o.y = pk2(r.v[j].z, r.v[j].w); q[64 * j] = o; } }
__device__ __forceinline__ const float* xrow0(const Ptrs& P, int r) { return r < NL ? P.in[0] + (size_t)r * D : P.in[2] + (size_t)(r - NL) * D; }

__device__ __forceinline__ void ph_norm0(Fr& F) {
    const Ptrs& P = F.P; const float* MOD = WSP(float, WS_MOD);
    for (int r = F.gw; r < NT; r += F.ngw) {
        RowV v = load_row(xrow0(P, r), F.lane);
        const float* m = MOD + (size_t)mod_row(r) * 6144;
        norm_mod(v, P.in[6], m + 1024, m, F.lane);
        store_row_bf16(WSP(bf16, WS_HN) + (size_t)r * D, v, F.lane);
    }
}

__device__ __forceinline__ void wtile(const bf16* a0, const bf16* a1, const bf16* b0, const bf16* b1, int K, f32x4 (&acc)[2][2]) {
#pragma unroll
    for (int m = 0; m < 2; ++m)
#pragma unroll
        for (int n = 0; n < 2; ++n) acc[m][n] = (f32x4){0.f, 0.f, 0.f, 0.f};
#pragma unroll 2
    for (int k = 0; k < K; k += 32) {
        const bf16x8 A0 = *(const bf16x8*)(a0 + k), A1 = *(const bf16x8*)(a1 + k), B0 = *(const bf16x8*)(b0 + k), B1 = *(const bf16x8*)(b1 + k);
        acc[0][0] = __builtin_amdgcn_mfma_f32_16x16x32_bf16(B0, A0, acc[0][0], 0, 0, 0);
        acc[0][1] = __builtin_amdgcn_mfma_f32_16x16x32_bf16(B1, A0, acc[0][1], 0, 0, 0);
        acc[1][0] = __builtin_amdgcn_mfma_f32_16x16x32_bf16(B0, A1, acc[1][0], 0, 0, 0);
        acc[1][1] = __builtin_amdgcn_mfma_f32_16x16x32_bf16(B1, A1, acc[1][1], 0, 0, 0);
    }
}
struct EpiF32 { float* C; int ldc, nvalid;
    __device__ __forceinline__ void operator()(int row, int col, f32x4 a, f32x4 b) const {
        if (col < nvalid) *(f32x4*)(C + (size_t)row * ldc + col) = a;
        if (col + 16 < nvalid) *(f32x4*)(C + (size_t)row * ldc + col + 16) = b; } };
struct EpiResid { const float* xin0; const float* xin1; float* xout; const float* g;
    __device__ __forceinline__ void operator()(int row, int col, f32x4 a, f32x4 b) const {
        const float* xi = row < NL ? xin0 + (size_t)row * D : xin1 + (size_t)(row - NL) * D; const float* gg = g + (size_t)mod_row(row) * 6144;
        float* xo = xout + (size_t)row * D;
        *(f32x4*)(xo + col) = *(const f32x4*)(xi + col) + *(const f32x4*)(gg + col) * a;
        *(f32x4*)(xo + col + 16) = *(const f32x4*)(xi + col + 16) + *(const f32x4*)(gg + col + 16) * b; } };
struct EpiSwiglu { bf16* act; const float* bias;
    __device__ __forceinline__ void operator()(int row, int col, f32x4 a, f32x4 b) const {
        const int j = (col >> 5) * 16 + (col & 15);
        const f32x4 bg = *(const f32x4*)(bias + j), bu = *(const f32x4*)(bias + 1024 + j);
        float o[4];
#pragma unroll
        for (int i = 0; i < 4; ++i) { float hg = a[i] + bg[i], hu = b[i] + bu[i]; hg = fminf(hg, 7.f); hu = fminf(fmaxf(hu, -7.f), 7.f);
            o[i] = hg * sigmoidf_(1.702f * hg) * (hu + 1.f); }
        *(unsigned*)((unsigned char*)act + (size_t)row * D + j) = pk4_fp8(o[0], o[1], o[2], o[3]); } };
struct EpiBiasBf16 { bf16* Y; const float* bias;
    __device__ __forceinline__ void operator()(int row, int col, f32x4 a, f32x4 b) const {
        const f32x4 b0 = *(const f32x4*)(bias + col), b1 = *(const f32x4*)(bias + col + 16);
        u32x2 w; w.x = pk2(a[0] + b0[0], a[1] + b0[1]); w.y = pk2(a[2] + b0[2], a[3] + b0[3]); *(u32x2*)(Y + (size_t)row * D + col) = w;
        w.x = pk2(b[0] + b1[0], b[1] + b1[1]); w.y = pk2(b[2] + b1[2], b[3] + b1[3]); *(u32x2*)(Y + (size_t)row * D + col + 16) = w; } };

__device__ __forceinline__ void moe_prefix(Fr& F, int layer) {
    int* pre = (int*)(F.lds + LDS_MISC + 64);
    const int* cnt = (const int*)(F.P.ws + WS_CTL + CW_CNT) + layer * NE;
    __syncthreads();
    if (F.tid == 0) { int s = 0; for (int e = 0; e < NE; ++e) { pre[e] = s; s += (cnt[e] + 255) >> 8; } pre[NE] = s; }
    __syncthreads();
}
__device__ __forceinline__ int moe_find(const int* pre, int t256) {
    const int lane = threadIdx.x & 63; const int v = lane < NE ? pre[lane + 1] : 0x7fffffff; return __popcll(__ballot(v <= t256)); }

namespace pg {
constexpr int BM = 256, BK = 64, HALF = 128, HTB = HALF * BK * 2, STAGE_BYTES = 8 * HTB, NXCD = 8, WGM = 8;
__device__ __forceinline__ int lds_byte(int r, int c) { const int st = (r >> 4) * 2 + (c >> 5), rr = r & 15, cc = c & 31, ob = rr * 64 + cc * 2; return st * 1024 + (ob ^ (((ob >> 9) & 1) << 5)); }
__device__ __forceinline__ void stage_rc(int b, int& R, int& C) { const int st = b / 1024, sb = b % 1024, swz = sb ^ (((sb >> 9) & 1) << 5); R = (st >> 1) * 16 + swz / 64; C = (st & 1) * 32 + (swz % 64) / 2; }
struct Unit { int pm, pn, e, mt; };
struct DenseSched {
    const bf16* A; const bf16* Bt; int ldab, ldbb, nkt; int nM, nN, nwg, G, c;
    __device__ __forceinline__ void init(const bf16* A_, int lda_, const bf16* Bt_, int ldb_, int M, int N, int K_, int G_, int c_) { A = A_; Bt = Bt_; ldab = lda_ * 2; ldbb = ldb_ * 2; nkt = K_ / BK; nM = M / BM; nN = N / BM; nwg = nM * nN; G = G_; c = c_; }
    __device__ __forceinline__ bool next(int i, Unit& u) const {
        const long L = (long)i * G + c; if (L >= nwg) return false;
        int wgid = (int)L; { const int q = nwg / NXCD, r = nwg % NXCD, xcd = wgid % NXCD, off = wgid / NXCD; wgid = (xcd < r ? xcd * (q + 1) : r * (q + 1) + (xcd - r) * q) + off; }
        const int nig = WGM * nN, gid = wgid / nig, fm = gid * WGM, gsz = (nM - fm) < WGM ? (nM - fm) : WGM;
        u.pm = fm + ((wgid % nig) % gsz); u.pn = (wgid % nig) / gsz; u.e = 0; u.mt = 0; return true;
    }
    __device__ __forceinline__ void fill(const Unit&, int, int, LAS unsigned char*, int) const {}
    __device__ __forceinline__ unsigned aoff(const Unit& u, int, LAS unsigned char*, int r, int C) const { return (unsigned)((u.pm * BM + r) * ldab + C * 2); }
    __device__ __forceinline__ const char* bbase(const Unit& u) const { return (const char*)Bt + (size_t)u.pn * BM * ldbb; }
};
template <int STAGE> struct MoeSched {
    const bf16* A; const bf16* Bt; int ldab, ldbb, nkt; int G, c, NN, nunits; const int* pre; const int* cnt; const int* toklist; const float* bias;
    __device__ __forceinline__ bool next(int i, Unit& u) const {
        int t256;
        if (G == 256) { const int x = c & 7, j = c >> 3;
            const int tpr = 256 / NN, nfull = (nunits / NN) / tpr;
            if (i < nfull) { if (STAGE == 1) { t256 = i * 32 + x * 4 + (j >> 3); u.pn = j & 7; } else { t256 = i * 64 + x * 8 + (j >> 2); u.pn = j & 3; } }
            else { const long L = (long)nfull * 256 + (long)(i - nfull) * 256 + c; if (L >= nunits) return false; t256 = (int)(L / NN); u.pn = (int)(L % NN); } }
        else { const long L = (long)i * G + c; if (L >= nunits) return false; t256 = (int)(L / NN); u.pn = (int)(L % NN); }
        u.pm = t256; u.e = moe_find(pre, t256); u.mt = t256 - pre[u.e]; return true;
    }
    __device__ __forceinline__ void fill(const Unit& u, int par, int slot3, LAS unsigned char* lds, int tid) const {
        if (STAGE == 1 && tid < 256) { const int c = cnt[u.e]; int slot = u.mt * BM + tid; slot = slot < c ? slot : c - 1;
            __builtin_amdgcn_global_load_lds((const unsigned*)(toklist + (size_t)u.e * NT + slot), (LAS unsigned*)(lds + LDS_MISC + 512 + par * 1024 + (tid >> 6) * 256), 4, 0, 0); }
        if (tid >= 256) { const int w = (tid >> 6) - 4, l = tid & 63;
            const float* src = STAGE == 1 ? bias + (size_t)u.e * 2048 + (w >> 1) * 1024 + u.pn * 128 + (w & 1) * 64 + l : bias + (size_t)u.e * 1024 + u.pn * 256 + w * 64 + l;
            __builtin_amdgcn_global_load_lds((const unsigned*)src, (LAS unsigned*)(lds + LDS_MISC + 2560 + slot3 * 1024 + w * 256), 4, 0, 0); }
    }
    __device__ __forceinline__ unsigned aoff(const Unit& u, int par, LAS unsigned char* lds, int r, int C) const {
        if (STAGE == 1) { const int tok = *(const LAS int*)(lds + LDS_MISC + 512 + par * 1024 + r * 4); return (unsigned)(tok * ldab + C * 2); }
        return (unsigned)((u.pm * BM + r) * ldab + C * 2);
    }
    __device__ __forceinline__ const char* bbase(const Unit& u) const { return (const char*)Bt + ((size_t)u.e * NN * BM + (size_t)u.pn * BM) * ldbb; }
};

template <bool FP8, class Sched, class Epi>
__device__ __forceinline__ void gemm_phase(LAS unsigned char* lds, const Sched& S, const Epi& E) {
    const int tid = threadIdx.x, wid = __builtin_amdgcn_readfirstlane(tid >> 6), lane = tid & 63, wr = wid >> 2, wc = wid & 3, fr = lane & 15, fq = lane >> 4;
    const int nt = S.nkt;
    int Rr[2], Cc[2]; unsigned voffB[2];
#pragma unroll
    for (int i = 0; i < 2; ++i) { stage_rc(tid * 16 + i * 8192, Rr[i], Cc[i]); voffB[i] = (unsigned)(Rr[i] * S.ldbb + Cc[i] * 2); }
    const size_t kstep = (size_t)(BK * 2);
    const size_t hstepB = (size_t)HALF * S.ldbb;
    const unsigned ldsw = (unsigned)wid * 1024u;
    const int aoff = lds_byte(wr * 64 + fr, fq * 8), boff = lds_byte(wc * 32 + fr, fq * 8);
#define PG_SA(b, h) (((b) * 2 + (h)) * HTB)
#define PG_SB(b, h) ((4 + (b) * 2 + (h)) * HTB)
#define PG_STAGE(bufoff, gbase, voff) do { _Pragma("unroll") for (int _i = 0; _i < 2; ++_i) \
        __builtin_amdgcn_global_load_lds((const unsigned*)((const char*)(gbase) + (voff)[_i]), (LAS unsigned*)(lds + (bufoff) + ldsw + _i * 8192), 16, 0, 0); } while (0)
#define PG_LDA(dst, b, h) do { if constexpr (FP8) { _Pragma("unroll") for (int m = 0; m < 4; ++m) { const i32x4 _l = *(const LAS i32x4*)(lds + PG_SA(b, h) + aoff + m * 2048), _h = *(const LAS i32x4*)(lds + PG_SA(b, h) + aoff + m * 2048 + 1024); \
        dst##8[m] = __builtin_shufflevector(_l, _h, 0, 1, 2, 3, 4, 5, 6, 7); } } \
    else { _Pragma("unroll") for (int m = 0; m < 4; ++m) _Pragma("unroll") for (int k = 0; k < 2; ++k) dst[m][k] = *(const LAS bf16x8*)(lds + PG_SA(b, h) + aoff + m * 2048 + k * 1024); } } while (0)
#define PG_LDB(dst, b, h) do { if constexpr (FP8) { _Pragma("unroll") for (int n = 0; n < 2; ++n) { const i32x4 _l = *(const LAS i32x4*)(lds + PG_SB(b, h) + boff + n * 2048), _h = *(const LAS i32x4*)(lds + PG_SB(b, h) + boff + n * 2048 + 1024); \
        dst##8[n] = __builtin_shufflevector(_l, _h, 0, 1, 2, 3, 4, 5, 6, 7); } } \
    else { _Pragma("unroll") for (int n = 0; n < 2; ++n) _Pragma("unroll") for (int k = 0; k < 2; ++k) dst[n][k] = *(const LAS bf16x8*)(lds + PG_SB(b, h) + boff + n * 2048 + k * 1024); } } while (0)
#define PG_MMA(ai, bj, At, Bt) do { __builtin_amdgcn_s_setprio(1); if constexpr (FP8) { _Pragma("unroll") for (int m = 0; m < 4; ++m) _Pragma("unroll") for (int n = 0; n < 2; ++n) \
        asm volatile("v_mfma_scale_f32_16x16x128_f8f6f4 %0, %1, %2, %0, %3, %4 op_sel_hi:[0,0,0]" : "+v"(acc[ai][bj][m][n]) : "v"(Bt##8[n]), "v"(At##8[m]), "v"(sc_w), "v"(sc_a)); } \
    else { _Pragma("unroll") for (int m = 0; m < 4; ++m) _Pragma("unroll") for (int n = 0; n < 2; ++n) _Pragma("unroll") for (int k = 0; k < 2; ++k) \
        acc[ai][bj][m][n] = __builtin_amdgcn_mfma_f32_16x16x32_bf16(Bt[n][k], At[m][k], acc[ai][bj][m][n], 0, 0, 0); } __builtin_amdgcn_s_setprio(0); } while (0)
#define PG_MMA2(ai, At, B0, B1) do { PG_MMA(ai, 0, At, B0); PG_MMA(ai, 1, At, B1); } while (0)
#define PG_WAIT_V(n) asm volatile("s_waitcnt vmcnt(" #n ")" ::: "memory")
#define PG_WAIT_VL(n) asm volatile("s_waitcnt vmcnt(" #n ") lgkmcnt(0)" ::: "memory")
#define PG_WAIT_L(n) asm volatile("s_waitcnt lgkmcnt(" #n ")" ::: "memory")
#define PG_BAR __builtin_amdgcn_s_barrier()
#define PG_SCHED __builtin_amdgcn_sched_barrier(0)
    Unit cur, nxt; int ui = 0;
    if (!S.next(0, cur)) return;
    f32x4 acc[2][2][4][2];
#pragma unroll
    for (int a = 0; a < 2; ++a)
#pragma unroll
        for (int b = 0; b < 2; ++b)
#pragma unroll
            for (int m = 0; m < 4; ++m)
#pragma unroll
                for (int n = 0; n < 2; ++n) acc[a][b][m][n] = (f32x4){0.f, 0.f, 0.f, 0.f};
    bf16x8 At[4][2], B0[2][2], B1[2][2]; i32x8 At8[4], B08[2], B18[2];
    int sc_w = 0x79797979, sc_a = 0x7F7F7F7F;
    asm volatile("" : "+v"(sc_w), "+v"(sc_a));
    unsigned voA0[2], voA1[2], vnA0[2], vnA1[2];
    S.fill(cur, 0, 0, lds, tid);
    asm volatile("s_waitcnt vmcnt(0)" ::: "memory"); __syncthreads();
#pragma unroll
    for (int i = 0; i < 2; ++i) { voA0[i] = S.aoff(cur, 0, lds, Rr[i], Cc[i]); voA1[i] = S.aoff(cur, 0, lds, HALF + Rr[i], Cc[i]); }
    const char* Ab = (const char*)S.A; const char* cB = S.bbase(cur);
    PG_STAGE(PG_SB(0, 0), cB, voffB); PG_STAGE(PG_SB(0, 1), cB + hstepB, voffB); PG_STAGE(PG_SA(0, 0), Ab, voA0); PG_STAGE(PG_SA(0, 1), Ab, voA1);
    if (wr == 1) PG_BAR;
    PG_WAIT_V(2); PG_BAR;
    PG_STAGE(PG_SB(1, 0), cB + kstep, voffB); PG_STAGE(PG_SA(1, 0), Ab + kstep, voA0); PG_STAGE(PG_SB(1, 1), cB + hstepB + kstep, voffB);
    PG_WAIT_V(6); PG_BAR;
    for (;;) {
        const bool has_next = S.next(ui + 1, nxt);
        const char* nB = has_next ? S.bbase(nxt) : cB;
        if (has_next) S.fill(nxt, (ui + 1) & 1, (ui + 1) % 3, lds, tid);
        for (int t = 0; t < nt; t += 2) {
            const bool last = (t == nt - 2);
            if (last) {
#pragma unroll
                for (int i = 0; i < 2; ++i) { vnA0[i] = has_next ? S.aoff(nxt, (ui + 1) & 1, lds, Rr[i], Cc[i]) : voA0[i]; vnA1[i] = has_next ? S.aoff(nxt, (ui + 1) & 1, lds, HALF + Rr[i], Cc[i]) : voA1[i]; } }
            const char* a1 = Ab + (size_t)(t + 1) * kstep;
            const char* a2 = last ? Ab : Ab + (size_t)(t + 2) * kstep; const char* b2 = last ? nB : cB + (size_t)(t + 2) * kstep;
            const char* a3 = a2 + kstep; const char* b3 = b2 + kstep;
            unsigned o20[2], o21[2];
#pragma unroll
            for (int i = 0; i < 2; ++i) { o20[i] = last ? vnA0[i] : voA0[i]; o21[i] = last ? vnA1[i] : voA1[i]; }
            PG_LDB(B0, 0, 0); PG_LDB(B1, 0, 1); PG_LDA(At, 0, 0); PG_STAGE(PG_SA(1, 1), a1, voA1);
            PG_WAIT_VL(8); PG_BAR; PG_SCHED; PG_MMA2(0, At, B0, B1); PG_BAR; PG_SCHED;
            PG_LDA(At, 0, 1); PG_STAGE(PG_SB(0, 0), b2, voffB); PG_STAGE(PG_SB(0, 1), b2 + hstepB, voffB); PG_STAGE(PG_SA(0, 0), a2, o20);
            PG_WAIT_VL(8); PG_BAR; PG_SCHED; PG_MMA2(1, At, B0, B1); PG_BAR; PG_SCHED;
            PG_LDB(B0, 1, 0); PG_LDB(B1, 1, 1); PG_LDA(At, 1, 0); PG_STAGE(PG_SA(0, 1), a2, o21);
            PG_WAIT_VL(8); PG_BAR; PG_SCHED; PG_MMA2(0, At, B0, B1); PG_BAR; PG_SCHED;
            PG_LDA(At, 1, 1); PG_STAGE(PG_SB(1, 0), b3, voffB); PG_STAGE(PG_SB(1, 1), b3 + hstepB, voffB); PG_STAGE(PG_SA(1, 0), a3, o20);
            PG_WAIT_VL(8); PG_BAR; PG_SCHED; PG_MMA2(1, At, B0, B1); PG_BAR; PG_SCHED;
        }
        if constexpr (FP8) asm volatile("s_nop 15\n\ts_nop 15" : "+v"(acc[1][1][0][0]), "+v"(acc[1][1][0][1]), "+v"(acc[1][1][1][0]), "+v"(acc[1][1][1][1]), "+v"(acc[1][1][2][0]), "+v"(acc[1][1][2][1]), "+v"(acc[1][1][3][0]), "+v"(acc[1][1][3][1]) :: "memory");
        if constexpr (Epi::WIDE) { const int row0 = cur.pm * BM + wr * 64 + fr; const typename Epi::Ctx cx = E.prepw(cur, wc, fq, lds, ui % 3);
#pragma unroll
          for (int ai = 0; ai < 2; ++ai)
#pragma unroll
              for (int m = 0; m < 4; ++m) E.applyw(cx, row0 + ai * HALF + m * 16, acc[ai][0][m][0], acc[ai][0][m][1], acc[ai][1][m][0], acc[ai][1][m][1]); }
        else { const int row0 = cur.pm * BM + wr * 64 + fr, col0 = cur.pn * BM + wc * 32 + 4 * fq;
          const typename Epi::Ctx cx0 = E.prep(cur, col0), cx1 = E.prep(cur, col0 + HALF);
#pragma unroll
          for (int ai = 0; ai < 2; ++ai) {
              if constexpr (Epi::ROWLOAD) {
                  typename Epi::Rv rv[4][2];
#pragma unroll
                  for (int m = 0; m < 4; ++m) { rv[m][0] = E.load(row0 + ai * HALF + m * 16, col0); rv[m][1] = E.load(row0 + ai * HALF + m * 16, col0 + HALF); }
#pragma unroll
                  for (int m = 0; m < 4; ++m) { E.apply(cx0, rv[m][0], row0 + ai * HALF + m * 16, col0, acc[ai][0][m][0], acc[ai][0][m][1]);
                                                E.apply(cx1, rv[m][1], row0 + ai * HALF + m * 16, col0 + HALF, acc[ai][1][m][0], acc[ai][1][m][1]); }
              } else {
#pragma unroll
                  for (int m = 0; m < 4; ++m) { E.apply(cx0, cur, row0 + ai * HALF + m * 16, col0, acc[ai][0][m][0], acc[ai][0][m][1]);
                                                E.apply(cx1, cur, row0 + ai * HALF + m * 16, col0 + HALF, acc[ai][1][m][0], acc[ai][1][m][1]); }
              } } }
        if (!has_next) break;
#pragma unroll
        for (int a = 0; a < 2; ++a)
#pragma unroll
            for (int b = 0; b < 2; ++b)
#pragma unroll
                for (int m = 0; m < 4; ++m)
#pragma unroll
                    for (int n = 0; n < 2; ++n) acc[a][b][m][n] = (f32x4){0.f, 0.f, 0.f, 0.f};
        cur = nxt; cB = nB; ++ui;
#pragma unroll
        for (int i = 0; i < 2; ++i) { voA0[i] = vnA0[i]; voA1[i] = vnA1[i]; }
    }
    PG_WAIT_V(0);
    if (wr == 0) PG_BAR;
    PG_BAR;
#undef PG_SA
#undef PG_SB
#undef PG_STAGE
#undef PG_LDA
#undef PG_LDB
#undef PG_MMA
#undef PG_MMA2
#undef PG_WAIT_VL
#undef PG_WAIT_V
#undef PG_WAIT_L
#undef PG_BAR
#undef PG_SCHED
}
}
struct GF32 { EpiF32 e; static constexpr bool ROWLOAD = false, WIDE = false; struct Ctx {}; struct Rv {};
    __device__ __forceinline__ Ctx prep(const pg::Unit&, int) const { return Ctx{}; }
    __device__ __forceinline__ void apply(const Ctx&, const pg::Unit&, int row, int col, f32x4 a, f32x4 b) const { e(row, col, a, b); } };
struct GResid { const float* xin0; const float* xin1; float* xout; const float* g; static constexpr bool ROWLOAD = true, WIDE = false;
    struct Ctx { f32x4 g0, g1; }; struct Rv { f32x4 x0, x1; };
    __device__ __forceinline__ Ctx prep(const pg::Unit& u, int col) const { const float* gg = g + (size_t)mod_row(u.pm * 256) * 6144; return Ctx{*(const f32x4*)(gg + col), *(const f32x4*)(gg + col + 16)}; }
    __device__ __forceinline__ Rv load(int row, int col) const { const float* xi = row < NL ? xin0 + (size_t)row * D : xin1 + (size_t)(row - NL) * D; return Rv{*(const f32x4*)(xi + col), *(const f32x4*)(xi + col + 16)}; }
    __device__ __forceinline__ void apply(const Ctx& c, const Rv& r, int row, int col, f32x4 a, f32x4 b) const { float* xo = xout + (size_t)row * D;
        *(f32x4*)(xo + col) = r.x0 + c.g0 * a; *(f32x4*)(xo + col + 16) = r.x1 + c.g1 * b; } };
struct GSwiglu { bf16* act; const float* bias; static constexpr bool ROWLOAD = false, WIDE = true;
    struct Ctx { f32x4 bg0, bg1, bu0, bu1; int j; }; struct Rv {};
    __device__ __forceinline__ Ctx prepw(const pg::Unit& u, int wc, int fq, LAS unsigned char* lds, int par) const { const int jl = 8 * (4 * wc + fq); const LAS float* tb = (const LAS float*)(lds + LDS_MISC + 2560 + par * 1024);
        const f32x4 one = {1.f, 1.f, 1.f, 1.f};
        return Ctx{*(const LAS f32x4*)(tb + jl), *(const LAS f32x4*)(tb + jl + 4), *(const LAS f32x4*)(tb + 128 + jl) + one, *(const LAS f32x4*)(tb + 128 + jl + 4) + one, u.pn * 128 + jl}; }
    __device__ __forceinline__ f32x4 glu4(f32x4 g, f32x4 u, f32x4 bg, f32x4 bu) const {
        f32x4 hg = g + bg, hu = u + bu;
#pragma unroll
        for (int i = 0; i < 4; ++i) { hg[i] = __builtin_amdgcn_fmed3f(hg[i], -20.f, 7.f); hu[i] = __builtin_amdgcn_fmed3f(hu[i], -6.f, 8.f); }
        const f32x4 kk = {-1.702f * 1.4426950408889634f, -1.702f * 1.4426950408889634f, -1.702f * 1.4426950408889634f, -1.702f * 1.4426950408889634f}, one = {1.f, 1.f, 1.f, 1.f};
        f32x4 e = hg * kk;
#pragma unroll
        for (int i = 0; i < 4; ++i) e[i] = __builtin_amdgcn_exp2f(e[i]);
        const f32x4 d = e + one;
        const float r01 = __builtin_amdgcn_rcpf(d[0] * d[1]), r23 = __builtin_amdgcn_rcpf(d[2] * d[3]);
        const f32x4 rr = {r01, r01, r23, r23}, ds = {d[1], d[0], d[3], d[2]};
        return (hg * hu) * (rr * ds);
    }
    __device__ __forceinline__ void applyw(const Ctx& c, int row, f32x4 g0, f32x4 u0, f32x4 g1, f32x4 u1) const {
        const f32x4 o0 = glu4(g0, u0, c.bg0, c.bu0), o1 = glu4(g1, u1, c.bg1, c.bu1);
        u32x2 w; w.x = pk4_fp8(o0[0], o0[1], o0[2], o0[3]); w.y = pk4_fp8(o1[0], o1[1], o1[2], o1[3]);
        *(u32x2*)((unsigned char*)act + (size_t)row * D + c.j) = w; } };
struct GBiasBf16 { bf16* Y; const float* bias; static constexpr bool ROWLOAD = false, WIDE = true;
    struct Ctx { f32x4 b00, b01, b10, b11; int col; }; struct Rv {};
    __device__ __forceinline__ Ctx prepw(const pg::Unit& u, int wc, int fq, LAS unsigned char* lds, int par) const { const int cl = 32 * wc + 8 * fq; const LAS float* tb = (const LAS float*)(lds + LDS_MISC + 2560 + par * 1024) + cl;
        return Ctx{*(const LAS f32x4*)tb, *(const LAS f32x4*)(tb + 4), *(const LAS f32x4*)(tb + 128), *(const LAS f32x4*)(tb + 132), u.pn * 256 + cl}; }
    __device__ __forceinline__ void applyw(const Ctx& c, int row, f32x4 a0, f32x4 a1, f32x4 b0, f32x4 b1) const {
        a0 += c.b00; a1 += c.b01; b0 += c.b10; b1 += c.b11;
        u32x4 w; w.x = pk2(a0[0], a0[1]); w.y = pk2(a0[2], a0[3]); w.z = pk2(a1[0], a1[1]); w.w = pk2(a1[2], a1[3]); *(u32x4*)(Y + (size_t)row * D + c.col) = w;
        w.x = pk2(b0[0], b0[1]); w.y = pk2(b0[2], b0[3]); w.z = pk2(b1[0], b1[1]); w.w = pk2(b1[2], b1[3]); *(u32x4*)(Y + (size_t)row * D + c.col + 128) = w; } };
template <class Epi>
__device__ __forceinline__ void ph_gemm(Fr& F, const bf16* A, int lda, const bf16* Bt, int ldb, int M, int N, int K, const Epi& E) {
    pg::DenseSched S; S.init(A, lda, Bt, ldb, M, N, K, F.nblk, F.blk);
    pg::gemm_phase<false>((LAS unsigned char*)F.lds, S, E);
}
template <int STAGE>
__device__ __forceinline__ void ph_moe_gemm(Fr& F, int layer, int nkt_probe = 0) {
    const Ptrs& P = F.P;
    moe_prefix(F, layer);
    const int* pre = (const int*)(F.lds + LDS_MISC + 64);
    pg::MoeSched<STAGE> S; S.ldab = 1024; S.ldbb = 1024; S.nkt = nkt_probe > 0 ? nkt_probe : 8; S.G = F.nblk; S.c = F.blk; S.NN = STAGE == 1 ? 8 : 4; S.nunits = pre[NE] * S.NN;
    S.pre = pre; S.cnt = (const int*)(P.ws + WS_CTL + CW_CNT) + layer * NE; S.toklist = WSP(int, WS_TOK);
    S.bias = STAGE == 1 ? P.in[30] + (size_t)layer * NE * 2048 : P.in[32] + (size_t)layer * NE * 1024;
    if (STAGE == 1) { S.A = WSP(bf16, WS_F); S.Bt = (const bf16*)(P.ws + WS_WGU + (size_t)layer * NE * 2048 * 1024); pg::gemm_phase<true>((LAS unsigned char*)F.lds, S, GSwiglu{WSP(bf16, WS_ACT), P.in[30] + (size_t)layer * NE * 2048}); }
    else { S.A = WSP(bf16, WS_ACT); S.Bt = (const bf16*)(P.ws + WS_WDN + (size_t)layer * NE * 1024 * 1024); pg::gemm_phase<true>((LAS unsigned char*)F.lds, S, GBiasBf16{WSP(bf16, WS_Y), P.in[32] + (size_t)layer * NE * 1024}); }
}

__device__ __forceinline__ void ph_e3(Fr& F) {
    const Ptrs& P = F.P; const int lane = F.lane;
    const float* Z = WSP(float, WS_Z); bf16* QKVN = WSP(bf16, WS_QKVN); bf16* KM = WSP(bf16, WS_KM);
    const float* ropeM = WSP(float, WS_ROPEM);
    if (F.blk < 16 && F.nblk > 32) return;
    for (int r = (F.nblk > 32 ? F.gw - 16 * NWAVES : F.gw); r < NT; r += (F.nblk > 32 ? F.ngw - 16 * NWAVES : F.ngw)) {
        const float* z = Z + (size_t)r * ZLD;
        const f32x4 qa = *(const f32x4*)(z + 1024 + 4 * lane);
        float ss = wave_sum(qa.x * qa.x + qa.y * qa.y + qa.z * qa.z + qa.w * qa.w);
        float rs = rsqrtf(ss * (1.f / 256.f) + 1e-6f);
        const f32x4 gq = *(const f32x4*)(P.in[16] + 4 * lane);
        u32x2 o; o.x = pk2(qa.x * rs * gq.x, qa.y * rs * gq.y); o.y = pk2(qa.z * rs * gq.z, qa.w * rs * gq.w);
        *(u32x2*)(QKVN + (size_t)r * 384 + 4 * lane) = o;
        const float k0 = z[1280 + 2 * lane], k1 = z[1280 + 2 * lane + 1];
        ss = wave_sum(k0 * k0 + k1 * k1); rs = rsqrtf(ss * (1.f / 128.f) + 1e-6f);
        *(unsigned*)(QKVN + (size_t)r * 384 + 256 + 2 * lane) = pk2(k0 * rs * P.in[18][2 * lane], k1 * rs * P.in[18][2 * lane + 1]);
        float kr = lane < 32 ? z[1408 + lane] : 0.f;
        ss = wave_sum(kr * kr); rs = rsqrtf(ss * (1.f / 32.f) + 1e-6f);
        kr = kr * rs * (lane < 32 ? P.in[21][32 + lane] : 0.f);
        int b, s; row_bs(r, b, s);
        const float other = __shfl_xor(kr, 16);
        float outv = kr;
        if (r < NL && lane < 32) { const int i = lane & 15; const float cs = ropeM[((size_t)s * 16 + i) * 2], sn = ropeM[((size_t)s * 16 + i) * 2 + 1];
            outv = lane < 16 ? kr * cs - other * sn : kr * cs + other * sn; }
        if (lane < 32) { const bf16 ov = (bf16)f2bf(outv);
#pragma unroll
            for (int h = 0; h < 8; ++h) KM[(((size_t)b * 8 + h) * TA + s) * 96 + 64 + lane] = ov; }
    }
}
__device__ __forceinline__ void ph_e5(Fr& F) {
    const Ptrs& P = F.P; const int lane = F.lane, sub = lane >> 4, d4 = lane & 15;
    const float* R = WSP(float, WS_QKVR); bf16* QM = WSP(bf16, WS_QM); bf16* KM = WSP(bf16, WS_KM); bf16* VT = WSP(bf16, WS_VM);
    const float* ropeM = WSP(float, WS_ROPEM);
    LAS unsigned char* scr = (LAS unsigned char*)F.lds + F.wave * LRU_WB;
    const f32x4 gqn = *(const f32x4*)(P.in[20] + 4 * d4), gkn = *(const f32x4*)(P.in[20] + 64 + 4 * d4);
    const f32x4 gqr = d4 < 8 ? *(const f32x4*)(P.in[21] + 4 * d4) : (f32x4){0.f, 0.f, 0.f, 0.f};
    if (F.blk < 16 && F.nblk > 32) return;
    for (int g = (F.nblk > 32 ? F.gw - 16 * NWAVES : F.gw); g < NT / 4; g += (F.nblk > 32 ? F.ngw - 16 * NWAVES : F.ngw)) {
        const int r0 = g * 4; int b, s0; row_bs(r0, b, s0);
        const int r = r0 + sub, s = s0 + sub; const float* q = R + (size_t)r * 1792;
#pragma unroll 2
        for (int hp = 0; hp < 4; ++hp) {
#pragma unroll
            for (int h2 = 0; h2 < 2; ++h2) {
                const int h = 2 * hp + h2;
                const size_t qo = (((size_t)b * 8 + h) * TA + s) * 96;
                f32x4 x = *(const f32x4*)(q + h * 96 + 4 * d4);
                float rs = rsqrtf(reduce16(dot4(x)) * (1.f / 64.f) + 1e-6f);
                x = x * rs * gqn;
                { u32x2 w; w.x = pk2(x.x, x.y); w.y = pk2(x.z, x.w); *(u32x2*)(QM + qo + 4 * d4) = w; }
                f32x4 y = d4 < 8 ? *(const f32x4*)(q + h * 96 + 64 + 4 * d4) : (f32x4){0.f, 0.f, 0.f, 0.f};
                rs = rsqrtf(reduce16(dot4(y)) * (1.f / 32.f) + 1e-6f);
                y = y * rs * gqr;
                f32x4 yo; yo.x = __shfl_xor(y.x, 4); yo.y = __shfl_xor(y.y, 4); yo.z = __shfl_xor(y.z, 4); yo.w = __shfl_xor(y.w, 4);
                if (r < NL && d4 < 8) { const float* rp = ropeM + ((size_t)s * 16 + 4 * (d4 & 3)) * 2; const f32x4 c0 = *(const f32x4*)rp, c1 = *(const f32x4*)(rp + 4);
                    const f32x4 cs = {c0.x, c0.z, c1.x, c1.z}, sn = {c0.y, c0.w, c1.y, c1.w};
                    y = d4 < 4 ? y * cs - yo * sn : y * cs + yo * sn; }
                if (d4 < 8) { u32x2 w; w.x = pk2(y.x, y.y); w.y = pk2(y.z, y.w); *(u32x2*)(QM + qo + 64 + 4 * d4) = w; }
                f32x4 kx = *(const f32x4*)(q + 768 + h * 128 + 4 * d4);
                rs = rsqrtf(reduce16(dot4(kx)) * (1.f / 64.f) + 1e-6f);
                kx = kx * rs * gkn;
                { u32x2 w; w.x = pk2(kx.x, kx.y); w.y = pk2(kx.z, kx.w); *(u32x2*)(KM + qo + 4 * d4) = w; }
                const f32x4 vx = *(const f32x4*)(q + 768 + h * 128 + 64 + 4 * d4);
                { u32x2 w; w.x = pk2(vx.x, vx.y); w.y = pk2(vx.z, vx.w); *(LAS u32x2*)(scr + (h2 * 4 + sub) * 128 + 8 * d4) = w; }
            }
#pragma unroll
            for (int h2 = 0; h2 < 2; ++h2) {
                unsigned short t4[4];
#pragma unroll
                for (int rr = 0; rr < 4; ++rr) t4[rr] = *(const LAS unsigned short*)(scr + (h2 * 4 + rr) * 128 + 2 * lane);
                u32x2 w; w.x = t4[0] | ((unsigned)t4[1] << 16); w.y = t4[2] | ((unsigned)t4[3] << 16);
                *(u32x2*)(VT + (((size_t)b * 8 + 2 * hp + h2) * 64 + lane) * TA + s0) = w;
            }
        }
    }
}

template <int DQ> struct ACfg { static constexpr int KP = DQ * 2 + 16, KCH = DQ / 8, KBYTES = 64 * KP, VP = 136, VBYTES = 64 * VP, BUF = KBYTES + VBYTES; };
template <int DQ, bool WIN>
__device__ __forceinline__ void attn_unit(LAS unsigned char* lds, const bf16* Qrow, const bf16* Kb, const bf16* Vtb, int a0, int a1, int b0, int b1,
                                          float c, int qpos, int ctile, float sink2, bf16* Orow, int tid, int lane) {
    typedef ACfg<DQ> C;
    const int hh = lane >> 5, ql = lane & 31;
    bf16x8 qf[DQ / 16];
#pragma unroll
    for (int ks = 0; ks < DQ / 16; ++ks) qf[ks] = *(const bf16x8*)(Qrow + 16 * ks + 8 * hh);
    f32x16 o0, o1;
#pragma unroll
    for (int r = 0; r < 16; ++r) { o0[r] = 0.f; o1[r] = 0.f; }
    float m = -1e30f, lsum = 0.f;
    const int n0 = a1 - a0, ntl = n0 + (b1 - b0);
    const int kkey0 = tid / C::KCH, kpc0 = tid % C::KCH, kkey1 = (tid + 512) / C::KCH, kpc1 = (tid + 512) % C::KCH;
    const bool two = (C::KCH == 12) && tid < 256;
    u32x4 kst0[2], kst1[2], vst[2];
    kst1[0] = (u32x4){0u, 0u, 0u, 0u}; kst1[1] = kst1[0];
#define AT_ISSUE(ti, p) do { const int _t = (ti) < n0 ? a0 + (ti) : b0 + (ti) - n0; const int _k0 = _t * 64; \
        kst0[p] = *(const u32x4*)(Kb + (size_t)(_k0 + kkey0) * DQ + kpc0 * 8); if (two) kst1[p] = *(const u32x4*)(Kb + (size_t)(_k0 + kkey1) * DQ + kpc1 * 8); \
        vst[p] = *(const u32x4*)(Vtb + (size_t)(tid >> 3) * TA + _k0 + (tid & 7) * 8); } while (0)
#define AT_COMMIT(buf, p) do { LAS unsigned char* _b = lds + (buf) * C::BUF; \
        *(LAS u32x4*)(_b + kkey0 * C::KP + kpc0 * 16) = kst0[p]; if (two) *(LAS u32x4*)(_b + kkey1 * C::KP + kpc1 * 16) = kst1[p]; \
        LAS unsigned char* _v = _b + C::KBYTES + (tid >> 3) * C::VP + (tid & 7) * 16; *(LAS u32x2*)_v = (u32x2){vst[p].x, vst[p].y}; *(LAS u32x2*)(_v + 8) = (u32x2){vst[p].z, vst[p].w}; } while (0)
    AT_ISSUE(0, 0); AT_COMMIT(0, 0);
    if (ntl > 1) AT_ISSUE(1, 1);
    __syncthreads();
    for (int tb = 0; tb < ntl; tb += 2) {
#pragma unroll
      for (int half = 0; half < 2; ++half) {
        const int ti = tb + half;
        if (ti < ntl) {
        const int buf = half;
        if (ti + 2 < ntl) AT_ISSUE(ti + 2, half);
        const LAS unsigned char* kb_ = lds + buf * C::BUF; const LAS unsigned char* vb_ = kb_ + C::KBYTES;
        bf16x8 kf0[DQ / 16], kf1[DQ / 16]; u32x2 va0[4], va1[4], vc0[4], vc1[4];
#pragma unroll
        for (int ks = 0; ks < DQ / 16; ++ks) { kf0[ks] = *(const LAS bf16x8*)(kb_ + ql * C::KP + (16 * ks + 8 * hh) * 2); kf1[ks] = *(const LAS bf16x8*)(kb_ + (32 + ql) * C::KP + (16 * ks + 8 * hh) * 2); }
#pragma unroll
        for (int s4 = 0; s4 < 4; ++s4) { const LAS unsigned char* v0 = vb_ + ql * C::VP + (16 * s4 + 4 * hh) * 2; const LAS unsigned char* v1 = v0 + 32 * C::VP;
            va0[s4] = *(const LAS u32x2*)v0; va1[s4] = *(const LAS u32x2*)(v0 + 16); vc0[s4] = *(const LAS u32x2*)v1; vc1[s4] = *(const LAS u32x2*)(v1 + 16); }
        __builtin_amdgcn_sched_barrier(0);
        f32x16 s0, s1;
#pragma unroll
        for (int r = 0; r < 16; ++r) { s0[r] = 0.f; s1[r] = 0.f; }
#pragma unroll
        for (int ks = 0; ks < DQ / 16; ++ks) {
            s0 = __builtin_amdgcn_mfma_f32_32x32x16_bf16(kf0[ks], qf[ks], s0, 0, 0, 0);
            s1 = __builtin_amdgcn_mfma_f32_32x32x16_bf16(kf1[ks], qf[ks], s1, 0, 0, 0);
        }
        const int tile = ti < n0 ? a0 + ti : b0 + ti - n0;
        const bool masked = WIN && ti < n0 && (tile - ctile >= 2 || ctile - tile >= 2);
        if (masked) {
#pragma unroll
            for (int r = 0; r < 16; ++r) { const int key = tile * 64 + (r & 3) + 8 * (r >> 2) + 4 * hh; const int d0 = qpos - key, d1 = qpos - key - 32;
                if (d0 > 128 || d0 < -128) s0[r] = -1e30f; if (d1 > 128 || d1 < -128) s1[r] = -1e30f; }
        }
        asm volatile("s_nop 15\n\ts_nop 15" : "+v"(s0), "+v"(s1));
        float mx;
        { float t0, t1, t2, t3;
          asm volatile("v_max3_f32 %0, %1, %2, %3" : "=v"(t0) : "v"(s0[0]), "v"(s0[1]), "v"(s0[2]));
          asm volatile("v_max3_f32 %0, %1, %2, %3" : "=v"(t1) : "v"(s0[3]), "v"(s0[4]), "v"(s0[5]));
          asm volatile("v_max3_f32 %0, %1, %2, %3" : "=v"(t2) : "v"(s1[0]), "v"(s1[1]), "v"(s1[2]));
          asm volatile("v_max3_f32 %0, %1, %2, %3" : "=v"(t3) : "v"(s1[3]), "v"(s1[4]), "v"(s1[5]));
#pragma unroll
          for (int r = 6; r < 16; r += 2) { asm volatile("v_max3_f32 %0, %0, %1, %2" : "+v"(t0) : "v"(s0[r]), "v"(s0[r + 1])); asm volatile("v_max3_f32 %0, %0, %1, %2" : "+v"(t2) : "v"(s1[r]), "v"(s1[r + 1])); }
          asm volatile("v_max3_f32 %0, %0, %1, %2" : "+v"(t0) : "v"(t1), "v"(t2));
          asm volatile("v_max_f32 %0, %1, %2" : "=v"(mx) : "v"(t0), "v"(t3)); }
        mx = fmaxf(mx, __shfl_xor(mx, 32)) * c;
        if (!__all(mx <= m + 8.f)) { const float mn = fmaxf(m, mx), alpha = __builtin_amdgcn_exp2f(m - mn); m = mn; lsum *= alpha;
#pragma unroll
            for (int r = 0; r < 16; ++r) { o0[r] *= alpha; o1[r] *= alpha; } }
        { f32x16 cv, mv;
#pragma unroll
          for (int r = 0; r < 16; ++r) { cv[r] = c; mv[r] = m; }
          s0 = s0 * cv - mv; s1 = s1 * cv - mv; }
#pragma unroll
        for (int r = 0; r < 16; ++r) { s0[r] = __builtin_amdgcn_exp2f(s0[r]); s1[r] = __builtin_amdgcn_exp2f(s1[r]); }
        { const f32x16 t = s0 + s1;
          typedef float f32x8_t __attribute__((ext_vector_type(8)));
          const f32x8_t u = __builtin_shufflevector(t, t, 0, 1, 2, 3, 4, 5, 6, 7) + __builtin_shufflevector(t, t, 8, 9, 10, 11, 12, 13, 14, 15);
          const f32x4 w = __builtin_shufflevector(u, u, 0, 1, 2, 3) + __builtin_shufflevector(u, u, 4, 5, 6, 7);
          lsum += (w.x + w.y) + (w.z + w.w); }
        bf16x8 pf[4];
#pragma unroll
        for (int s4 = 0; s4 < 4; ++s4) { u32x4 w;
            if (s4 < 2) { w.x = pk2(s0[8 * s4], s0[8 * s4 + 1]); w.y = pk2(s0[8 * s4 + 2], s0[8 * s4 + 3]); w.z = pk2(s0[8 * s4 + 4], s0[8 * s4 + 5]); w.w = pk2(s0[8 * s4 + 6], s0[8 * s4 + 7]); }
            else { const int q = s4 - 2; w.x = pk2(s1[8 * q], s1[8 * q + 1]); w.y = pk2(s1[8 * q + 2], s1[8 * q + 3]); w.z = pk2(s1[8 * q + 4], s1[8 * q + 5]); w.w = pk2(s1[8 * q + 6], s1[8 * q + 7]); }
            pf[s4] = __builtin_bit_cast(bf16x8, w); }
#pragma unroll
        for (int s4 = 0; s4 < 4; ++s4) {
            const bf16x8 va = __builtin_bit_cast(bf16x8, (u32x4){va0[s4].x, va0[s4].y, va1[s4].x, va1[s4].y}), vc = __builtin_bit_cast(bf16x8, (u32x4){vc0[s4].x, vc0[s4].y, vc1[s4].x, vc1[s4].y});
            o0 = __builtin_amdgcn_mfma_f32_32x32x16_bf16(va, pf[s4], o0, 0, 0, 0);
            o1 = __builtin_amdgcn_mfma_f32_32x32x16_bf16(vc, pf[s4], o1, 0, 0, 0);
        }
        if (ti + 1 < ntl) AT_COMMIT(buf ^ 1, half ^ 1);
        __syncthreads();
        }
      }
    }
#undef AT_ISSUE
#undef AT_COMMIT
    float ltot = lsum + __shfl_xor(lsum, 32);
    float fin = 1.f;
    if (WIN) { const float mn = fmaxf(m, sink2); fin = __builtin_amdgcn_exp2f(m - mn); ltot = ltot * fin + __builtin_amdgcn_exp2f(sink2 - mn); }
    const float inv = fin / ltot;
#pragma unroll
    for (int rq = 0; rq < 4; ++rq) {
        u32x2 w; w.x = pk2(o0[4 * rq] * inv, o0[4 * rq + 1] * inv); w.y = pk2(o0[4 * rq + 2] * inv, o0[4 * rq + 3] * inv); *(u32x2*)(Orow + 8 * rq + 4 * hh) = w;
        w.x = pk2(o1[4 * rq] * inv, o1[4 * rq + 1] * inv); w.y = pk2(o1[4 * rq + 2] * inv, o1[4 * rq + 3] * inv); *(u32x2*)(Orow + 32 + 8 * rq + 4 * hh) = w;
    }
}
__device__ __forceinline__ void ph_attn_mla(Fr& F) {
    const Ptrs& P = F.P;
    const bf16* QM = WSP(bf16, WS_QM); const bf16* KM = WSP(bf16, WS_KM); const bf16* VT = WSP(bf16, WS_VM);
    const int x = F.blk & 7, j = F.blk >> 3;
    const float c = 0.10206207261596577f * 1.4426950408889634f;
    for (int rd = 0; ; ++rd) {
        int bh, qb;
        if (F.nblk == 256) { if (rd < 2) { bh = rd * 16 + 2 * x + (j >> 4); qb = j & 15; } else if (rd == 2 && F.blk < 32) { bh = F.blk; qb = 16; } else break; }
        else { const int u = rd * F.nblk + F.blk; if (u >= 544) break; if (u < 512) { bh = u >> 4; qb = u & 15; } else { bh = u - 512; qb = 16; } }
        const int b = bh >> 3, h = bh & 7;
        const int s = qb * 256 + F.wave * 32 + (F.lane & 31);
        const int row = s < SEQ ? b * SEQ + s : NL + b * CTX + (s - SEQ);
        attn_unit<96, false>((LAS unsigned char*)F.lds, QM + ((size_t)bh * TA + s) * 96, KM + (size_t)bh * TA * 96, VT + (size_t)bh * 64 * TA,
                             qb < 16 ? 0 : 64, 68, 0, 0, c, 0, 0, 0.f, WSP(bf16, WS_YM) + (size_t)row * D + 512 + h * 64, F.tid, F.lane);
    }
}

__device__ __forceinline__ float gelu_fast(float x) { const float u = 1.5957691216057308f * (x + 0.044715f * x * x * x); return x / (1.f + __expf(-u)); }
__device__ __forceinline__ void ph_lru_carry(Fr& F) {
    if (F.blk < F.nblk - 8) return;
    const Ptrs& P = F.P; const int g = (F.blk - (F.nblk - 8)) * 8 + F.wave;
    const int bd = g >> 3, ch = (g & 7) * 64 + F.lane;
    const float* ag = WSP(float, WS_LA) + ((size_t)bd * 68) * 1024 + ch * 2; float* cr = WSP(float, WS_LH) + ((size_t)bd * 68) * 512 + ch;
    float h = 0.f;
#pragma unroll 17
    for (int kk = 0; kk < 68; ++kk) { cr[(size_t)kk * 512] = h; const f32x2_t ab = *(const f32x2_t*)(ag + (size_t)kk * 1024); h = ab.x * h + ab.y; }
}
template <int PASS>
__device__ __forceinline__ void ph_lru(Fr& F) {
    const Ptrs& P = F.P; const int lane = F.lane, w = F.wave, ch = w * 64 + lane, fr = lane & 15, fq = lane >> 4;
    LAS unsigned char* At = (LAS unsigned char*)F.lds + w * LRU_WB; LAS unsigned char* Gt = At + LRU_AT; LAS unsigned char* Ht = Gt + LRU_GT;
    const float* Z = WSP(float, WS_Z); const bf16* WRI = WSP(bf16, WS_WRI);
    float* AGG = WSP(float, WS_LA);
    for (int unit = F.blk; unit < NB * 68; unit += F.nblk) {
        const int b = unit / 68, k = unit % 68;
        const bool isctx = k < 4; const int T = isctx ? CTX : SEQ, t0 = isctx ? 64 * k : 64 * (k - 4), segrow0 = isctx ? NL + b * CTX : b * SEQ;
#pragma unroll 1
        for (int dir = 0; dir < 2; ++dir) {
            const int kd = dir == 0 ? k : (isctx ? 3 - k : 71 - k);
            const float cw0 = P.in[9][(dir * 4 + 0) * 512 + ch], cw1 = P.in[9][(dir * 4 + 1) * 512 + ch], cw2 = P.in[9][(dir * 4 + 2) * 512 + ch], cw3 = P.in[9][(dir * 4 + 3) * 512 + ch];
            const float cb = P.in[10][dir * 512 + ch], br = P.in[12][dir * 512 + ch], bi = P.in[14][dir * 512 + ch];
            const float sp8 = -8.f * log1pf(__expf(-P.in[15][dir * 512 + ch]));
            bf16x8 wf[2][2][4];
#pragma unroll
            for (int gate = 0; gate < 2; ++gate)
#pragma unroll
                for (int ks = 0; ks < 2; ++ks)
#pragma unroll
                    for (int n = 0; n < 4; ++n) wf[gate][ks][n] = *(const bf16x8*)(WRI + ((size_t)(dir * 8 + w) * 128 + gate * 64 + 16 * n + fr) * 64 + 32 * ks + 8 * fq);
            float uw[LRU_ST + 3], un[LRU_ST + 3], gv[LRU_ST], gn[LRU_ST];
#define LRU_LOAD(dstu, dstg, st_) do { const int _sub = dir == 0 ? (st_) : LRU_NST - 1 - (st_); const int _ts = t0 + LRU_ST * _sub; \
                _Pragma("unroll") for (int q = 0; q < LRU_ST + 3; ++q) { const int t = dir == 0 ? _ts - 3 + q : _ts + LRU_ST + 2 - q; const bool ok = t >= 0 && t < T; \
                    dstu[q] = ok ? Z[(size_t)(segrow0 + (ok ? t : 0)) * ZLD + ch] : 0.f; } \
                if (PASS == 1 && dir == 1) { _Pragma("unroll") for (int i = 0; i < LRU_ST; ++i) dstg[i] = Z[(size_t)(segrow0 + _ts + LRU_ST - 1 - i) * ZLD + 512 + ch]; } } while (0)
            LRU_LOAD(uw, gv, 0);
            float h = 0.f, pa = 1.f;
            if (PASS == 1) h = WSP(float, WS_LH)[((size_t)(b * 2 + dir) * 68 + kd) * 512 + ch];
#pragma unroll 1
            for (int st = 0; st < LRU_NST; ++st) {
                const int sub = dir == 0 ? st : LRU_NST - 1 - st;
                if (st + 1 < LRU_NST) LRU_LOAD(un, gn, st + 1);
                float xf[LRU_ST], rg[LRU_ST];
#pragma unroll
                for (int i = 0; i < LRU_ST; ++i) xf[i] = cb + cw0 * uw[i] + cw1 * uw[i + 1] + cw2 * uw[i + 2] + cw3 * uw[i + 3];
#pragma unroll
                for (int i = 0; i < LRU_ST; ++i) *(LAS bf16*)(At + i * 144 + lane * 2) = (bf16)f2bf(xf[i]);
#pragma unroll
                for (int gate = 0; gate < 2; ++gate) {
                    f32x4 acc[4];
#pragma unroll
                    for (int n = 0; n < 4; ++n) acc[n] = (f32x4){0.f, 0.f, 0.f, 0.f};
#pragma unroll
                    for (int ks = 0; ks < 2; ++ks) {
                        const bf16x8 af0 = *(const LAS bf16x8*)(At + fr * 144 + (32 * ks + 8 * fq) * 2);
#pragma unroll
                        for (int n = 0; n < 4; ++n) acc[n] = __builtin_amdgcn_mfma_f32_16x16x32_bf16(wf[gate][ks][n], af0, acc[n], 0, 0, 0);
                    }
#pragma unroll
                    for (int n = 0; n < 4; ++n) *(LAS f32x4*)(Gt + fr * 272 + (16 * n + 4 * fq) * 4) = acc[n];
#pragma unroll
                    for (int i = 0; i < LRU_ST; ++i) { const float pre = *(const LAS float*)(Gt + i * 272 + lane * 4);
                        if (gate == 0) rg[i] = sigmoidf_(pre + br);
                        else { const float gi = sigmoidf_(pre + bi); const float a = __expf(sp8 * rg[i]); rg[i] = a; xf[i] = sqrtf(fmaxf(1.f - a * a, 0.f)) * (gi * xf[i]); } }
                }
#pragma unroll
                for (int i = 0; i < LRU_ST; ++i) { const int tl = dir == 0 ? LRU_ST * sub + i : LRU_ST * sub + LRU_ST - 1 - i;
                    h = rg[i] * h + xf[i]; if (PASS == 0) pa *= rg[i];
                    if (PASS == 1) {
                        if (dir == 0) *(LAS bf16*)(Ht + tl * 128 + lane * 2) = (bf16)f2bf(h);
                        else { const float hf = bf2f(*(const LAS bf16*)(Ht + tl * 128 + lane * 2)); const size_t row = (size_t)(segrow0 + t0 + tl);
                            WSP(bf16, WS_YM)[row * D + ch] = (bf16)f2bf((hf + h) * gelu_fast(gv[i])); } } }
#pragma unroll
                for (int q = 0; q < LRU_ST + 3; ++q) uw[q] = un[q];
                if (PASS == 1) {
#pragma unroll
                    for (int i = 0; i < LRU_ST; ++i) gv[i] = gn[i]; }
            }
#undef LRU_LOAD
            if (PASS == 0) { f32x2_t o; o.x = pa; o.y = h; *(f32x2_t*)(AGG + ((size_t)(b * 2 + dir) * 68 + kd) * 1024 + ch * 2) = o; }
        }
    }
}

__device__ __forceinline__ void ph_oprep(Fr& F) {
    const Ptrs& P = F.P; const int lane = F.lane, sub = lane >> 4, d4 = lane & 15;
    const float* Z = WSP(float, WS_Z); bf16* QG = WSP(bf16, WS_QG); bf16* KG = WSP(bf16, WS_KG); bf16* VGT = WSP(bf16, WS_VG);
    const float* ropeG = WSP(float, WS_ROPEG);
    LAS unsigned char* scr = (LAS unsigned char*)F.lds + F.wave * 4096;
    const f32x4 gq = *(const f32x4*)(P.in[24] + 4 * d4), gk = *(const f32x4*)(P.in[24] + 64 + 4 * d4);
    for (int g = F.gw; g < NT / 8; g += F.ngw) {
        const int r0 = g * 8; int b, s0; row_bs(r0, b, s0);
        const bool lat = r0 < NL;
#pragma unroll 2
        for (int rr = 0; rr < 8; ++rr) {
            const int s = s0 + rr; const float* z = Z + (size_t)(r0 + rr) * ZLD;
            f32x4 cs = {1.f, 1.f, 1.f, 1.f}, sn = {0.f, 0.f, 0.f, 0.f};
            if (lat) { const float* rp = ropeG + ((size_t)s * 32 + 4 * (d4 & 7)) * 2; const f32x4 c0 = *(const f32x4*)rp, c1 = *(const f32x4*)(rp + 4);
                cs = (f32x4){c0.x, c0.z, c1.x, c1.z}; sn = (f32x4){c0.y, c0.w, c1.y, c1.w}; }
            if (d4 >= 8) sn = -sn;
            if (lat) {
#pragma unroll
                for (int pass = 0; pass < 4; ++pass) { const int hd = 4 * pass + sub;
                    f32x4 x = *(const f32x4*)(z + hd * 64 + 4 * d4);
                    const float rs = rsqrtf(reduce16(dot4(x)) * (1.f / 64.f) + 1e-6f);
                    x = x * rs * gq;
                    f32x4 xo; xo.x = dppf<0x128>(x.x); xo.y = dppf<0x128>(x.y); xo.z = dppf<0x128>(x.z); xo.w = dppf<0x128>(x.w);
                    x = x * cs - xo * sn;
                    u32x2 w; w.x = pk2(x.x, x.y); w.y = pk2(x.z, x.w); *(u32x2*)(QG + (((size_t)b * 16 + hd) * SEQ + s) * 64 + 4 * d4) = w; } }
            { f32x4 x = *(const f32x4*)(z + 1024 + sub * 64 + 4 * d4);
              const float rs = rsqrtf(reduce16(dot4(x)) * (1.f / 64.f) + 1e-6f);
              x = x * rs * gk;
              f32x4 xo; xo.x = dppf<0x128>(x.x); xo.y = dppf<0x128>(x.y); xo.z = dppf<0x128>(x.z); xo.w = dppf<0x128>(x.w);
              x = x * cs - xo * sn;
              u32x2 w; w.x = pk2(x.x, x.y); w.y = pk2(x.z, x.w); *(u32x2*)(KG + (((size_t)b * 4 + sub) * TA + s) * 64 + 4 * d4) = w;
              const f32x4 vx = *(const f32x4*)(z + 1280 + sub * 64 + 4 * d4);
              w.x = pk2(vx.x, vx.y); w.y = pk2(vx.z, vx.w); *(LAS u32x2*)(scr + (sub * 8 + rr) * 128 + 8 * d4) = w; }
        }
#pragma unroll
        for (int hh = 0; hh < 4; ++hh) {
            unsigned short t8[8];
#pragma unroll
            for (int rr = 0; rr < 8; ++rr) t8[rr] = *(const LAS unsigned short*)(scr + (hh * 8 + rr) * 128 + 2 * lane);
            u32x4 w; w.x = t8[0] | ((unsigned)t8[1] << 16); w.y = t8[2] | ((unsigned)t8[3] << 16); w.z = t8[4] | ((unsigned)t8[5] << 16); w.w = t8[6] | ((unsigned)t8[7] << 16);
            *(u32x4*)(VGT + (((size_t)b * 4 + hh) * 64 + lane) * TA + s0) = w;
        }
    }
}
__device__ __forceinline__ void ph_attn_gqa(Fr& F) {
    const Ptrs& P = F.P;
    const int x = F.blk & 7, j = F.blk >> 3;
    const float c = 0.125f * 1.4426950408889634f;
    for (int rd = 0; ; ++rd) {
        int pair, qblk;
        if (F.nblk == 256) { if (rd >= 4) break; pair = rd * 4 + (x >> 1); qblk = 32 * (x & 1) + j; }
        else { const int u = rd * F.nblk + F.blk; if (u >= 1024) break; pair = u >> 6; qblk = u & 63; }
        const int b = pair >> 2, kh = pair & 3, head = kh * 4 + (F.wave >> 1);
        const int qpos = qblk * 64 + 32 * (F.wave & 1) + (F.lane & 31);
        const int a0 = qblk - 2 < 0 ? 0 : qblk - 2, a1 = qblk + 3 > 64 ? 64 : qblk + 3;
        attn_unit<64, true>((LAS unsigned char*)F.lds, WSP(bf16, WS_QG) + (((size_t)b * 16 + head) * SEQ + qpos) * 64, WSP(bf16, WS_KG) + ((size_t)b * 4 + kh) * TA * 64,
                            WSP(bf16, WS_VG) + ((size_t)b * 4 + kh) * 64 * TA, a0, a1, 64, 68, c, qpos, qblk, P.in[25][head] * 1.4426950408889634f,
                            WSP(bf16, WS_YM) + ((size_t)b * SEQ + qpos) * D + head * 64, F.tid, F.lane);
    }
}

__device__ __forceinline__ void ph_router(Fr& F, int layer, int nrows, int dummy = 0) {
    const Ptrs& P = F.P; const int lane = F.lane;
    const float* MOD = WSP(float, WS_MOD); const float* X1 = WSP(float, WS_X1);
    { const f32x4* src = (const f32x4*)(WSP(float, WS_WRT) + (size_t)layer * 32 * 1024); LAS f32x4* dst = (LAS f32x4*)F.lds;
#pragma unroll 4
      for (int i = 0; i < 16; ++i) dst[F.tid + NTHR * i] = src[F.tid + NTHR * i];
      __syncthreads(); }
    const LAS float* wl = (const LAS float*)F.lds;
    int* cnt = (int*)(P.ws + WS_CTL + CW_CNT) + layer * NE + (dummy ? 64 : 0);
    unsigned char* const wsd = P.ws + (dummy ? (WS_XF - WS_F) : 0);
    LAS int* lcnt = (LAS int*)((LAS unsigned char*)F.lds + LDS_MISC + 4096); LAS int* lbase = lcnt + 32;
    LAS int* rec = (LAS int*)((LAS unsigned char*)F.lds + LDS_MISC + 4608) + F.wave * 80;
    if (F.tid < 32) lcnt[F.tid] = 0;
    __syncthreads();
    const int e8 = ((lane >> 5) & 1) * 4 + ((lane >> 4) & 1) * 2 + ((lane >> 3) & 1);
    int it = 0;
    for (int r0 = F.gw * 2; r0 < nrows; r0 += F.ngw * 2, ++it) {
        RowV v[2];
#pragma unroll
        for (int rr = 0; rr < 2; ++rr) { v[rr] = load_row(X1 + (size_t)(r0 + rr) * D, lane);
            const float* m = MOD + (size_t)(layer * 5 + mod_row(r0 + rr)) * 6144;
            norm_mod(v[rr], P.in[7] + layer * D, m + 4 * 1024, m + 3 * 1024, lane);
            { unsigned* f8 = (unsigned*)(wsd + WS_F + (size_t)(r0 + rr) * D) + lane;
#pragma unroll
              for (int j = 0; j < 4; ++j) f8[64 * j] = pk4_fp8(v[rr].v[j].x, v[rr].v[j].y, v[rr].v[j].z, v[rr].v[j].w); } }
        float lg[2][4];
        int zoff = 0; asm volatile("" : "+v"(zoff));
#pragma unroll
        for (int grp = 0; grp < 4; ++grp) {
            float acc[2][8];
#pragma unroll
            for (int e = 0; e < 8; ++e) { const LAS f32x4* w = (const LAS f32x4*)(wl + (grp * 8 + e) * 1024) + lane + zoff;
                const f32x4 w0 = w[0], w1 = w[64], w2 = w[128], w3 = w[192];
#pragma unroll
                for (int rr = 0; rr < 2; ++rr) { const f32x4 p = v[rr].v[0] * w0 + v[rr].v[1] * w1 + v[rr].v[2] * w2 + v[rr].v[3] * w3; acc[rr][e] = (p.x + p.y) + (p.z + p.w); }
                if ((e & 3) == 3) asm volatile("" : "+v"(zoff) : "v"(acc[1][e])); }
            const float bias = P.in[28][layer * NE + grp * 8 + e8];
#pragma unroll
            for (int rr = 0; rr < 2; ++rr) {
                float (&a)[8] = acc[rr];
#pragma unroll
                for (int i = 0; i < 4; ++i) { const bool hi = lane & 32; const float send = hi ? a[i] : a[i + 4], keep = hi ? a[i + 4] : a[i]; a[i] = keep + __shfl_xor(send, 32); }
#pragma unroll
                for (int i = 0; i < 2; ++i) { const bool hi = lane & 16; const float send = hi ? a[i] : a[i + 2], keep = hi ? a[i + 2] : a[i]; a[i] = keep + __shfl_xor(send, 16); }
                { const bool hi = lane & 8; const float send = hi ? a[0] : a[1], keep = hi ? a[1] : a[0]; a[0] = keep + dppf<0x128>(send); }
                float t = a[0]; t += dppf<0xB1>(t); t += dppf<0x4E>(t); t += dppf<0x141>(t);
                lg[rr][grp] = t + bias;
            }
        }
#pragma unroll
        for (int rr = 0; rr < 2; ++rr) {
            float c[4] = {lg[rr][0], lg[rr][1], lg[rr][2], lg[rr][3]};
            int te[4]; float tv[4];
#pragma unroll
            for (int k = 0; k < 4; ++k) {
                float bv = c[0]; int bi = e8;
#pragma unroll
                for (int g = 1; g < 4; ++g) { const bool take = c[g] > bv; bv = take ? c[g] : bv; bi = take ? 8 * g + e8 : bi; }
#pragma unroll
                for (int o = 8; o < 64; o <<= 1) { const float ov = __shfl_xor(bv, o); const int oi = __shfl_xor(bi, o); const bool take = ov > bv || (ov == bv && oi < bi); bv = take ? ov : bv; bi = take ? oi : bi; }
                te[k] = bi; tv[k] = bv;
#pragma unroll
                for (int g = 0; g < 4; ++g) c[g] = (bi == 8 * g + e8) ? -3.4e38f : c[g]; }
            const float e1 = __expf(tv[1] - tv[0]), e2 = __expf(tv[2] - tv[0]), e3 = __expf(tv[3] - tv[0]); const float inv = 1.f / (1.f + e1 + e2 + e3);
            if (lane < 4) { const int e = lane == 0 ? te[0] : lane == 1 ? te[1] : lane == 2 ? te[2] : te[3]; const float g = (lane == 0 ? 1.f : lane == 1 ? e1 : lane == 2 ? e2 : e3) * inv;
                const int rank = __hip_atomic_fetch_add(lcnt + e, 1, __ATOMIC_RELAXED, __HIP_MEMORY_SCOPE_WORKGROUP);
                rec[((it * 2 + rr) * 4 + lane) * 2] = e | (rank << 8); rec[((it * 2 + rr) * 4 + lane) * 2 + 1] = __float_as_int(g); }
        }
    }
    __syncthreads();
    if (F.tid < 32) lbase[F.tid] = atomicAdd(&cnt[F.tid], lcnt[F.tid]);
    __syncthreads();
    it = 0;
    for (int r0 = F.gw * 2; r0 < nrows; r0 += F.ngw * 2, ++it) {
        if (lane < 8) { const int rr = lane >> 2, k = lane & 3, r = r0 + rr; const int er = rec[((it * 2 + rr) * 4 + k) * 2]; const int e = er & 255, slot = lbase[e] + (er >> 8);
            ((int*)(wsd + WS_TOK))[(size_t)e * NT + slot] = r;
            ((int*)(wsd + WS_PE))[r * 4 + k] = e; ((int*)(wsd + WS_PS))[r * 4 + k] = slot; ((int*)(wsd + WS_PG))[r * 4 + k] = rec[((it * 2 + rr) * 4 + k) * 2 + 1]; }
    }
}
template <int MODE>
__device__ __forceinline__ void ph_combine(Fr& F, int layer, int nrows) {
    const Ptrs& P = F.P; const int lane = F.lane;
    moe_prefix(F, layer);
    const int* pre = (const int*)(F.lds + LDS_MISC + 64);
    const float* MOD = WSP(float, WS_MOD); const float* X1 = WSP(float, WS_X1); const bf16* Y = WSP(bf16, WS_Y);
    for (int r = F.gw; r < nrows; r += F.ngw) {
        RowV v = load_row(X1 + (size_t)r * D, lane);
        const float* g2 = MOD + (size_t)(layer * 5 + mod_row(r)) * 6144 + 5 * 1024;
        RowV acc;
#pragma unroll
        for (int j = 0; j < 4; ++j) acc.v[j] = (f32x4){0.f, 0.f, 0.f, 0.f};
#pragma unroll
        for (int k = 0; k < 4; ++k) { const int e = WSP(int, WS_PE)[r * 4 + k], slot = WSP(int, WS_PS)[r * 4 + k]; const float g = WSP(float, WS_PG)[r * 4 + k];
            const u32x2* y = (const u32x2*)(Y + ((size_t)pre[e] * 256 + slot) * D) + lane;
#pragma unroll
            for (int j = 0; j < 4; ++j) { const u32x2 w = y[64 * j]; acc.v[j] += (f32x4){bflo(w.x), bfhi(w.x), bflo(w.y), bfhi(w.y)} * g; } }
#pragma unroll
        for (int j = 0; j < 4; ++j) v.v[j] += ((const f32x4*)g2)[lane + 64 * j] * acc.v[j];
        if (MODE == 0) {
            f32x4* xo = (f32x4*)(WSP(float, WS_X2) + (size_t)r * D) + lane;
#pragma unroll
            for (int j = 0; j < 4; ++j) xo[64 * j] = v.v[j];
            const float* m = MOD + (size_t)(1 * 5 + mod_row(r)) * 6144;
            norm_mod(v, P.in[6] + D, m + 1024, m, lane);
            store_row_bf16(WSP(bf16, WS_HN) + (size_t)r * D, v, lane);
        } else {
            f32x4* xo = (f32x4*)(P.out + (size_t)r * D) + lane;
#pragma unroll
            for (int j = 0; j < 4; ++j) xo[64 * j] = v.v[j];
        }
    }
}

constexpr int NPHASE = 20;
struct Args { Ptrs P; int ph_lo, ph_hi, bar_idx, variant; };
__global__ void __launch_bounds__(NTHR, 2) mk_fwd(Args args) {
    extern __shared__ __attribute__((aligned(16))) unsigned char lds[];
    Fr F; F.P = args.P; F.lds = lds;
    F.tid = threadIdx.x; F.lane = F.tid & 63; F.wave = __builtin_amdgcn_readfirstlane(F.tid >> 6);
    F.nblk = gridDim.x; F.blk = blockIdx.x; F.gw = F.blk * NWAVES + F.wave; F.ngw = F.nblk * NWAVES;
    F.gtid = (size_t)F.blk * NTHR + F.tid; F.gsz = (size_t)F.nblk * NTHR;
    const Ptrs& P = F.P;
    if (F.tid < 64) ((unsigned*)(lds + LDS_MISC))[F.tid] = 0u;
    __syncthreads();
    const int lo = args.ph_lo, hi = args.ph_hi;
    unsigned* barw = (unsigned*)(P.ws + WS_CTL) + args.bar_idx * XCD_BAR_WORDS;
    XcdBarrier bar; bar.bar = barw; bar.x = 0; bar.st = nullptr;
    if (hi - lo > 1) bar = xcd_barrier_post(barw, (volatile LAS unsigned*)(lds + LDS_MISC));
#ifndef PROBE_MASK
#define PROBE_MASK 0u
#endif
#define IN(k) (lo <= (k) && (k) < hi)
#define REP(k) for (int _rep = 0; _rep < (((PROBE_MASK >> (k)) & 1u) ? 2 : 1); ++_rep)
#define SEAM(k) do { if (IN(k) && IN((k) + 1)) xcd_barrier(bar); } while (0)
    const float* MOD = WSP(float, WS_MOD);
    if (IN(0)) REP(0) { ph_prologue(F); } if (IN(0)) conv_fill<0>(F); SEAM(0);
    if (IN(1)) REP(1) { ph_norm0(F); } SEAM(1);
    if (IN(2)) REP(2) { ph_gemm(F, WSP(bf16, WS_HN), 1024, WSP(bf16, WS_WIN), 1024, NT, 1536, 1024, GF32{EpiF32{WSP(float, WS_Z), ZLD, EVEN_IN}}); } if (IN(2)) conv_fill<2>(F); SEAM(2);
    if (IN(3)) { REP(20) { ph_e3(F); } REP(21) { ph_lru<0>(F); } } if (IN(3)) conv_fill<3>(F); SEAM(3);
    if (IN(4)) REP(4) { ph_gemm(F, WSP(bf16, WS_QKVN), 384, WSP(bf16, WS_WQKVB), 384, NT, 1792, 384, GF32{EpiF32{WSP(float, WS_QKVR), 1792, 1792}}); ph_lru_carry(F); } SEAM(4);
    if (IN(5)) { REP(22) { ph_lru<1>(F); } REP(23) { ph_e5(F); } } if (IN(5)) conv_fill<5>(F); SEAM(5);
    if (IN(6)) REP(6) { ph_attn_mla(F); } SEAM(6);
    if (IN(7)) REP(7) { ph_gemm(F, WSP(bf16, WS_YM), 1024, WSP(bf16, WS_WOE), 1024, NT, 1024, 1024, GResid{P.in[0], P.in[2], WSP(float, WS_X1), MOD + 2 * 1024}); } if (IN(7)) conv_fill<7>(F); SEAM(7);
    if (IN(8)) REP(8) { ph_router(F, 0, NT, args.variant); } SEAM(8);
    if (IN(9)) REP(9) { ph_moe_gemm<1>(F, 0, args.variant); } SEAM(9);
    if (IN(10)) REP(10) { ph_moe_gemm<2>(F, 0, args.variant); } if (IN(10)) conv_fill<10>(F); SEAM(10);
    if (IN(11)) REP(11) { ph_combine<0>(F, 0, NT); } if (IN(11)) conv_fill<11>(F); SEAM(11);
    if (IN(12)) REP(12) { ph_gemm(F, WSP(bf16, WS_HN), 1024, WSP(bf16, WS_WQO), 1024, NT, 1536, 1024, GF32{EpiF32{WSP(float, WS_Z), ZLD, 1536}}); } if (IN(12)) conv_fill<12>(F); SEAM(12);
    if (IN(13)) REP(13) { ph_oprep(F); } SEAM(13);
    if (IN(14)) REP(14) { ph_attn_gqa(F); } SEAM(14);
    if (IN(15)) REP(15) { ph_gemm(F, WSP(bf16, WS_YM), 1024, WSP(bf16, WS_WOO), 1024, NL, 1024, 1024, GResid{WSP(float, WS_X2), WSP(float, WS_X2) + (size_t)NL * D, WSP(float, WS_X1), MOD + 5 * 6144 + 2 * 1024}); } SEAM(15);
    if (IN(16)) REP(16) { ph_router(F, 1, NL, args.variant); } SEAM(16);
    if (IN(17)) REP(17) { ph_moe_gemm<1>(F, 1); } SEAM(17);
    if (IN(18)) REP(18) { ph_moe_gemm<2>(F, 1); } SEAM(18);
    if (IN(19)) REP(19) { ph_combine<1>(F, 1, NL); }
#undef IN
#undef SEAM
}

#ifndef MK_N_LAUNCHES
#define MK_N_LAUNCHES 1
#endif
extern "C" void kernel_launch(void* const* d_in, const int* in_sizes, int n_in, void* d_out, int out_size, void* d_ws, size_t ws_size, hipStream_t stream) {
    static int grid = 0;
    if (grid == 0) {
        if (n_in != 33 || ws_size < WS_END) { fprintf(stderr, "kernel_launch: unexpected n_in %d or ws_size %zu < %zu\n", n_in, ws_size, (size_t)WS_END); grid = -1; return; }
        int dev = 0, cus = 0, per_cu = 0;
        if (hipGetDevice(&dev) != hipSuccess || hipDeviceGetAttribute(&cus, hipDeviceAttributeMultiprocessorCount, dev) != hipSuccess) { grid = -1; return; }
        if (hipFuncSetAttribute((const void*)mk_fwd, hipFuncAttributeMaxDynamicSharedMemorySize, LDS_BYTES) != hipSuccess) { fprintf(stderr, "kernel_launch: hipFuncSetAttribute failed\n"); grid = -1; return; }
        if (hipOccupancyMaxActiveBlocksPerMultiprocessor(&per_cu, (const void*)mk_fwd, NTHR, LDS_BYTES) != hipSuccess || per_cu < 1) { fprintf(stderr, "kernel_launch: occupancy query says %d blocks per CU\n", per_cu); grid = -1; return; }
        (void)hipGetLastError();
        grid = cus;
    }
    if (grid < 0) return;
    Args a{};
    for (int i = 0; i < 33; ++i) a.P.in[i] = (const float*)d_in[i];
    a.P.out = (float*)d_out; a.P.ws = (unsigned char*)d_ws;
    (void)hipMemsetAsync((unsigned char*)d_ws + WS_CTL, 0, CTL_BYTES, stream);
    a.bar_idx = 0; a.variant = 0;
#if defined(PROBE_PHASE)
    { const int k = PROBE_PHASE; a.ph_lo = 0; a.ph_hi = k; a.bar_idx = 0; hipLaunchKernelGGL(mk_fwd, dim3(grid), dim3(NTHR), LDS_BYTES, stream, a);
      for (int r = 0; r < PROBE_REPEAT; ++r) { a.ph_lo = k; a.ph_hi = k + 1; a.bar_idx = 2; a.variant = PROBE_VARIANT; hipLaunchKernelGGL(mk_fwd, dim3(grid), dim3(NTHR), LDS_BYTES, stream, a); }
      a.variant = 0; a.ph_lo = k; a.ph_hi = NPHASE; a.bar_idx = 1; hipLaunchKernelGGL(mk_fwd, dim3(grid), dim3(NTHR), LDS_BYTES, stream, a); }
#else
    a.ph_lo = 0; a.ph_hi = NPHASE; hipLaunchKernelGGL(mk_fwd, dim3(grid), dim3(NTHR), LDS_BYTES, stream, a);
#endif
}
```
